# Optimizing an MI355X kernel written in HIP

```python
import math
import jax
import jax.numpy as jnp
from jax import lax
import numpy as np

D_MODEL = 1024
BATCH = 8
SEQ = 4096
DEPTH = 2

GRID_W = 64
CTX_LEN = 256
D_FF = 2816
N_SUB = 3
N_MOD = 3 * N_SUB
MACARON_W = 0.5
ROPE_THETA = 10000.0
Q_BLOCK = 128
NEG_INF = -1e30
EPS = 1e-6

MLA_HEADS = 4
MLA_NOPE = 64
MLA_ROPE = 32
MLA_V = 64
MLA_Q_LORA = 192
MLA_KV_LORA = 128
MLA_W = MLA_HEADS * MLA_V
MLA_SCALE = (MLA_NOPE + MLA_ROPE) ** -0.5

HY_W = 256
HY_ORDER = 2
HY_EMB = 33
HY_FH = 64
HY_DECAY_TARGET = 1e-2
HY_FAST_PCT = 0.3
HY_SLOW_PCT = 1.5
SHORT_K = 3

SWA_HEADS = 4
SWA_KV_HEADS = 2
SWA_HD = 64
SWA_W = SWA_HEADS * SWA_HD
WINDOW = 128
SWA_BLOCK = WINDOW
SWA_SCALE = SWA_HD ** -0.5

S5_W = 256
S5_GC = 16
S5_GROUPS = S5_W // S5_GC
S5_P = 64
S5_DT_MIN = 1e-3
S5_DT_MAX = 1e-1

IN_SPLITS = (
    ('mla_ckv', MLA_KV_LORA),
    ('mla_krope', MLA_ROPE),
    ('swa_k', SWA_KV_HEADS * SWA_HD),
    ('swa_v', SWA_KV_HEADS * SWA_HD),
    ('s5_u', S5_W),
    ('mla_cq', MLA_Q_LORA),
    ('swa_q', SWA_W),
    ('hy', (HY_ORDER + 1) * HY_W),
)
N_SIDE = MLA_KV_LORA + MLA_ROPE + 2 * SWA_KV_HEADS * SWA_HD + S5_W
N_IN = N_SIDE + MLA_Q_LORA + SWA_W + (HY_ORDER + 1) * HY_W
BRANCH_PROJ = ('w_br_mla', 'w_br_hy', 'w_br_swa', 'w_br_s5')
N_BRANCH = len(BRANCH_PROJ)

kernel_name = 'hybrid_dit_parallel_mixers'


def rmsnorm(x, g):
    xf = x.astype(jnp.float32)
    y = xf * lax.rsqrt(jnp.mean(xf * xf, axis=-1, keepdims=True) + EPS)
    return (y * g.astype(jnp.float32)).astype(x.dtype)


def swiglu(u, w_up, w_down):
    a, b = jnp.split(u @ w_up, 2, axis=-1)
    return (jax.nn.silu(a) * b) @ w_down


def modulation(cvec, p):
    m = jax.nn.silu(cvec) @ p['w_ada'] + p['b_ada']
    return m.reshape(m.shape[:-1] + (N_MOD, D_MODEL))


def pre_mod(x, g, m, i):
    return rmsnorm(x, g) * (1.0 + m[..., None, 3 * i + 1, :]) + m[..., None, 3 * i, :]


def post_add(x, f, g, m, i, res_w):
    return x + res_w * m[..., None, 3 * i + 2, :] * rmsnorm(f, g)


def ffn_sublayer(x, m, p, i, w_up, w_down):
    u = pre_mod(x, p['norm_pre'][i], m, i)
    return post_add(x, swiglu(u, w_up, w_down), p['norm_post'][i], m, i, MACARON_W)


def split_cols(t):
    parts, off = {}, 0
    for name, size in IN_SPLITS:
        if off >= t.shape[-1]:
            break
        parts[name] = t[..., off:off + size]
        off += size
    return parts


def axial_rope(n_tokens, rot_dim):
    rows = n_tokens // GRID_W
    r = jnp.repeat(jnp.arange(rows, dtype=jnp.float32), GRID_W)
    col = jnp.tile(jnp.arange(GRID_W, dtype=jnp.float32), rows)
    n_freq = rot_dim // 4
    freqs = ROPE_THETA ** (-jnp.arange(n_freq, dtype=jnp.float32) / n_freq)
    ang = jnp.concatenate([r[:, None] * freqs, col[:, None] * freqs], axis=-1)
    return jnp.cos(ang), jnp.sin(ang)


def apply_rope(x, cos, sin):
    half = x.shape[-1] // 2
    x1, x2 = x[..., :half], x[..., half:]
    cos, sin = cos.astype(x.dtype), sin.astype(x.dtype)
    return jnp.concatenate([x1 * cos - x2 * sin, x1 * sin + x2 * cos], axis=-1)


def block_attention(q, k, v, scale):
    B, L, H, dq = q.shape
    nb = L // Q_BLOCK
    qb = jnp.moveaxis(q.reshape(B, nb, Q_BLOCK, H, dq), 1, 0)

    def one_block(qblk):
        s = jnp.einsum('bqhd,bkhd->bhqk', qblk, k).astype(jnp.float32) * scale
        pr = jax.nn.softmax(s, axis=-1).astype(v.dtype)
        return jnp.einsum('bhqk,bkhd->bqhd', pr, v)

    o = lax.map(one_block, qb)
    return jnp.moveaxis(o, 0, 1).reshape(B, L, -1)


def mla_queries(cq, p, rope):
    B, L, _ = cq.shape
    q = (rmsnorm(cq, p['mla_q_norm']) @ p['mla_w_uq']).reshape(B, L, MLA_HEADS, MLA_NOPE + MLA_ROPE)
    if rope is not None:
        q_rope = apply_rope(q[..., MLA_NOPE:], rope[0][:, None], rope[1][:, None])
        q = jnp.concatenate([q[..., :MLA_NOPE], q_rope], axis=-1)
    return q


def mla_keys_values(ckv, krope, p, rope):
    B, L, _ = ckv.shape
    kv = (rmsnorm(ckv, p['mla_kv_norm']) @ p['mla_w_ukv']).reshape(B, L, MLA_HEADS, MLA_NOPE + MLA_V)
    if rope is not None:
        krope = apply_rope(krope, rope[0], rope[1])
    k_rope = jnp.broadcast_to(krope[:, :, None, :], (B, L, MLA_HEADS, MLA_ROPE))
    k = jnp.concatenate([kv[..., :MLA_NOPE], k_rope], axis=-1)
    return k, kv[..., MLA_NOPE:]


def short_conv(x, w, b):
    L = x.shape[1]
    r = SHORT_K // 2
    xp = jnp.pad(x, ((0, 0), (r, r), (0, 0)))
    y = b
    for j in range(SHORT_K):
        y = y + xp[:, j:j + L] * w[j]
    return y


def hyena_filter_response(L, p):
    f32 = jnp.float32
    t = jnp.linspace(0.0, 1.0, L, dtype=f32)[:, None]
    bands = (HY_EMB - 1) // 2
    w = 2.0 * math.pi * jnp.arange(L, dtype=f32) / L
    fr = jnp.linspace(1e-4, bands - 1, bands, dtype=f32)
    ang = w[:, None] * fr[None, :]
    z = jnp.concatenate([t, jnp.cos(ang), -jnp.sin(ang)], axis=-1)
    freq = p['hy_f_freq'].astype(f32)
    h = jnp.sin(freq[0] * (z @ p['hy_f_w1'].astype(f32) + p['hy_f_b1'].astype(f32)))
    h = jnp.sin(freq[1] * (h @ p['hy_f_w2'].astype(f32) + p['hy_f_b2'].astype(f32)))
    h = (h @ p['hy_f_w3'].astype(f32)).reshape(L, HY_ORDER, 2, HY_W)
    deltas = jnp.abs(jnp.linspace(math.log(HY_DECAY_TARGET) / HY_SLOW_PCT,
                                  math.log(HY_DECAY_TARGET) / HY_FAST_PCT, HY_W, dtype=f32))
    h = h * jnp.exp(-t[:, :, None, None] * deltas)
    h_fwd, h_bwd = h[:, :, 0], h[:, :, 1]
    k_full = jnp.concatenate([h_fwd, jnp.zeros_like(h_fwd[:1]), h_bwd[1:][::-1]], axis=0)
    return jnp.fft.rfft(k_full, axis=0)


def fft_long_conv(z, kf, bias):
    L = z.shape[1]
    zf32 = z.astype(jnp.float32)
    y = jnp.fft.irfft(jnp.fft.rfft(zf32, n=2 * L, axis=1) * kf[None], n=2 * L, axis=1)[:, :L]
    return (y + zf32 * bias.astype(jnp.float32)).astype(z.dtype)


def hyena(proj, p):
    L = proj.shape[1]
    u = short_conv(proj, p['hy_conv_w'], p['hy_conv_b'])
    v, *gates = jnp.split(u, HY_ORDER + 1, axis=-1)
    kf = hyena_filter_response(L, p)
    z = v
    for o in range(HY_ORDER):
        z = gates[o] * fft_long_conv(z, kf[:, o], p['hy_bias'][o])
    return z


def sink_attention(q, k, v, sink):
    B, L, _, _ = q.shape
    g = SWA_HEADS // SWA_KV_HEADS
    qg = q.reshape(B, L, SWA_KV_HEADS, g, SWA_HD)
    s = jnp.einsum('bqkgd,bjkd->bkgqj', qg, k).astype(jnp.float32) * SWA_SCALE
    snk = jnp.broadcast_to(sink.astype(jnp.float32).reshape(SWA_KV_HEADS, g)[None, :, :, None, None],
                           s.shape[:-1] + (1,))
    pr = jax.nn.softmax(jnp.concatenate([s, snk], axis=-1), axis=-1)[..., :-1].astype(v.dtype)
    return jnp.einsum('bkgqj,bjkd->bqkgd', pr, v).reshape(B, L, SWA_W)


def banded_sink_attention(q, k, v, k_ctx, v_ctx, sink):
    B, S, _, _ = q.shape
    g = SWA_HEADS // SWA_KV_HEADS
    nb = S // SWA_BLOCK
    span = 3 * SWA_BLOCK
    qb = q.reshape(B, nb, SWA_BLOCK, SWA_KV_HEADS, g, SWA_HD)

    def band(t):
        tp = jnp.pad(t, ((0, 0), (SWA_BLOCK, SWA_BLOCK), (0, 0), (0, 0)))
        tp = tp.reshape(B, nb + 2, SWA_BLOCK, SWA_KV_HEADS, SWA_HD)
        return jnp.concatenate([tp[:, :-2], tp[:, 1:-1], tp[:, 2:]], axis=2)

    kw, vw = band(k), band(v)
    qpos = jnp.arange(S).reshape(nb, SWA_BLOCK)
    kpos = jnp.arange(nb)[:, None] * SWA_BLOCK - SWA_BLOCK + jnp.arange(span)[None, :]
    valid = ((jnp.abs(qpos[:, :, None] - kpos[:, None, :]) <= WINDOW)
             & (kpos[:, None, :] >= 0) & (kpos[:, None, :] < S))
    s_w = jnp.einsum('bnqkgd,bnjkd->bnkgqj', qb, kw).astype(jnp.float32) * SWA_SCALE
    s_w = jnp.where(valid[None, :, None, None], s_w, NEG_INF)
    s_c = jnp.einsum('bnqkgd,bjkd->bnkgqj', qb, k_ctx).astype(jnp.float32) * SWA_SCALE
    snk = jnp.broadcast_to(sink.astype(jnp.float32).reshape(SWA_KV_HEADS, g)[None, None, :, :, None, None],
                           s_w.shape[:-1] + (1,))
    pr = jax.nn.softmax(jnp.concatenate([s_w, s_c, snk], axis=-1), axis=-1).astype(v.dtype)
    n_ctx = k_ctx.shape[1]
    o = (jnp.einsum('bnkgqj,bnjkd->bnqkgd', pr[..., :span], vw)
         + jnp.einsum('bnkgqj,bjkd->bnqkgd', pr[..., span:span + n_ctx], v_ctx))
    return o.reshape(B, S, SWA_W)


def s5_discretize(p, d):
    f32 = jnp.float32
    a_re = p['s5_a_re'][d].astype(f32)
    a_im = p['s5_a_im'][d].astype(f32)
    dt = jnp.exp(p['s5_log_dt'][d].astype(f32))[:, None]
    mag = jnp.exp(dt * a_re)
    ab_re, ab_im = mag * jnp.cos(dt * a_im), mag * jnp.sin(dt * a_im)
    den = a_re * a_re + a_im * a_im
    f_re = ((ab_re - 1.0) * a_re + ab_im * a_im) / den
    f_im = (ab_im * a_re - (ab_re - 1.0) * a_im) / den
    return ab_re, ab_im, f_re, f_im


def complex_scan(ab_re, ab_im, x_re, x_im, h0, reverse):
    a_re = jnp.broadcast_to(ab_re, x_re.shape)
    a_im = jnp.broadcast_to(ab_im, x_re.shape)

    def combine(e1, e2):
        a1r, a1i, b1r, b1i = e1
        a2r, a2i, b2r, b2i = e2
        return (a2r * a1r - a2i * a1i, a2r * a1i + a2i * a1r,
                a2r * b1r - a2i * b1i + b2r, a2r * b1i + a2i * b1r + b2i)

    cr, ci, hr, hi = lax.associative_scan(combine, (a_re, a_im, x_re, x_im), reverse=reverse, axis=1)
    if h0 is not None:
        h0r, h0i = h0[0][:, None], h0[1][:, None]
        hr, hi = hr + cr * h0r - ci * h0i, hi + cr * h0i + ci * h0r
    return hr, hi


def s5_run(u, p, init):
    B, L, _ = u.shape
    ug = u.astype(jnp.float32).reshape(B, L, S5_GROUPS, S5_GC)
    states = []
    for d in range(2):
        ab_re, ab_im, f_re, f_im = s5_discretize(p, d)
        bu_re = jnp.einsum('blgc,gpc->blgp', ug, p['s5_b_re'][d].astype(jnp.float32))
        bu_im = jnp.einsum('blgc,gpc->blgp', ug, p['s5_b_im'][d].astype(jnp.float32))
        x_re = f_re * bu_re - f_im * bu_im
        x_im = f_re * bu_im + f_im * bu_re
        states.append(complex_scan(ab_re, ab_im, x_re, x_im, init[d], reverse=(d == 1)))
    return states


def s5_readout(u, states, p):
    B, L, _ = u.shape
    f32 = jnp.float32
    y = u.astype(f32) * p['s5_d'].astype(f32)
    for d, (hr, hi) in enumerate(states):
        yd = (jnp.einsum('blgp,gcp->blgc', hr, p['s5_c_re'][d].astype(f32))
              - jnp.einsum('blgp,gcp->blgc', hi, p['s5_c_im'][d].astype(f32)))
        y = y + yd.reshape(B, L, S5_W)
    g = jax.nn.gelu(y)
    out = g * jax.nn.sigmoid(g @ p['s5_glu_w'].astype(f32) + p['s5_glu_b'].astype(f32))
    return out.astype(u.dtype)


def merge_branches(u, outs, p):
    m = None
    for i, (o, name) in enumerate(zip(outs, BRANCH_PROJ)):
        gate = jax.nn.sigmoid(u @ p['w_gate'][i] + p['b_gate'][i])
        term = gate * (o @ p[name])
        m = term if m is None else m + term
    return m @ p['w_out']


def mixer_context(u, p, with_outputs):
    B, C, _ = u.shape
    w_in = p['w_in'] if with_outputs else p['w_in'][:, :N_SIDE]
    parts = split_cols(u @ w_in)
    k_mla, v_mla = mla_keys_values(parts['mla_ckv'], parts['mla_krope'], p, None)
    k_swa = parts['swa_k'].reshape(B, C, SWA_KV_HEADS, SWA_HD)
    v_swa = parts['swa_v'].reshape(B, C, SWA_KV_HEADS, SWA_HD)
    states = s5_run(parts['s5_u'], p, (None, None))
    (fr, fi), (br, bi) = states
    finals = ((fr[:, -1], fi[:, -1]), (br[:, 0], bi[:, 0]))
    side = (k_mla, v_mla, k_swa, v_swa, finals)
    if not with_outputs:
        return side, None
    o_mla = block_attention(mla_queries(parts['mla_cq'], p, None), k_mla, v_mla, MLA_SCALE)
    o_hy = hyena(parts['hy'], p)
    o_swa = sink_attention(parts['swa_q'].reshape(B, C, SWA_HEADS, SWA_HD), k_swa, v_swa, p['swa_sink'])
    o_s5 = s5_readout(parts['s5_u'], states, p)
    return side, merge_branches(u, (o_mla, o_hy, o_swa, o_s5), p)


def mixer_latent(u, side, p):
    B, S, _ = u.shape
    k_mla_c, v_mla_c, k_swa_c, v_swa_c, s5_h0 = side
    parts = split_cols(u @ p['w_in'])
    rope_m = axial_rope(S, MLA_ROPE)
    rope_w = axial_rope(S, SWA_HD)
    k_l, v_l = mla_keys_values(parts['mla_ckv'], parts['mla_krope'], p, rope_m)
    q_m = mla_queries(parts['mla_cq'], p, rope_m)
    o_mla = block_attention(q_m, jnp.concatenate([k_l, k_mla_c], axis=1),
                            jnp.concatenate([v_l, v_mla_c], axis=1), MLA_SCALE)
    o_hy = hyena(parts['hy'], p)
    cw, sw = rope_w[0][:, None], rope_w[1][:, None]
    q_w = apply_rope(parts['swa_q'].reshape(B, S, SWA_HEADS, SWA_HD), cw, sw)
    k_w = apply_rope(parts['swa_k'].reshape(B, S, SWA_KV_HEADS, SWA_HD), cw, sw)
    v_w = parts['swa_v'].reshape(B, S, SWA_KV_HEADS, SWA_HD)
    o_swa = banded_sink_attention(q_w, k_w, v_w, k_swa_c, v_swa_c, p['swa_sink'])
    states = s5_run(parts['s5_u'], p, s5_h0)
    o_s5 = s5_readout(parts['s5_u'], states, p)
    return merge_branches(u, (o_mla, o_hy, o_swa, o_s5), p)


def layer(xl, xc, ml, mc, p, ctx_out):
    xl = ffn_sublayer(xl, ml, p, 0, p['ffn1_up'], p['ffn1_down'])
    xc = ffn_sublayer(xc, mc, p, 0, p['ffn1_up'], p['ffn1_down'])
    ul = pre_mod(xl, p['norm_pre'][1], ml, 1)
    uc = pre_mod(xc, p['norm_pre'][1], mc, 1)
    side, oc = mixer_context(uc, p, ctx_out)
    ol = mixer_latent(ul, side, p)
    xl = post_add(xl, ol, p['norm_post'][1], ml, 1, 1.0)
    xl = ffn_sublayer(xl, ml, p, 2, p['ffn2_up'], p['ffn2_down'])
    if not ctx_out:
        return xl, None
    xc = post_add(xc, oc, p['norm_post'][1], mc, 1, 1.0)
    xc = ffn_sublayer(xc, mc, p, 2, p['ffn2_up'], p['ffn2_down'])
    return xl, xc


def setup_inputs(seed: int = 0) -> dict:
    key = jax.random.key(seed)
    keys = iter(jax.random.split(key, 64))
    f32 = jnp.float32

    def nrm(shape, std):
        return std * jax.random.normal(next(keys), shape, f32)

    def gain(shape):
        return 1.0 + nrm(shape, 0.02)

    inp = {}
    inp['x'] = nrm((BATCH, SEQ, D_MODEL), 1.0)
    inp['c'] = nrm((BATCH, D_MODEL), 1.0)
    inp['ctx'] = nrm((BATCH, CTX_LEN, D_MODEL), 1.0)
    inp['c_ctx'] = nrm((D_MODEL,), 1.0)
    inp['w_ada'] = nrm((DEPTH, D_MODEL, N_MOD * D_MODEL), 0.5 * D_MODEL ** -0.5)
    inp['b_ada'] = nrm((DEPTH, N_MOD * D_MODEL), 0.02)
    inp['norm_pre'] = gain((DEPTH, N_SUB, D_MODEL))
    inp['norm_post'] = gain((DEPTH, N_SUB, D_MODEL))
    inp['ffn1_up'] = nrm((DEPTH, D_MODEL, 2 * D_FF), D_MODEL ** -0.5)
    inp['ffn1_down'] = nrm((DEPTH, D_FF, D_MODEL), D_FF ** -0.5)
    inp['ffn2_up'] = nrm((DEPTH, D_MODEL, 2 * D_FF), D_MODEL ** -0.5)
    inp['ffn2_down'] = nrm((DEPTH, D_FF, D_MODEL), D_FF ** -0.5)
    inp['w_in'] = nrm((DEPTH, D_MODEL, N_IN), D_MODEL ** -0.5)
    inp['mla_q_norm'] = gain((DEPTH, MLA_Q_LORA))
    inp['mla_kv_norm'] = gain((DEPTH, MLA_KV_LORA))
    inp['mla_w_uq'] = nrm((DEPTH, MLA_Q_LORA, MLA_HEADS * (MLA_NOPE + MLA_ROPE)), MLA_Q_LORA ** -0.5)
    inp['mla_w_ukv'] = nrm((DEPTH, MLA_KV_LORA, MLA_HEADS * (MLA_NOPE + MLA_V)), MLA_KV_LORA ** -0.5)
    inp['hy_conv_w'] = nrm((DEPTH, SHORT_K, (HY_ORDER + 1) * HY_W), SHORT_K ** -0.5)
    inp['hy_conv_b'] = nrm((DEPTH, (HY_ORDER + 1) * HY_W), 0.02)
    inp['hy_f_w1'] = nrm((DEPTH, HY_EMB, HY_FH), HY_EMB ** -0.5)
    inp['hy_f_b1'] = nrm((DEPTH, HY_FH), 0.02)
    inp['hy_f_freq'] = gain((DEPTH, 2, HY_FH))
    inp['hy_f_w2'] = nrm((DEPTH, HY_FH, HY_FH), HY_FH ** -0.5)
    inp['hy_f_b2'] = nrm((DEPTH, HY_FH), 0.02)
    inp['hy_f_w3'] = nrm((DEPTH, HY_FH, HY_ORDER * 2 * HY_W), 0.1 * HY_FH ** -0.5)
    inp['hy_bias'] = nrm((DEPTH, HY_ORDER, HY_W), 0.5)
    inp['swa_sink'] = nrm((DEPTH, SWA_HEADS), 0.5)
    inp['s5_a_re'] = -0.5 + nrm((DEPTH, 2, S5_GROUPS, S5_P), 0.01)
    inp['s5_a_im'] = math.pi * jnp.arange(S5_P, dtype=f32) + nrm((DEPTH, 2, S5_GROUPS, S5_P), 0.01)
    inp['s5_log_dt'] = jax.random.uniform(next(keys), (DEPTH, 2, S5_GROUPS), f32,
                                          math.log(S5_DT_MIN), math.log(S5_DT_MAX))
    inp['s5_b_re'] = nrm((DEPTH, 2, S5_GROUPS, S5_P, S5_GC), (2 * S5_GC) ** -0.5)
    inp['s5_b_im'] = nrm((DEPTH, 2, S5_GROUPS, S5_P, S5_GC), (2 * S5_GC) ** -0.5)
    inp['s5_c_re'] = nrm((DEPTH, 2, S5_GROUPS, S5_GC, S5_P), S5_P ** -0.5)
    inp['s5_c_im'] = nrm((DEPTH, 2, S5_GROUPS, S5_GC, S5_P), S5_P ** -0.5)
    inp['s5_d'] = nrm((DEPTH, S5_W), 1.0)
    inp['s5_glu_w'] = nrm((DEPTH, S5_W, S5_W), S5_W ** -0.5)
    inp['s5_glu_b'] = nrm((DEPTH, S5_W), 0.02)
    inp['w_gate'] = nrm((DEPTH, N_BRANCH, D_MODEL, D_MODEL), D_MODEL ** -0.5)
    inp['b_gate'] = nrm((DEPTH, N_BRANCH, D_MODEL), 0.02)
    inp['w_br_mla'] = nrm((DEPTH, MLA_W, D_MODEL), MLA_W ** -0.5)
    inp['w_br_hy'] = nrm((DEPTH, HY_W, D_MODEL), HY_W ** -0.5)
    inp['w_br_swa'] = nrm((DEPTH, SWA_W, D_MODEL), SWA_W ** -0.5)
    inp['w_br_s5'] = nrm((DEPTH, S5_W, D_MODEL), S5_W ** -0.5)
    inp['w_out'] = nrm((DEPTH, D_MODEL, D_MODEL), D_MODEL ** -0.5)
    return inp


def reference(x, c, ctx, c_ctx, w_ada, b_ada, norm_pre, norm_post, ffn1_up, ffn1_down, ffn2_up, ffn2_down,
              w_in, mla_q_norm, mla_kv_norm, mla_w_uq, mla_w_ukv, hy_conv_w, hy_conv_b, hy_f_w1, hy_f_b1,
              hy_f_freq, hy_f_w2, hy_f_b2, hy_f_w3, hy_bias, swa_sink, s5_a_re, s5_a_im, s5_log_dt,
              s5_b_re, s5_b_im, s5_c_re, s5_c_im, s5_d, s5_glu_w, s5_glu_b, w_gate, b_gate,
              w_br_mla, w_br_hy, w_br_swa, w_br_s5, w_out):
    stacked = dict(w_ada=w_ada, b_ada=b_ada, norm_pre=norm_pre, norm_post=norm_post,
                   ffn1_up=ffn1_up, ffn1_down=ffn1_down, ffn2_up=ffn2_up, ffn2_down=ffn2_down,
                   w_in=w_in, mla_q_norm=mla_q_norm, mla_kv_norm=mla_kv_norm, mla_w_uq=mla_w_uq,
                   mla_w_ukv=mla_w_ukv, hy_conv_w=hy_conv_w, hy_conv_b=hy_conv_b, hy_f_w1=hy_f_w1,
                   hy_f_b1=hy_f_b1, hy_f_freq=hy_f_freq, hy_f_w2=hy_f_w2, hy_f_b2=hy_f_b2, hy_f_w3=hy_f_w3,
                   hy_bias=hy_bias, swa_sink=swa_sink, s5_a_re=s5_a_re, s5_a_im=s5_a_im,
                   s5_log_dt=s5_log_dt, s5_b_re=s5_b_re, s5_b_im=s5_b_im, s5_c_re=s5_c_re,
                   s5_c_im=s5_c_im, s5_d=s5_d, s5_glu_w=s5_glu_w, s5_glu_b=s5_glu_b,
                   w_gate=w_gate, b_gate=b_gate, w_br_mla=w_br_mla, w_br_hy=w_br_hy,
                   w_br_swa=w_br_swa, w_br_s5=w_br_s5, w_out=w_out)
    xl, xc = x, ctx
    for l in range(DEPTH):
        p = {name: arr[l] for name, arr in stacked.items()}
        ml = modulation(c, p)
        mc = modulation(c_ctx, p)
        xl, xc = layer(xl, xc, ml, mc, p, l < DEPTH - 1)
    return xl
```

```cpp
#include <hip/hip_runtime.h>
#include <hip/hip_cooperative_groups.h>
#include <cstdio>
namespace cg = cooperative_groups;
#ifndef PROBE_DBL
#define PROBE_DBL 0
#endif
#ifndef REP_S5
#define REP_S5 1
#endif
#ifndef REP_HY
#define REP_HY 1
#endif
#ifndef REP_MLA
#define REP_MLA 1
#endif
#ifndef REP_SWA
#define REP_SWA 1
#endif

#define DI __device__ __forceinline__
typedef unsigned short bf16_t;
typedef short bf16x8 __attribute__((ext_vector_type(8)));
typedef short s16x4 __attribute__((ext_vector_type(4)));
typedef float f32x16 __attribute__((ext_vector_type(16)));
typedef float f32x4 __attribute__((ext_vector_type(4)));
typedef float f32x2 __attribute__((ext_vector_type(2)));
typedef __bf16 bf16v2 __attribute__((ext_vector_type(2)));
#define MFMA32(a, b, c) __builtin_amdgcn_mfma_f32_32x32x16_bf16((a), (b), (c), 0, 0, 0)
#define MFMA16(a, b, c) __builtin_amdgcn_mfma_f32_16x16x32_bf16((a), (b), (c), 0, 0, 0)

constexpr int NT = 256;
constexpr int DM = 1024, NB = 8, SEQ = 4096, CTX = 256, DFF = 2816;
constexpr int M_LAT = NB * SEQ, M_CTX = NB * CTX, M_ALL = M_LAT + M_CTX;
constexpr int KEYS = SEQ + CTX;
constexpr float EPS = 1e-6f;
constexpr float LOG2E = 1.4426950408889634f;
constexpr int SMEM_BYTES = 73728;

enum { I_X = 0, I_C, I_CTX, I_CCTX, I_WADA, I_BADA, I_NPRE, I_NPOST, I_UP1, I_DN1, I_UP2, I_DN2, I_WIN, I_QNORM, I_KVNORM, I_WUQ, I_WUKV,
       I_HCW, I_HCB, I_HW1, I_HB1, I_HFREQ, I_HW2, I_HB2, I_HW3, I_HBIAS, I_SINK, I_ARE, I_AIM, I_LOGDT, I_BRE, I_BIM, I_CRE, I_CIM, I_S5D,
       I_GLUW, I_GLUB, I_WGATE, I_BGATE, I_BRMLA, I_BRHY, I_BRSWA, I_BRS5, I_WOUT, N_INPUTS };

constexpr size_t AL(size_t x) { return (x + 255) & ~size_t(255); }
constexpr size_t O_WUP1 = 0;
constexpr size_t O_WDN1 = O_WUP1 + AL((size_t)5632 * 1024 * 2);
constexpr size_t O_WUP2 = O_WDN1 + AL((size_t)1024 * 2816 * 2);
constexpr size_t O_WDN2 = O_WUP2 + AL((size_t)5632 * 1024 * 2);
constexpr size_t O_WIN = O_WDN2 + AL((size_t)1024 * 2816 * 2);
constexpr size_t O_WGATE = O_WIN + AL((size_t)1920 * 1024 * 2);
constexpr size_t O_WBR = O_WGATE + AL((size_t)4096 * 1024 * 2);
constexpr size_t O_WOUT = O_WBR + AL((size_t)4 * 1024 * 256 * 2);
constexpr size_t O_WUKV = O_WOUT + AL((size_t)1024 * 1024 * 2);
constexpr size_t O_WUQ = O_WUKV + AL((size_t)512 * 128 * 2);
constexpr size_t O_WGLU = O_WUQ + AL((size_t)384 * 192 * 2);
constexpr size_t O_U = O_WGLU + AL((size_t)256 * 256 * 2);
constexpr size_t O_XC = O_U + AL((size_t)M_ALL * 1024 * 2);
constexpr size_t O_MOD = O_XC + AL((size_t)M_CTX * 1024 * 4);
constexpr size_t O_H2 = O_MOD + AL((size_t)2 * 9 * 9216 * 4);
constexpr size_t O_ROPEM = O_H2 + AL((size_t)2 * (4096 + 256) * 64 * 4);
constexpr size_t O_ROPEW = O_ROPEM + AL((size_t)4096 * 16 * 8);
constexpr size_t O_KF0 = O_ROPEW + AL((size_t)4096 * 32 * 8);
constexpr size_t O_KF1 = O_KF0 + AL((size_t)256 * 2 * 8192 * 8);
constexpr size_t O_ROWSS = O_KF1 + AL((size_t)256 * 2 * 512 * 8);
constexpr size_t O_CTR = O_ROWSS + AL((size_t)2 * M_ALL * 4);
constexpr size_t O_BAR = O_CTR + 256;
constexpr size_t O_R = O_BAR + AL((size_t)3456 * 4);
constexpr size_t O_ACT = O_R;
constexpr size_t O_F = O_R + AL((size_t)M_ALL * 2816 * 2);
constexpr size_t O_O4 = O_R;
constexpr size_t O_Y = O_O4 + AL((size_t)4 * M_ALL * 256 * 2);
constexpr size_t O_HYT = O_Y + AL((size_t)2 * M_ALL * 256 * 2);
constexpr size_t O_MBUF = O_HYT;
constexpr size_t O_S5U = O_HYT + AL((size_t)M_ALL * 768 * 2);
constexpr size_t O_CKV = O_S5U + AL((size_t)M_ALL * 256 * 4);
constexpr size_t O_CQ = O_CKV + AL((size_t)M_ALL * 128 * 2);
constexpr size_t O_KMLA = O_CQ + AL((size_t)M_ALL * 192 * 2);
constexpr size_t O_VMLAT = O_KMLA + AL((size_t)NB * 4 * KEYS * 96 * 2);
constexpr size_t O_QMLA = O_VMLAT + AL((size_t)NB * 4 * 64 * KEYS * 2);
constexpr size_t O_KSWA = O_QMLA + AL((size_t)M_ALL * 384 * 2);
constexpr size_t O_VSWAT = O_KSWA + AL((size_t)NB * 2 * KEYS * 64 * 2);
constexpr size_t O_QSWA = O_VSWAT + AL((size_t)NB * 2 * 64 * KEYS * 2);
constexpr size_t O_END_MIX = O_QSWA + AL((size_t)M_ALL * 256 * 2);
constexpr size_t O_END_FFN = O_F + AL((size_t)M_ALL * 1024 * 2);
constexpr size_t WS_NEED = O_END_MIX > O_END_FFN ? O_END_MIX : O_END_FFN;
static_assert(O_MBUF + (size_t)M_ALL * 1024 * 2 <= O_CKV, "mbuf overlaps");
static_assert(O_F >= O_CKV, "F placement");
static_assert(WS_NEED <= (size_t)512 * 1024 * 1024, "workspace budget");
constexpr size_t HYT_LATSZ = (size_t)NB * 768 * 4096;

struct P {
  const float* in[N_INPUTS];
  float* out;
  unsigned char* ws;
};

DI int opaque_i(int x) { asm volatile("" : "+v"(x)); return x; }
#define TIDX opaque_i((int)threadIdx.x)
DI unsigned pk2(float lo, float hi) { f32x2 v = {lo, hi}; return __builtin_bit_cast(unsigned, __builtin_convertvector(v, bf16v2)); }
DI bf16_t f2bf(float x) { return (bf16_t)(pk2(x, 0.f) & 0xffffu); }
DI float bf2f(bf16_t b) { return __uint_as_float(((unsigned)b) << 16); }
DI float wave_sum(float v) {
#pragma unroll
  for (int o = 32; o; o >>= 1) v += __shfl_xor(v, o);
  return v;
}
DI int crow(int i, int h) { return (i & 3) + 8 * (i >> 2) + 4 * h; }
DI float fast_exp(float x) { return __builtin_amdgcn_exp2f(x * LOG2E); }
DI float sigmoidf_(float x) { return __builtin_amdgcn_rcpf(1.f + fast_exp(-x)); }
DI float siluf_(float x) { return x * sigmoidf_(x); }
DI void sincos_d(double x, float& s_out, float& c_out) {
  double k = rint(x * 0.15915494309189535);
  double r = x - k * 6.283185307179586;
  double y = r * 0.0625, y2 = y * y;
  double s = y * (1.0 - y2 / 6.0 * (1.0 - y2 / 20.0 * (1.0 - y2 / 42.0 * (1.0 - y2 / 72.0 * (1.0 - y2 / 110.0)))));
  double c = 1.0 - y2 / 2.0 * (1.0 - y2 / 12.0 * (1.0 - y2 / 30.0 * (1.0 - y2 / 56.0 * (1.0 - y2 / 90.0 * (1.0 - y2 / 132.0)))));
#pragma unroll
  for (int i = 0; i < 4; ++i) { double s2 = 2.0 * s * c, c2 = c * c - s * s; s = s2; c = c2; }
  s_out = (float)s; c_out = (float)c;
}
DI void sincos_f(float x, float& s_out, float& c_out) {
  const float k = rintf(x * 0.15915494309f);
  float r = fmaf(-k, 6.2831855f, x);
  r = fmaf(-k, -1.7484555e-7f, r);
  const float rv = r * 0.15915494309f;
  s_out = __builtin_amdgcn_sinf(rv); c_out = __builtin_amdgcn_cosf(rv);
}
DI float sin_acc(float x) { float s, c; sincos_f(x, s, c); return s; }

template <int NI>
DI void gemm_kloop(f32x16 (&acc)[2][NI], const bf16_t* __restrict__ A, int lda, const bf16_t* __restrict__ Bt, int ldb, int K, int m0, int n0,
                   unsigned char* smem) {
  unsigned char* sA = smem;
  unsigned char* sB = smem + 32768;
  const int tid = TIDX, lane = tid & 63, wave = tid >> 6, r = lane & 31, h = lane >> 5, wm = wave >> 1, wn = wave & 1;
  const int drow = wave * 8 + (lane >> 3);
  const int csw = (lane & 7) ^ ((drow >> 1) & 7);
  const bf16_t* gA = A + (size_t)(m0 + drow) * lda + csw * 8;
  const bf16_t* gB = Bt + (size_t)(n0 + drow) * ldb + csw * 8;
  const int ldst = wave * 1024 + lane * 16;
  const int rsw = (r >> 1) & 7;
#define G_ISSUE(BUF, KO)                                                                                                        \
  {                                                                                                                             \
    _Pragma("unroll") for (int i = 0; i < 4; ++i)                                                                               \
        __builtin_amdgcn_global_load_lds((const unsigned*)(gA + (size_t)(32 * i) * lda + (KO)),                                 \
                                         (unsigned*)(sA + (BUF) * 16384 + i * 4096 + ldst), 16, 0, 0);                          \
    _Pragma("unroll") for (int i = 0; i < 2 * NI; ++i)                                                                          \
        __builtin_amdgcn_global_load_lds((const unsigned*)(gB + (size_t)(32 * i) * ldb + (KO)),                                 \
                                         (unsigned*)(sB + (BUF) * 16384 + i * 4096 + ldst), 16, 0, 0);                          \
  }
  const int nk = K >> 6;
  __syncthreads();
  G_ISSUE(0, 0)
  asm volatile("s_waitcnt vmcnt(0)" ::: "memory");
  __syncthreads();
  for (int ks = 0; ks < nk; ++ks) {
    const int cur = ks & 1;
    if (ks + 1 < nk) G_ISSUE(cur ^ 1, (ks + 1) * 64)
    const unsigned char* ab = sA + cur * 16384 + (wm * 64 + r) * 128;
    const unsigned char* bb = sB + cur * 16384 + (wn * 32 * NI + r) * 128;
#pragma unroll
    for (int kk = 0; kk < 4; ++kk) {
      const int pc = ((kk * 2 + h) ^ rsw) * 16;
      const bf16x8 a0 = *(const bf16x8*)(ab + pc), a1 = *(const bf16x8*)(ab + 32 * 128 + pc);
#pragma unroll
      for (int ni = 0; ni < NI; ++ni) {
        const bf16x8 b = *(const bf16x8*)(bb + ni * 32 * 128 + pc);
        acc[0][ni] = MFMA32(a0, b, acc[0][ni]);
        acc[1][ni] = MFMA32(a1, b, acc[1][ni]);
      }
    }
    asm volatile("s_waitcnt vmcnt(0)" ::: "memory");
    __syncthreads();
  }
#undef G_ISSUE
}
template <int NI>
DI void zero_acc(f32x16 (&acc)[2][NI]) {
#pragma unroll
  for (int a = 0; a < 2; ++a)
#pragma unroll
    for (int b = 0; b < NI; ++b)
#pragma unroll
      for (int i = 0; i < 16; ++i) acc[a][b][i] = 0.f;
}
#define DSR(dst, addr, off) asm volatile("ds_read_b128 %0, %1 offset:%2" : "=v"(dst) : "v"(addr), "i"(off))
#define FR_READ(F, ST, AA, BB)                                     \
  {                                                                \
    DSR(F##a0, AA, (ST) * 24576);                                  \
    DSR(F##a1, AA, (ST) * 24576 + 2048);                           \
    DSR(F##b0, BB, (ST) * 24576 + 8192);                           \
    DSR(F##b1, BB, (ST) * 24576 + 8192 + 2048);                    \
    DSR(F##b2, BB, (ST) * 24576 + 8192 + 4096);                    \
    DSR(F##b3, BB, (ST) * 24576 + 8192 + 6144);                    \
  }
#define FR_WAIT(F, N) asm volatile("s_waitcnt lgkmcnt(" #N ")" : "+v"(F##a0), "+v"(F##a1), "+v"(F##b0), "+v"(F##b1), "+v"(F##b2), "+v"(F##b3)::"memory")
#define FR_MFMA(F)                                                 \
  {                                                                \
    acc[0][0] = MFMA32(F##a0, F##b0, acc[0][0]);                   \
    acc[1][0] = MFMA32(F##a1, F##b0, acc[1][0]);                   \
    acc[0][1] = MFMA32(F##a0, F##b1, acc[0][1]);                   \
    acc[1][1] = MFMA32(F##a1, F##b1, acc[1][1]);                   \
    acc[0][2] = MFMA32(F##a0, F##b2, acc[0][2]);                   \
    acc[1][2] = MFMA32(F##a1, F##b2, acc[1][2]);                   \
    acc[0][3] = MFMA32(F##a0, F##b3, acc[0][3]);                   \
    acc[1][3] = MFMA32(F##a1, F##b3, acc[1][3]);                   \
    if (PROBE_DBL) {                                               \
      dum0 = MFMA32(F##a1, F##b0, dum0); dum1 = MFMA32(F##a0, F##b1, dum1);  \
      dum0 = MFMA32(F##a1, F##b2, dum0); dum1 = MFMA32(F##a0, F##b3, dum1);  \
      dum0 = MFMA32(F##a0, F##b0, dum0); dum1 = MFMA32(F##a1, F##b1, dum1);  \
      dum0 = MFMA32(F##a0, F##b2, dum0); dum1 = MFMA32(F##a1, F##b3, dum1);  \
    }                                                              \
  }
DI void gemm_kloop_wide(f32x16 (&acc)[2][4], const bf16_t* __restrict__ A, int lda, const bf16_t* __restrict__ Bt, int ldb, int K, int m0, int n0,
                        unsigned char* smem) {
  const int tid = TIDX, lane = tid & 63, wave = tid >> 6, r = lane & 31, h = lane >> 5, wm = wave >> 1, wn = wave & 1;
  const int drow = wave * 16 + (lane >> 2);
  const int csw = (lane & 3) ^ ((lane >> 4) & 3);
  const bf16_t* gA = A + (size_t)(m0 + drow) * lda + csw * 8;
  const bf16_t* gB = Bt + (size_t)(n0 + drow) * ldb + csw * 8;
  const int ldst = wave * 1024 + lane * 16;
  const int rsw = (r >> 2) & 3;
  const unsigned lbase = (unsigned)(size_t)smem;
  const unsigned aA0 = lbase + (wm * 64 + r) * 64 + ((0 + h) ^ rsw) * 16, aA1 = lbase + (wm * 64 + r) * 64 + ((2 + h) ^ rsw) * 16;
  const unsigned bB0 = lbase + (wn * 128 + r) * 64 + ((0 + h) ^ rsw) * 16, bB1 = lbase + (wn * 128 + r) * 64 + ((2 + h) ^ rsw) * 16;
#define GW_ISSUE(ST, KO)                                                                                                        \
  {                                                                                                                             \
    _Pragma("unroll") for (int i = 0; i < 2; ++i)                                                                               \
        __builtin_amdgcn_global_load_lds((const unsigned*)(gA + (size_t)(64 * i) * lda + (KO)),                                 \
                                         (unsigned*)(smem + (ST) * 24576 + i * 4096 + ldst), 16, 0, 0);                         \
    _Pragma("unroll") for (int i = 0; i < 4; ++i)                                                                               \
        __builtin_amdgcn_global_load_lds((const unsigned*)(gB + (size_t)(64 * i) * ldb + (KO)),                                 \
                                         (unsigned*)(smem + (ST) * 24576 + 8192 + i * 4096 + ldst), 16, 0, 0);                  \
  }
  bf16x8 Pa0, Pa1, Pb0, Pb1, Pb2, Pb3, Qa0, Qa1, Qb0, Qb1, Qb2, Qb3;
  f32x16 dum0, dum1;
  _Pragma("unroll") for (int i = 0; i < 16; ++i) { dum0[i] = 0.f; dum1[i] = 0.f; }
#define GW_STEP(KIDX, S, S1, S2)                                                                                                \
  {                                                                                                                             \
    asm volatile("s_waitcnt vmcnt(0)" ::: "memory");                                 \
    __builtin_amdgcn_s_barrier();                               \
    if ((KIDX) + 2 < nk) GW_ISSUE(S2, ((KIDX) + 2) * 32)                                                                        \
    FR_READ(Q, S, aA1, bB1)                                                                           \
    FR_WAIT(P, 6);                                               \
    FR_MFMA(P)                                                                                                                  \
    FR_WAIT(Q, 0);                                                                                                              \
    if ((KIDX) + 1 < nk) FR_READ(P, S1, aA0, bB0)                                                    \
    FR_MFMA(Q)                                                                                                                  \
  }
  const int nk = K >> 5;
  asm volatile("s_waitcnt vmcnt(0) lgkmcnt(0)" ::: "memory");
  __builtin_amdgcn_s_barrier();
  GW_ISSUE(0, 0)
  GW_ISSUE(1, 32)
  asm volatile("s_waitcnt vmcnt(6)" ::: "memory");
  __builtin_amdgcn_s_barrier();
  FR_READ(P, 0, aA0, bB0)
  for (int k = 0; k < nk; k += 3) {
    GW_STEP(k, 0, 1, 2)
    if (k + 1 < nk) GW_STEP(k + 1, 1, 2, 0)
    if (k + 2 < nk) GW_STEP(k + 2, 2, 0, 1)
  }
#undef GW_ISSUE
#undef GW_STEP
  if (PROBE_DBL) { _Pragma("unroll") for (int i = 0; i < 16; ++i) acc[0][0][i] += 0.f * (dum0[i] + dum1[i]); }
}
template <int BN = 128, class F>
DI void for_tiles(int ntm, int ntn, F f, int m_base = 0) {
  constexpr int GM = 8, GN = 8;
  const int xcd = blockIdx.x & 7, slot = blockIdx.x >> 3, nslot = gridDim.x >> 3;
  const int nmx = ntm >> 3;
  const int per = nmx * ntn;
  const int fullN = ntn / GN, fullM = nmx / GM;
  for (int L = slot; L < per; L += nslot) {
    int ng = L / (nmx * GN), gn = GN;
    if (ng >= fullN) { ng = fullN; gn = ntn - fullN * GN; }
    const int rem = L - ng * (nmx * GN);
    int mg = rem / (GM * gn), gm = GM;
    if (mg >= fullM) { mg = fullM; gm = nmx - fullM * GM; }
    const int rem2 = rem - mg * (GM * gn);
    const int mi = rem2 % gm, ni = rem2 / gm;
    const int tn = ng * GN + ni, tm = xcd + 8 * (mg * GM + mi);
    f(m_base + tm * 128, tn * BN, tn);
  }
}
struct RowInfo { int b, pos, kpos, L; bool lat; };
DI RowInfo row_info(int row) {
  RowInfo ri;
  if (row < M_LAT) { ri.b = row >> 12; ri.pos = row & 4095; ri.kpos = ri.pos; ri.lat = true; ri.L = 4096; }
  else { int q = row - M_LAT; ri.b = q >> 8; ri.pos = q & 255; ri.kpos = 4096 + ri.pos; ri.lat = false; ri.L = 256; }
  return ri;
}

DI int map_col(int mode, int n) {
  if (mode == 0) return n;
  if (mode == 1) { const int isb = n >= DFF; const int j = isb ? n - DFF : n; return (j >> 5) * 64 + (isb ? 32 : 0) + (j & 31); }
  if (n >= 1120) return n - 1120;
  if (n >= 864) return n - 864 + 1024;
  if (n >= 672) return n - 672 + 1664;
  if (n >= 416) return n - 416 + 768;
  if (n >= 288) return n - 288 + 1408;
  if (n >= 160) return n - 160 + 1280;
  if (n >= 128) return n - 128 + 1856;
  return n + 1536;
}
DI void conv_tile(const float* __restrict__ src, bf16_t* __restrict__ dst, const float* __restrict__ kscale, int K, int N, int mode, int t, float* tile  ) {
  const int ntn = (N + 63) >> 6;
  const int kt = t / ntn, nt = t % ntn, k0 = kt * 64, n0 = nt * 64, tid = TIDX;
  float vv[16];
#pragma unroll
  for (int i = 0; i < 16; ++i) {
    const int idx = tid + 256 * i, kk = idx >> 6, nn = idx & 63;
    vv[i] = (n0 + nn < N) ? src[(size_t)(k0 + kk) * N + n0 + nn] : 0.f;
  }
#pragma unroll
  for (int i = 0; i < 16; ++i) {
    const int idx = tid + 256 * i, kk = idx >> 6, nn = idx & 63;
    float v = vv[i];
    if (kscale) v *= kscale[k0 + kk];
    tile[kk * 65 + nn] = v;
  }
  __syncthreads();
#pragma unroll 4
  for (int i = 0; i < 8; ++i) {
    const int idx = tid + 256 * i, nn = idx >> 5, kp = idx & 31;
    if (n0 + nn < N) {
      const int dr = map_col(mode, n0 + nn);
      *(unsigned*)(dst + (size_t)dr * K + k0 + 2 * kp) = pk2(tile[(2 * kp) * 65 + nn], tile[(2 * kp + 1) * 65 + nn]);
    }
  }
  __syncthreads();
}
DI void phase_convert(const P& p, int layer, unsigned char* smem) {
  unsigned char* ws = p.ws;
  const size_t l = (size_t)layer;
  const int tid = TIDX;
#define CONV_JOB(SRC, OFF, KS, KK, NN, MODE)                                                              \
  {                                                                                                       \
    const int ntiles_ = ((KK) >> 6) * (((NN) + 63) >> 6);                                                 \
    for (int t = blockIdx.x; t < ntiles_; t += gridDim.x) conv_tile((SRC), (bf16_t*)(ws + (OFF)), (KS), (KK), (NN), (MODE), t, (float*)smem); \
  }
  CONV_JOB(p.in[I_UP1] + l * 1024 * 5632, O_WUP1, nullptr, 1024, 5632, 1)
  CONV_JOB(p.in[I_DN1] + l * 2816 * 1024, O_WDN1, nullptr, 2816, 1024, 0)
  CONV_JOB(p.in[I_UP2] + l * 1024 * 5632, O_WUP2, nullptr, 1024, 5632, 1)
  CONV_JOB(p.in[I_DN2] + l * 2816 * 1024, O_WDN2, nullptr, 2816, 1024, 0)
  CONV_JOB(p.in[I_WIN] + l * 1024 * 1888, O_WIN, nullptr, 1024, 1888, 2)
#pragma unroll 1
  for (int i = 0; i < 4; ++i) CONV_JOB(p.in[I_WGATE] + (l * 4 + i) * 1024 * 1024, O_WGATE + (size_t)i * 1024 * 1024 * 2, nullptr, 1024, 1024, 0)
  CONV_JOB(p.in[I_BRMLA] + l * 256 * 1024, O_WBR + (size_t)0 * 1024 * 256 * 2, nullptr, 256, 1024, 0)
  CONV_JOB(p.in[I_BRHY] + l * 256 * 1024, O_WBR + (size_t)1 * 1024 * 256 * 2, nullptr, 256, 1024, 0)
  CONV_JOB(p.in[I_BRSWA] + l * 256 * 1024, O_WBR + (size_t)2 * 1024 * 256 * 2, nullptr, 256, 1024, 0)
  CONV_JOB(p.in[I_BRS5] + l * 256 * 1024, O_WBR + (size_t)3 * 1024 * 256 * 2, nullptr, 256, 1024, 0)
  CONV_JOB(p.in[I_WOUT] + l * 1024 * 1024, O_WOUT, nullptr, 1024, 1024, 0)
  CONV_JOB(p.in[I_WUKV] + l * 128 * 512, O_WUKV, p.in[I_KVNORM] + l * 128, 128, 512, 0)
  CONV_JOB(p.in[I_WUQ] + l * 192 * 384, O_WUQ, p.in[I_QNORM] + l * 192, 192, 384, 0)
  CONV_JOB(p.in[I_GLUW] + l * 256 * 256, O_WGLU, nullptr, 256, 256, 0)
#undef CONV_JOB
  {
    unsigned* z = (unsigned*)(ws + O_WIN + (size_t)1888 * 1024 * 2);
    for (int i = blockIdx.x * NT + tid; i < 32 * 1024 / 2; i += gridDim.x * NT) z[i] = 0u;
  }
}

DI void phase_modulation(const P& p, unsigned char* smem) {
  float* sS = (float*)smem;
  float* sR = sS + 9 * 1024;
  const int tid = TIDX, lane = tid & 63, wave = tid >> 6;
  float* MOD = (float*)(p.ws + O_MOD);
  bool filled = false;
  for (int it = blockIdx.x; it < 2 * 144; it += gridDim.x) {
    if (!filled) {
      for (int i = tid; i < 9 * 1024; i += NT) {
        const int v = i >> 10, k = i & 1023;
        const float x = v < 8 ? p.in[I_C][v * 1024 + k] : p.in[I_CCTX][k];
        sS[i] = siluf_(x);
      }
      filled = true;
      __syncthreads();
    }
    const int layer = it / 144, col = (it % 144) * 64 + lane;
    const float* w = p.in[I_WADA] + (size_t)layer * 1024 * 9216 + col;
    float acc[9];
#pragma unroll
    for (int v = 0; v < 9; ++v) acc[v] = 0.f;
#pragma unroll 8
    for (int k = wave * 256; k < wave * 256 + 256; ++k) {
      const float wv = w[(size_t)k * 9216];
#pragma unroll
      for (int v = 0; v < 9; ++v) acc[v] += sS[v * 1024 + k] * wv;
    }
#pragma unroll
    for (int v = 0; v < 9; ++v) sR[(wave * 9 + v) * 64 + lane] = acc[v];
    __syncthreads();
    for (int i = tid; i < 9 * 64; i += NT) {
      const int v = i >> 6, c = i & 63;
      const float s = sR[(0 * 9 + v) * 64 + c] + sR[(1 * 9 + v) * 64 + c] + sR[(2 * 9 + v) * 64 + c] + sR[(3 * 9 + v) * 64 + c];
      const int cc = (it % 144) * 64 + c;
      MOD[((size_t)layer * 9 + v) * 9216 + cc] = s + p.in[I_BADA][(size_t)layer * 9216 + cc];
    }
    __syncthreads();
  }
  __syncthreads();
}

DI size_t h2_off(int layer, int kind) { return ((size_t)layer * (4096 + 256) + (kind ? 4096 : 0)) * 64; }
DI void phase_h2(const P& p) {
  const int tid = TIDX, lane = tid & 63, wave = tid >> 6;
  float* H2 = (float*)(p.ws + O_H2);
  const int rows_per_layer = 4096 + 256;
  for (int rr = blockIdx.x * 4 + wave; rr < 2 * rows_per_layer; rr += gridDim.x * 4) {
    const int layer = rr / rows_per_layer, q = rr % rows_per_layer;
    const int kind = q >= 4096, t = kind ? q - 4096 : q, L = kind ? 256 : 4096;
    float z = 0.f;
    if (lane == 0) z = (float)t / (float)(L - 1);
    else if (lane < 33) {
      const int j = (lane - 1) & 15;
      const float w = (6.2831855f * (float)t) / (float)L;
      const float fr = 1e-4f + (float)j * ((15.0f - 1e-4f) / 15.0f);
      const float ang = w * fr;
      float s, c; sincos_f(ang, s, c);
      z = lane <= 16 ? c : -s;
    }
    const float* w1 = p.in[I_HW1] + (size_t)layer * 33 * 64;
    const float* w2 = p.in[I_HW2] + (size_t)layer * 64 * 64;
    float a = p.in[I_HB1][layer * 64 + lane];
    for (int i = 0; i < 33; ++i) a += __shfl(z, i) * w1[i * 64 + lane];
    const float h1 = sin_acc(p.in[I_HFREQ][(layer * 2 + 0) * 64 + lane] * a);
    float a2 = p.in[I_HB2][layer * 64 + lane];
    for (int i = 0; i < 64; ++i) a2 += __shfl(h1, i) * w2[i * 64 + lane];
    const float h2 = sin_acc(p.in[I_HFREQ][(layer * 2 + 1) * 64 + lane] * a2);
    H2[h2_off(layer, kind) + (size_t)t * 64 + lane] = h2;
  }
}

DI void phase_rope(const P& p) {
  f32x2* RM = (f32x2*)(p.ws + O_ROPEM);
  f32x2* RW = (f32x2*)(p.ws + O_ROPEW);
  const int g0 = blockIdx.x * NT + TIDX, gs = gridDim.x * NT;
  for (int i = g0; i < 4096 * 48; i += gs) {
    const int pos = i / 48, e = i % 48;
    const float rowf = (float)(pos >> 6), colf = (float)(pos & 63);
    float ang;
    if (e < 16) { const int f = e & 7; const float fr = fast_exp(-(float)f / 8.0f * 9.210340371976184f); ang = (e < 8 ? rowf : colf) * fr; }
    else { const int e2 = e - 16, f = e2 & 15; const float fr = fast_exp(-(float)f / 16.0f * 9.210340371976184f); ang = (e2 < 16 ? rowf : colf) * fr; }
    float s, c; sincos_f(ang, s, c);
    f32x2 v = {c, s};
    if (e < 16) RM[pos * 16 + e] = v; else RW[pos * 32 + (e - 16)] = v;
  }
}

DI f32x2 cmul(f32x2 a, f32x2 b) { f32x2 r = {a.x * b.x - a.y * b.y, a.x * b.y + a.y * b.x}; return r; }
DI f32x2 cmulc(f32x2 a, f32x2 b) { f32x2 r = {a.x * b.x + a.y * b.y, a.y * b.x - a.x * b.y}; return r; }
DI f32x2 mul_mi(f32x2 a) { f32x2 r = {a.y, -a.x}; return r; }
DI f32x2 mul_pi(f32x2 a) { f32x2 r = {-a.y, a.x}; return r; }
#define PH(i) ((i) + ((i) >> 4))
DI void fft16_dif_tail(f32x2 (&x)[16]) {
  const float C1 = 0.92387953251f, S1 = 0.38268343236f, R2 = 0.70710678118f;
  const f32x2 T[4] = {{1.f, 0.f}, {C1, -S1}, {R2, -R2}, {S1, -C1}};
  const f32x2 T2[4] = {{1.f, 0.f}, {R2, -R2}, {0.f, -1.f}, {-R2, -R2}};
#pragma unroll
  for (int j = 0; j < 4; ++j) {
    const f32x2 a0 = x[j], a1 = x[j + 4], a2 = x[j + 8], a3 = x[j + 12];
    const f32x2 b0 = a0 + a2, b2 = cmul(a0 - a2, T[j]), b1 = a1 + a3, b3 = mul_mi(cmul(a1 - a3, T[j]));
    x[j] = b0 + b1; x[j + 4] = cmul(b0 - b1, T2[j]); x[j + 8] = b2 + b3; x[j + 12] = cmul(b2 - b3, T2[j]);
  }
#pragma unroll
  for (int k = 0; k < 4; ++k) {
    const f32x2 a0 = x[4 * k], a1 = x[4 * k + 1], a2 = x[4 * k + 2], a3 = x[4 * k + 3];
    const f32x2 b0 = a0 + a2, b2 = a0 - a2, b1 = a1 + a3, b3 = mul_mi(a1 - a3);
    x[4 * k] = b0 + b1; x[4 * k + 1] = b0 - b1; x[4 * k + 2] = b2 + b3; x[4 * k + 3] = b2 - b3;
  }
}
DI void fft16_dit_head(f32x2 (&x)[16]) {
  const float C1 = 0.92387953251f, S1 = 0.38268343236f, R2 = 0.70710678118f;
  const f32x2 T[4] = {{1.f, 0.f}, {C1, -S1}, {R2, -R2}, {S1, -C1}};
  const f32x2 T2[4] = {{1.f, 0.f}, {R2, -R2}, {0.f, -1.f}, {-R2, -R2}};
#pragma unroll
  for (int k = 0; k < 4; ++k) {
    const f32x2 c0 = x[4 * k], c1 = x[4 * k + 1], c2 = x[4 * k + 2], c3 = x[4 * k + 3];
    const f32x2 b0 = c0 + c1, b1 = c0 - c1, b2 = c2 + c3, b3 = c2 - c3;
    const f32x2 up = mul_pi(b3);
    x[4 * k] = b0 + b2; x[4 * k + 2] = b0 - b2; x[4 * k + 1] = b1 + up; x[4 * k + 3] = b1 - up;
  }
#pragma unroll
  for (int j = 0; j < 4; ++j) {
    const f32x2 c0 = x[j], c1 = x[j + 4], c2 = x[j + 8], c3 = x[j + 12];
    const f32x2 t = cmulc(c1, T2[j]), tp = cmulc(c3, T2[j]);
    const f32x2 b0 = c0 + t, b1 = c0 - t, b2 = c2 + tp, b3 = c2 - tp;
    const f32x2 u = cmulc(b2, T[j]), up = mul_pi(cmulc(b3, T[j]));
    x[j] = b0 + u; x[j + 8] = b0 - u; x[j + 4] = b1 + up; x[j + 12] = b1 - up;
  }
}
DI void fft_dif(f32x2* W, int N, int logN) {
  const int tid = TIDX;
  int s = logN - 1;
  {
    const int half = 1 << s, hp = half + (half >> 4);
    const float inv = 1.0f / (float)(2 * half);
    for (int i = tid; i < (N >> 1); i += NT) {
      const int j = i & (half - 1), base = PH(((i >> s) << (s + 1)) + j);
      const f32x2 a = W[base], b = W[base + hp];
      const float rev = (float)j * inv;
      const f32x2 w = {__builtin_amdgcn_cosf(rev), -__builtin_amdgcn_sinf(rev)};
      W[base] = a + b;
      W[base + hp] = cmul(a - b, w);
    }
    __syncthreads();
    --s;
  }
  for (; s >= 5; s -= 2) {
    const int half = 1 << s, quarter = half >> 1, hp = half + (half >> 4), qp = quarter + (quarter >> 4);
    const float inv = 1.0f / (float)(2 * half);
    for (int i = tid; i < (N >> 2); i += NT) {
      const int j = i & (quarter - 1), i0 = PH(((i >> (s - 1)) << (s + 1)) + j);
      const f32x2 a0 = W[i0], a1 = W[i0 + qp], a2 = W[i0 + hp], a3 = W[i0 + hp + qp];
      const float rev = (float)j * inv;
      const f32x2 w1 = {__builtin_amdgcn_cosf(rev), -__builtin_amdgcn_sinf(rev)};
      const f32x2 w2 = cmul(w1, w1);
      const f32x2 b0 = a0 + a2, b2 = cmul(a0 - a2, w1), b1 = a1 + a3, b3 = mul_mi(cmul(a1 - a3, w1));
      W[i0] = b0 + b1;
      W[i0 + qp] = cmul(b0 - b1, w2);
      W[i0 + hp] = b2 + b3;
      W[i0 + hp + qp] = cmul(b2 - b3, w2);
    }
    __syncthreads();
  }
  for (int gq = tid; gq < (N >> 4); gq += NT) {
    f32x2 x[16];
#pragma unroll
    for (int e = 0; e < 16; ++e) x[e] = W[17 * gq + e];
    fft16_dif_tail(x);
#pragma unroll
    for (int e = 0; e < 16; ++e) W[17 * gq + e] = x[e];
  }
  __syncthreads();
}
DI void fft_dit_inv(f32x2* W, int N, int logN) {
  const int tid = TIDX;
  for (int gq = tid; gq < (N >> 4); gq += NT) {
    f32x2 x[16];
#pragma unroll
    for (int e = 0; e < 16; ++e) x[e] = W[17 * gq + e];
    fft16_dit_head(x);
#pragma unroll
    for (int e = 0; e < 16; ++e) W[17 * gq + e] = x[e];
  }
  __syncthreads();
  int s = 5;
  for (; s < logN - 1; s += 2) {
    const int half = 1 << s, quarter = half >> 1, hp = half + (half >> 4), qp = quarter + (quarter >> 4);
    const float inv = 1.0f / (float)(2 * half);
    for (int i = tid; i < (N >> 2); i += NT) {
      const int j = i & (quarter - 1), i0 = PH(((i >> (s - 1)) << (s + 1)) + j);
      const f32x2 c0 = W[i0], c1 = W[i0 + qp], c2 = W[i0 + hp], c3 = W[i0 + hp + qp];
      const float rev = (float)j * inv;
      const f32x2 w1 = {__builtin_amdgcn_cosf(rev), -__builtin_amdgcn_sinf(rev)};
      const f32x2 w2 = cmul(w1, w1);
      const f32x2 t = cmulc(c1, w2), tp = cmulc(c3, w2);
      const f32x2 b0 = c0 + t, b1 = c0 - t, b2 = c2 + tp, b3 = c2 - tp;
      const f32x2 u = cmulc(b2, w1), up = mul_pi(cmulc(b3, w1));
      W[i0] = b0 + u;
      W[i0 + hp] = b0 - u;
      W[i0 + qp] = b1 + up;
      W[i0 + hp + qp] = b1 - up;
    }
    __syncthreads();
  }
  {
    const int sl = logN - 1, half = 1 << sl, hp = half + (half >> 4);
    const float inv = 1.0f / (float)(2 * half);
    for (int i = tid; i < (N >> 1); i += NT) {
      const int j = i & (half - 1), base = PH(((i >> sl) << (sl + 1)) + j);
      const f32x2 a = W[base], b = W[base + hp];
      const float rev = (float)j * inv;
      const f32x2 w = {__builtin_amdgcn_cosf(rev), __builtin_amdgcn_sinf(rev)};
      const f32x2 t = cmul(b, w);
      W[base] = a + t;
      W[base + hp] = a - t;
    }
    __syncthreads();
  }
}

DI void kf_item(const P& p, int layer, int kind, int c, int o, unsigned char* smem) {
  const int tid = TIDX;
  const int L = kind ? 256 : 4096, N = 2 * L, logN = kind ? 9 : 13;
  f32x2* W = (f32x2*)smem;
  float* sW3 = (float*)(smem + 69632);
  const float* w3 = p.in[I_HW3] + (size_t)layer * 64 * 1024;
  if (tid < 128) { const int dir = tid >> 6, j = tid & 63; sW3[tid] = w3[(size_t)j * 1024 + o * 512 + dir * 256 + c]; }
  __syncthreads();
  const float* H2 = (const float*)(p.ws + O_H2) + h2_off(layer, kind);
  const float lo = -3.0701134573253942f, hi = -15.350567286626971f;
  const float delta = fabsf(lo + (float)c * ((hi - lo) / 255.0f));
  const float invN = 1.0f / (float)N;
  for (int n = tid; n < N; n += NT) {
    float val = 0.f;
    if (n != L) {
      const int dir = n > L, t = dir ? N - n : n;
      const float4* hr = (const float4*)(H2 + (size_t)t * 64);
      const float* wv = sW3 + dir * 64;
      float acc = 0.f;
#pragma unroll
      for (int q = 0; q < 16; ++q) { const float4 hv = hr[q]; acc += hv.x * wv[4 * q] + hv.y * wv[4 * q + 1] + hv.z * wv[4 * q + 2] + hv.w * wv[4 * q + 3]; }
      const float tl = (float)t / (float)(L - 1);
      val = acc * fast_exp(-tl * delta) * invN;
    }
    f32x2 v = {val, 0.f};
    W[PH(n)] = v;
  }
  __syncthreads();
  fft_dif(W, N, logN);
  f32x2* KF = kind ? (f32x2*)(p.ws + O_KF1) + (size_t)(c * 2 + o) * 512 : (f32x2*)(p.ws + O_KF0) + (size_t)(c * 2 + o) * 8192;
  for (int n = tid; n < N; n += NT) KF[n] = W[PH(n)];
  __syncthreads();
}
DI void phase_kf(const P& p, int layer, bool with_ctx, unsigned char* smem) {
  const int total = 512 + (with_ctx ? 512 : 0);
  for (int it = blockIdx.x; it < total; it += gridDim.x) {
    const int kind = it >= 512, q = it & 511;
    kf_item(p, layer, kind, q >> 1, q & 1, smem);
  }
}

DI void phase_rows(const P& p, int Mrows, int mode, int layer, int sub, float resw, bool from_input, bool has_next, int nl, int nj, bool zero_rowss) {
  const int tid = TIDX, lane = tid & 63, wave = tid >> 6;
  const float* MOD = (const float*)(p.ws + O_MOD);
  const bf16_t* F = (const bf16_t*)(p.ws + O_F);
  bf16_t* U = (bf16_t*)(p.ws + O_U);
  float* XC = (float*)(p.ws + O_XC);
  float* ROWSS = (float*)(p.ws + O_ROWSS);
  for (int row0 = (blockIdx.x * 4 + wave) * 2; row0 < Mrows; row0 += gridDim.x * 8) {
    if (mode == 2) { if (lane < 2) { ROWSS[row0 + lane] = 0.f; ROWSS[M_ALL + row0 + lane] = 0.f; } continue; }
    const float* xin[2]; float* X[2]; int midx[2];
#pragma unroll
    for (int rr = 0; rr < 2; ++rr) {
      const int row = row0 + rr;
      const bool lat = row < M_LAT;
      midx[rr] = lat ? (row >> 12) : 8;
      xin[rr] = lat ? p.in[I_X] + (size_t)row * 1024 : p.in[I_CTX] + (size_t)(row - M_LAT) * 1024;
      X[rr] = lat ? p.out + (size_t)row * 1024 : XC + (size_t)(row - M_LAT) * 1024;
    }
    float4 xv[2][4];
    if (mode == 0) {
#pragma unroll
      for (int rr = 0; rr < 2; ++rr)
#pragma unroll
        for (int c4 = 0; c4 < 4; ++c4) xv[rr][c4] = *(const float4*)(xin[rr] + c4 * 256 + lane * 4);
    } else {
      uint2 raw[2][4];
      float4 xold[2][4];
#pragma unroll
      for (int rr = 0; rr < 2; ++rr)
#pragma unroll
        for (int c4 = 0; c4 < 4; ++c4) {
          raw[rr][c4] = *(const uint2*)(F + (size_t)(row0 + rr) * 1024 + c4 * 256 + lane * 4);
          xold[rr][c4] = *(const float4*)((from_input ? xin[rr] : X[rr]) + c4 * 256 + lane * 4);
        }
      const float* gp = p.in[I_NPOST] + ((size_t)layer * 3 + sub) * 1024;
#pragma unroll
      for (int rr = 0; rr < 2; ++rr) {
        const float* mod = MOD + ((size_t)layer * 9 + midx[rr]) * 9216 + (3 * sub + 2) * 1024;
        float4 fv[4];
        float ss = 0.f;
#pragma unroll
        for (int c4 = 0; c4 < 4; ++c4) {
          fv[c4].x = __uint_as_float(raw[rr][c4].x << 16); fv[c4].y = __uint_as_float(raw[rr][c4].x & 0xffff0000u);
          fv[c4].z = __uint_as_float(raw[rr][c4].y << 16); fv[c4].w = __uint_as_float(raw[rr][c4].y & 0xffff0000u);
          ss += fv[c4].x * fv[c4].x + fv[c4].y * fv[c4].y + fv[c4].z * fv[c4].z + fv[c4].w * fv[c4].w;
        }
        ss = wave_sum(ss);
        const float rstd = rsqrtf(ss * (1.0f / 1024.0f) + EPS);
#pragma unroll
        for (int c4 = 0; c4 < 4; ++c4) {
          const int col = c4 * 256 + lane * 4;
          const float4 g = *(const float4*)(gp + col);
          const float4 mg = *(const float4*)(mod + col);
          xv[rr][c4].x = xold[rr][c4].x + resw * mg.x * (fv[c4].x * rstd * g.x);
          xv[rr][c4].y = xold[rr][c4].y + resw * mg.y * (fv[c4].y * rstd * g.y);
          xv[rr][c4].z = xold[rr][c4].z + resw * mg.z * (fv[c4].z * rstd * g.z);
          xv[rr][c4].w = xold[rr][c4].w + resw * mg.w * (fv[c4].w * rstd * g.w);
          *(float4*)(X[rr] + col) = xv[rr][c4];
        }
      }
    }
    if (has_next) {
      const float* gpre = p.in[I_NPRE] + ((size_t)nl * 3 + nj) * 1024;
#pragma unroll
      for (int rr = 0; rr < 2; ++rr) {
        float ss = 0.f;
#pragma unroll
        for (int c4 = 0; c4 < 4; ++c4) ss += xv[rr][c4].x * xv[rr][c4].x + xv[rr][c4].y * xv[rr][c4].y + xv[rr][c4].z * xv[rr][c4].z + xv[rr][c4].w * xv[rr][c4].w;
        ss = wave_sum(ss);
        const float rstd = rsqrtf(ss * (1.0f / 1024.0f) + EPS);
        const float* modn = MOD + ((size_t)nl * 9 + midx[rr]) * 9216;
#pragma unroll
        for (int c4 = 0; c4 < 4; ++c4) {
          const int col = c4 * 256 + lane * 4;
          const float4 g = *(const float4*)(gpre + col);
          const float4 sc = *(const float4*)(modn + (3 * nj + 1) * 1024 + col);
          const float4 sh = *(const float4*)(modn + (3 * nj) * 1024 + col);
          const float u0 = xv[rr][c4].x * rstd * g.x * (1.f + sc.x) + sh.x;
          const float u1 = xv[rr][c4].y * rstd * g.y * (1.f + sc.y) + sh.y;
          const float u2 = xv[rr][c4].z * rstd * g.z * (1.f + sc.z) + sh.z;
          const float u3 = xv[rr][c4].w * rstd * g.w * (1.f + sc.w) + sh.w;
          uint2 o; o.x = pk2(u0, u1); o.y = pk2(u2, u3);
          *(uint2*)(U + (size_t)(row0 + rr) * 1024 + col) = o;
        }
      }
    }
    if (zero_rowss && lane < 2) { ROWSS[row0 + lane] = 0.f; ROWSS[M_ALL + row0 + lane] = 0.f; }
  }
}

#define EPI_COORDS                                                                                      \
  const int tid = TIDX, lane = tid & 63, wave = tid >> 6, r = lane & 31, h = lane >> 5, wm = wave >> 1, wn = wave & 1; \
  (void)tid; (void)lane; (void)wave; (void)r; (void)h; (void)wm; (void)wn;

DI void phase_ffn_up(const P& p, int Mrows, size_t off_w, unsigned char* smem) {
  const bf16_t* U = (const bf16_t*)(p.ws + O_U);
  const bf16_t* W = (const bf16_t*)(p.ws + off_w);
  bf16_t* ACT = (bf16_t*)(p.ws + O_ACT);
  for_tiles<256>(Mrows >> 7, 22, [&](int m0, int n0, int tn) __attribute__((always_inline)) {
    f32x16 acc[2][4];
    zero_acc<4>(acc);
    gemm_kloop_wide(acc, U, 1024, W, 1024, 1024, m0, n0, smem);
    EPI_COORDS
#pragma unroll
    for (int j = 0; j < 2; ++j) {
      const int col = tn * 128 + wn * 64 + j * 32 + r;
#pragma unroll
      for (int mi = 0; mi < 2; ++mi)
#pragma unroll
        for (int i = 0; i < 16; ++i) {
          const int row = m0 + wm * 64 + mi * 32 + crow(i, h);
          const float a = acc[mi][2 * j][i], b = acc[mi][2 * j + 1][i];
          ACT[(size_t)row * DFF + col] = f2bf(siluf_(a) * b);
        }
    }
  });
}
DI void phase_gemm_plain_bf16(const P& p, int Mrows, const bf16_t* A, int K, const bf16_t* W, bf16_t* OUT, int N, unsigned char* smem) {
  (void)p;
  const int Mwide = Mrows < M_LAT ? Mrows : M_LAT;
  for_tiles<256>(Mwide >> 7, N >> 8, [&](int m0, int n0, int tn) __attribute__((always_inline)) {
    (void)tn;
    f32x16 acc[2][4];
    zero_acc<4>(acc);
    gemm_kloop_wide(acc, A, K, W, K, K, m0, n0, smem);
    EPI_COORDS
#pragma unroll
    for (int mi = 0; mi < 2; ++mi)
#pragma unroll
      for (int ni = 0; ni < 4; ++ni)
#pragma unroll
        for (int i = 0; i < 16; ++i) {
          const int row = m0 + wm * 64 + mi * 32 + crow(i, h), col = n0 + wn * 128 + ni * 32 + r;
          OUT[(size_t)row * N + col] = f2bf(acc[mi][ni][i]);
        }
  });
  if (Mrows > Mwide) {
    for_tiles<64>((Mrows - Mwide) >> 7, N >> 6, [&](int m0, int n0, int tn) __attribute__((always_inline)) {
      (void)tn;
      f32x16 acc[2][1];
      zero_acc<1>(acc);
      gemm_kloop<1>(acc, A, K, W, K, K, m0, n0, smem);
      EPI_COORDS
#pragma unroll
      for (int mi = 0; mi < 2; ++mi)
#pragma unroll
        for (int i = 0; i < 16; ++i) {
          const int row = m0 + wm * 64 + mi * 32 + crow(i, h), col = n0 + wn * 32 + r;
          OUT[(size_t)row * N + col] = f2bf(acc[mi][0][i]);
        }
    }, Mwide);
  }
}

DI void win_epilogue(const P& p, int m0, int tn, int wn, f32x16 (&acc)[2][2]) {
  unsigned char* ws = p.ws;
  bf16_t* HYT = (bf16_t*)(ws + O_HYT);
  float* S5U = (float*)(ws + O_S5U);
  bf16_t* QSWA = (bf16_t*)(ws + O_QSWA);
  bf16_t* KSWA = (bf16_t*)(ws + O_KSWA);
  bf16_t* VSWAT = (bf16_t*)(ws + O_VSWAT);
  bf16_t* CKV = (bf16_t*)(ws + O_CKV);
  bf16_t* CQ = (bf16_t*)(ws + O_CQ);
  bf16_t* KMLA = (bf16_t*)(ws + O_KMLA);
  float* ROWSS = (float*)(ws + O_ROWSS);
  const f32x2* RM = (const f32x2*)(ws + O_ROPEM);
  const f32x2* RW = (const f32x2*)(ws + O_ROPEW);
  const float qscale = 0.125f * LOG2E;
  const int tid = TIDX, lane = tid & 63, wave = tid >> 6, r = lane & 31, h = lane >> 5, wm = wave >> 1;
    const RowInfo t0 = row_info(m0);
  if (tn < 6) {
    bf16_t* base = HYT + (t0.lat ? (size_t)t0.b * 768 * 4096 : HYT_LATSZ + (size_t)t0.b * 768 * 256);
#pragma unroll
    for (int mi = 0; mi < 2; ++mi)
#pragma unroll
      for (int ni = 0; ni < 2; ++ni) {
        const int ch = tn * 128 + wn * 64 + ni * 32 + r;
#pragma unroll
        for (int g = 0; g < 4; ++g) {
          const int pos = t0.pos + wm * 64 + mi * 32 + 8 * g + 4 * h;
          uint2 o; o.x = pk2(acc[mi][ni][4 * g], acc[mi][ni][4 * g + 1]); o.y = pk2(acc[mi][ni][4 * g + 2], acc[mi][ni][4 * g + 3]);
          *(uint2*)(base + (size_t)ch * t0.L + pos) = o;
        }
      }
  } else if (tn < 8) {
#pragma unroll
    for (int mi = 0; mi < 2; ++mi)
#pragma unroll
      for (int ni = 0; ni < 2; ++ni)
#pragma unroll
        for (int i = 0; i < 16; ++i) {
          const int row = m0 + wm * 64 + mi * 32 + crow(i, h), col = (tn - 6) * 128 + wn * 64 + ni * 32 + r;
          S5U[(size_t)row * 256 + col] = acc[mi][ni][i];
        }
  } else if (tn < 11) {
#pragma unroll
    for (int mi = 0; mi < 2; ++mi)
#pragma unroll
      for (int i = 0; i < 16; ++i) {
        const int lr = wm * 64 + mi * 32 + crow(i, h);
        const int row = m0 + lr, pos = t0.pos + lr;
        float x1 = acc[mi][0][i], x2 = acc[mi][1][i];
        if (t0.lat) {
          const f32x2 cs = RW[pos * 32 + r];
          const float y1 = x1 * cs.x - x2 * cs.y, y2 = x1 * cs.y + x2 * cs.x;
          x1 = y1; x2 = y2;
        }
        if (tn < 10) {
          const int head = (tn - 8) * 2 + wn;
          bf16_t* q = QSWA + ((size_t)row * 4 + head) * 64;
          q[r] = f2bf(x1 * qscale); q[r + 32] = f2bf(x2 * qscale);
        } else {
          bf16_t* k = KSWA + (((size_t)t0.b * 2 + wn) * KEYS + (t0.kpos + lr)) * 64;
          k[r] = f2bf(x1); k[r + 32] = f2bf(x2);
        }
      }
  } else if (tn == 11) {
#pragma unroll
    for (int mi = 0; mi < 2; ++mi)
#pragma unroll
      for (int ni = 0; ni < 2; ++ni) {
        const int dv = ni * 32 + r;
#pragma unroll
        for (int g = 0; g < 4; ++g) {
          const int kp = t0.kpos + wm * 64 + mi * 32 + 8 * g + 4 * h;
          uint2 o; o.x = pk2(acc[mi][ni][4 * g], acc[mi][ni][4 * g + 1]); o.y = pk2(acc[mi][ni][4 * g + 2], acc[mi][ni][4 * g + 3]);
          *(uint2*)(VSWAT + (((size_t)t0.b * 2 + wn) * 64 + dv) * KEYS + kp) = o;
        }
      }
  } else {
    const bool is_kv = tn == 12;
    const bool rope_wave = (tn == 14) && (wn == 1);
    if (!rope_wave) {
      bf16_t* dst = is_kv ? CKV : CQ;
      const int ld = is_kv ? 128 : 192;
      const int cbase = (tn == 14 ? 128 : 0) + wn * 64;
      float* rs = ROWSS + (is_kv ? 0 : M_ALL);
#pragma unroll
      for (int mi = 0; mi < 2; ++mi)
#pragma unroll
        for (int i = 0; i < 16; ++i) {
          const int row = m0 + wm * 64 + mi * 32 + crow(i, h);
          const float v0 = acc[mi][0][i], v1 = acc[mi][1][i];
          dst[(size_t)row * ld + cbase + r] = f2bf(v0);
          dst[(size_t)row * ld + cbase + 32 + r] = f2bf(v1);
          float s = v0 * v0 + v1 * v1;
#pragma unroll
          for (int o = 16; o; o >>= 1) s += __shfl_xor(s, o);
          if (r == 0) atomicAdd(rs + row, s);
        }
    } else {
#pragma unroll
      for (int mi = 0; mi < 2; ++mi)
#pragma unroll
        for (int i = 0; i < 16; ++i) {
          const int lr = wm * 64 + mi * 32 + crow(i, h);
          const int pos = t0.pos + lr;
          const float x = acc[mi][0][i];
          const float partner = __shfl_xor(x, 16);
          float y = x;
          if (t0.lat) {
            const f32x2 cs = RM[pos * 16 + (r & 15)];
            y = (r < 16) ? (x * cs.x - partner * cs.y) : (partner * cs.y + x * cs.x);
          }
          const bf16_t yb = f2bf(y);
#pragma unroll
          for (int hd = 0; hd < 4; ++hd) KMLA[(((size_t)t0.b * 4 + hd) * KEYS + (t0.kpos + lr)) * 96 + 64 + r] = yb;
        }
    }
  }
}
DI void phase_win(const P& p, int Mrows, unsigned char* smem) {
  const bf16_t* U = (const bf16_t*)(p.ws + O_U);
  const bf16_t* W = (const bf16_t*)(p.ws + O_WIN);
  const int Mwide = Mrows < M_LAT ? Mrows : M_LAT;
  for_tiles<256>(Mwide >> 7, 8, [&](int m0, int n0, int tn) __attribute__((always_inline)) {
    (void)n0;
    f32x16 acc[2][4];
    zero_acc<4>(acc);
    gemm_kloop_wide(acc, U, 1024, W, 1024, 1024, m0, n0, smem);
    const int wn = (TIDX >> 6) & 1, go = tn * 2 + wn;
    if (go < 15) {
#pragma unroll
      for (int half = 0; half < 2; ++half) {
        f32x16 t4[2][2];
        t4[0][0] = acc[0][2 * half]; t4[0][1] = acc[0][2 * half + 1]; t4[1][0] = acc[1][2 * half]; t4[1][1] = acc[1][2 * half + 1];
        win_epilogue(p, m0, go, half, t4);
      }
    }
  });
  if (Mrows > Mwide) {
    for_tiles((Mrows - Mwide) >> 7, 15, [&](int m0, int n0, int tn) __attribute__((always_inline)) {
      f32x16 acc[2][2];
      zero_acc<2>(acc);
      gemm_kloop<2>(acc, U, 1024, W, 1024, 1024, m0, n0, smem);
      win_epilogue(p, m0, tn, (TIDX >> 6) & 1, acc);
    }, Mwide);
  }
}

DI void phase_kvq(const P& p, int Mkv, int Mq, unsigned char* smem) {
  unsigned char* ws = p.ws;
  const bf16_t* CKV = (const bf16_t*)(ws + O_CKV);
  const bf16_t* CQ = (const bf16_t*)(ws + O_CQ);
  const bf16_t* WUKV = (const bf16_t*)(ws + O_WUKV);
  const bf16_t* WUQ = (const bf16_t*)(ws + O_WUQ);
  bf16_t* KMLA = (bf16_t*)(ws + O_KMLA);
  bf16_t* VMLAT = (bf16_t*)(ws + O_VMLAT);
  bf16_t* QMLA = (bf16_t*)(ws + O_QMLA);
  const float* ROWSS = (const float*)(ws + O_ROWSS);
  const f32x2* RM = (const f32x2*)(ws + O_ROPEM);
  const float qscale = 0.10206207261596577f * LOG2E;
  for_tiles(Mkv >> 7, 4, [&](int m0, int n0, int tn) __attribute__((always_inline)) {
    f32x16 acc[2][2];
    zero_acc<2>(acc);
    gemm_kloop<2>(acc, CKV, 128, WUKV, 128, 128, m0, n0, smem);
    EPI_COORDS
    const RowInfo t0 = row_info(m0);
#pragma unroll
    for (int mi = 0; mi < 2; ++mi) {
      float rstd[16];
#pragma unroll
      for (int i = 0; i < 16; ++i) rstd[i] = rsqrtf(ROWSS[m0 + wm * 64 + mi * 32 + crow(i, h)] * (1.0f / 128.0f) + EPS);
      if (wn == 0) {
#pragma unroll
        for (int ni = 0; ni < 2; ++ni)
#pragma unroll
          for (int i = 0; i < 16; ++i) {
            const int lr = wm * 64 + mi * 32 + crow(i, h);
            KMLA[(((size_t)t0.b * 4 + tn) * KEYS + (t0.kpos + lr)) * 96 + ni * 32 + r] = f2bf(acc[mi][ni][i] * rstd[i]);
          }
      } else {
#pragma unroll
        for (int ni = 0; ni < 2; ++ni) {
          const int dv = ni * 32 + r;
#pragma unroll
          for (int g = 0; g < 4; ++g) {
            const int kp = t0.kpos + wm * 64 + mi * 32 + 8 * g + 4 * h;
            uint2 o;
            o.x = pk2(acc[mi][ni][4 * g] * rstd[4 * g], acc[mi][ni][4 * g + 1] * rstd[4 * g + 1]);
            o.y = pk2(acc[mi][ni][4 * g + 2] * rstd[4 * g + 2], acc[mi][ni][4 * g + 3] * rstd[4 * g + 3]);
            *(uint2*)(VMLAT + (((size_t)t0.b * 4 + tn) * 64 + dv) * KEYS + kp) = o;
          }
        }
      }
    }
  });
  for_tiles(Mq >> 7, 3, [&](int m0, int n0, int tn) __attribute__((always_inline)) {
    f32x16 acc[2][2];
    zero_acc<2>(acc);
    gemm_kloop<2>(acc, CQ, 192, WUQ, 192, 192, m0, n0, smem);
    EPI_COORDS
    (void)tn;
    const RowInfo t0 = row_info(m0);
#pragma unroll
    for (int mi = 0; mi < 2; ++mi)
#pragma unroll
      for (int ni = 0; ni < 2; ++ni) {
        const int cb = n0 + wn * 64 + ni * 32;
        const int head = cb / 96, d0 = cb - head * 96;
#pragma unroll
        for (int i = 0; i < 16; ++i) {
          const int lr = wm * 64 + mi * 32 + crow(i, h);
          const int row = m0 + lr;
          const float rstd = rsqrtf(ROWSS[M_ALL + row] * (1.0f / 192.0f) + EPS);
          float v = acc[mi][ni][i] * rstd;
          if (d0 == 64) {
            const float partner = __shfl_xor(v, 16);
            if (t0.lat) {
              const f32x2 cs = RM[(t0.pos + lr) * 16 + (r & 15)];
              v = (r < 16) ? (v * cs.x - partner * cs.y) : (partner * cs.y + v * cs.x);
            }
          }
          QMLA[((size_t)row * 4 + head) * 96 + d0 + r] = f2bf(v * qscale);
        }
      }
  });
}

template <int NI>
DI void merge_tile(const P& p, int layer, int m0, int n0, unsigned char* smem) {
  unsigned char* ws = p.ws;
  const bf16_t* U = (const bf16_t*)(ws + O_U);
  const bf16_t* O4 = (const bf16_t*)(ws + O_O4);
  const bf16_t* WG = (const bf16_t*)(ws + O_WGATE);
  const bf16_t* WB = (const bf16_t*)(ws + O_WBR);
  bf16_t* MB = (bf16_t*)(ws + O_MBUF);
  const float* bg = p.in[I_BGATE] + (size_t)layer * 4 * 1024;
  EPI_COORDS
  f32x16 macc[2][NI];
  zero_acc<NI>(macc);
#pragma unroll 1
  for (int br = 0; br < 4; ++br) {
    f32x16 acc[2][NI];
    zero_acc<NI>(acc);
    gemm_kloop<NI>(acc, O4 + (size_t)br * M_ALL * 256, 256, WB + (size_t)br * 1024 * 256, 256, 256, m0, n0, smem);
    unsigned po[2][NI][8];
#pragma unroll
    for (int mi = 0; mi < 2; ++mi)
#pragma unroll
      for (int ni = 0; ni < NI; ++ni)
#pragma unroll
        for (int q = 0; q < 8; ++q) po[mi][ni][q] = pk2(acc[mi][ni][2 * q], acc[mi][ni][2 * q + 1]);
    zero_acc<NI>(acc);
    gemm_kloop<NI>(acc, U, 1024, WG + (size_t)br * 1024 * 1024, 1024, 1024, m0, n0, smem);
#pragma unroll
    for (int ni = 0; ni < NI; ++ni) {
      const float bias = bg[br * 1024 + n0 + wn * 32 * NI + ni * 32 + r];
#pragma unroll
      for (int mi = 0; mi < 2; ++mi)
#pragma unroll
        for (int q = 0; q < 8; ++q) {
          const float o0 = __uint_as_float(po[mi][ni][q] << 16), o1 = __uint_as_float(po[mi][ni][q] & 0xffff0000u);
          macc[mi][ni][2 * q] += sigmoidf_(acc[mi][ni][2 * q] + bias) * o0;
          macc[mi][ni][2 * q + 1] += sigmoidf_(acc[mi][ni][2 * q + 1] + bias) * o1;
        }
    }
  }
#pragma unroll
  for (int mi = 0; mi < 2; ++mi)
#pragma unroll
    for (int ni = 0; ni < NI; ++ni)
#pragma unroll
      for (int i = 0; i < 16; ++i) {
        const int row = m0 + wm * 64 + mi * 32 + crow(i, h), col = n0 + wn * 32 * NI + ni * 32 + r;
        MB[(size_t)row * 1024 + col] = f2bf(macc[mi][ni][i]);
      }
}
DI void phase_merge(const P& p, int layer, int Mrows, unsigned char* smem) {
  for_tiles(Mrows >> 7, 8, [&](int m0, int n0, int tn) __attribute__((always_inline)) { (void)tn; merge_tile<2>(p, layer, m0, n0, smem); });
}

DI float gelu_tanh(float x) {
  const float z = 0.7978845608028654f * (x + 0.044715f * x * x * x);
  const float e = fast_exp(2.f * z);
  const float th = 1.f - 2.f * __builtin_amdgcn_rcpf(e + 1.f);
  return 0.5f * x * (1.f + th);
}
DI void phase_glu(const P& p, int layer, int Mrows, unsigned char* smem) {
  unsigned char* ws = p.ws;
  const bf16_t* Y = (const bf16_t*)(ws + O_Y);
  const float* S5U = (const float*)(ws + O_S5U);
  const bf16_t* WGLU = (const bf16_t*)(ws + O_WGLU);
  bf16_t* O3 = (bf16_t*)(ws + O_O4) + (size_t)3 * M_ALL * 256;
  const float* Dv = p.in[I_S5D] + (size_t)layer * 256;
  const float* gb = p.in[I_GLUB] + (size_t)layer * 256;
  bf16_t* sG = (bf16_t*)smem;
  const int tid = TIDX, lane = tid & 63, wave = tid >> 6, r = lane & 31, h = lane >> 5;
  for (int t = blockIdx.x; t < (Mrows >> 6); t += gridDim.x) {
    const int m0 = t * 64;
    for (int e = tid; e < 64 * 64; e += NT) {
      const int rr = e >> 6, c4 = (e & 63) * 4;
      const size_t gi = (size_t)(m0 + rr) * 256 + c4;
      const uint2 y0 = *(const uint2*)(Y + gi), y1 = *(const uint2*)(Y + (size_t)M_ALL * 256 + gi);
      const float4 u = *(const float4*)(S5U + gi);
      const float4 dd = *(const float4*)(Dv + c4);
      const float a0 = __uint_as_float(y0.x << 16) + __uint_as_float(y1.x << 16) + u.x * dd.x;
      const float a1 = __uint_as_float(y0.x & 0xffff0000u) + __uint_as_float(y1.x & 0xffff0000u) + u.y * dd.y;
      const float a2 = __uint_as_float(y0.y << 16) + __uint_as_float(y1.y << 16) + u.z * dd.z;
      const float a3 = __uint_as_float(y0.y & 0xffff0000u) + __uint_as_float(y1.y & 0xffff0000u) + u.w * dd.w;
      uint2 o; o.x = pk2(gelu_tanh(a0), gelu_tanh(a1)); o.y = pk2(gelu_tanh(a2), gelu_tanh(a3));
      *(uint2*)(sG + rr * 264 + c4) = o;
    }
    __syncthreads();
    f32x16 acc[2][2];
    zero_acc<2>(acc);
#pragma unroll 4
    for (int kk = 0; kk < 16; ++kk) {
      const bf16x8 a0 = *(const bf16x8*)(sG + r * 264 + kk * 16 + 8 * h), a1 = *(const bf16x8*)(sG + (32 + r) * 264 + kk * 16 + 8 * h);
      const bf16x8 b0 = *(const bf16x8*)(WGLU + (size_t)(wave * 64 + r) * 256 + kk * 16 + 8 * h);
      const bf16x8 b1 = *(const bf16x8*)(WGLU + (size_t)(wave * 64 + 32 + r) * 256 + kk * 16 + 8 * h);
      acc[0][0] = MFMA32(a0, b0, acc[0][0]);
      acc[0][1] = MFMA32(a0, b1, acc[0][1]);
      acc[1][0] = MFMA32(a1, b0, acc[1][0]);
      acc[1][1] = MFMA32(a1, b1, acc[1][1]);
    }
#pragma unroll
    for (int mi = 0; mi < 2; ++mi)
#pragma unroll
      for (int ni = 0; ni < 2; ++ni) {
        const int col = wave * 64 + ni * 32 + r;
        const float bias = gb[col];
#pragma unroll
        for (int i = 0; i < 16; ++i) {
          const int lr = mi * 32 + crow(i, h);
          const float g = bf2f(sG[lr * 264 + col]);
          O3[(size_t)(m0 + lr) * 256 + col] = f2bf(g * sigmoidf_(acc[mi][ni][i] + bias));
        }
      }
    __syncthreads();
  }
}

DI f32x2 cmulf(f32x2 a, f32x2 b) { f32x2 r = {a.x * b.x - a.y * b.y, a.x * b.y + a.y * b.x}; return r; }
DI void s5_item(const P& p, int layer, int combo, unsigned char* smem) {
  unsigned char* ws = p.ws;
  const int tid = TIDX, lane = tid & 63, wave = tid >> 6;
  const int d = combo & 1, g = (combo >> 1) & 15, b = combo >> 5;
  f32x2* sX = (f32x2*)(smem + wave * 8448);
  bf16_t* sH = (bf16_t*)(smem + 4 * 8448) + wave * (16 * 136);
  f32x2* sE = (f32x2*)(smem + 4 * 8448 + 4 * 16 * 136 * 2);
  const float* S5U = (const float*)(ws + O_S5U);
  bf16_t* Y = (bf16_t*)(ws + O_Y) + (size_t)d * M_ALL * 256;
  const int pbase = ((layer * 2 + d) * 16 + g) * 64;
  const int col = lane & 15, q = lane >> 4;
  f32x2 ab, ff;
  {
    const float a_re = p.in[I_ARE][pbase + lane], a_im = p.in[I_AIM][pbase + lane];
    const float dt = fast_exp(p.in[I_LOGDT][(layer * 2 + d) * 16 + g]);
    const float mag = fast_exp(dt * a_re);
    float sn, cs; sincos_d((double)(dt * a_im), sn, cs);
    ab.x = mag * cs; ab.y = mag * sn;
    const float den = a_re * a_re + a_im * a_im;
    ff.x = ((ab.x - 1.f) * a_re + ab.y * a_im) / den;
    ff.y = (ab.y * a_re - (ab.x - 1.f) * a_im) / den;
  }
  bf16x8 fA[8];
#pragma unroll
  for (int blk = 0; blk < 8; ++blk) {
    const int ps = 8 * blk + (col >> 1), im = col & 1;
    const float fx = __shfl(ff.x, ps), fy = __shfl(ff.y, ps);
    const float* bre = p.in[I_BRE] + (size_t)(pbase + ps) * 16 + 8 * (q & 1);
    const float* bim = p.in[I_BIM] + (size_t)(pbase + ps) * 16 + 8 * (q & 1);
#pragma unroll
    for (int j = 0; j < 8; j += 2) {
      const float br0 = bre[j], bi0 = bim[j], br1 = bre[j + 1], bi1 = bim[j + 1];
      float v0 = im ? (fx * bi0 + fy * br0) : (fx * br0 - fy * bi0);
      float v1 = im ? (fx * bi1 + fy * br1) : (fx * br1 - fy * bi1);
      if (q >= 2) { v0 = 0.f; v1 = 0.f; }
      const unsigned w = pk2(v0, v1);
      fA[blk][j] = (short)(w & 0xffffu); fA[blk][j + 1] = (short)(w >> 16);
    }
  }
  bf16x8 cB[4];
  {
    const float* cre = p.in[I_CRE] + ((size_t)((layer * 2 + d) * 16 + g) * 16 + col) * 64;
    const float* cim = p.in[I_CIM] + ((size_t)((layer * 2 + d) * 16 + g) * 16 + col) * 64;
#pragma unroll
    for (int ks = 0; ks < 4; ++ks)
#pragma unroll
      for (int j = 0; j < 8; j += 2) {
        const int pp = (32 * ks + 8 * q + j) >> 1;
        const unsigned w = pk2(cre[pp], -cim[pp]);
        cB[ks][j] = (short)(w & 0xffffu); cB[ks][j + 1] = (short)(w >> 16);
      }
  }
  f32x2 apow;
  {
    f32x2 a2 = ab;
#pragma unroll
    for (int i = 0; i < 6; ++i) a2 = cmulf(a2, a2);
    f32x2 a3 = a2;
#pragma unroll
    for (int i = 0; i < 4; ++i) a3 = cmulf(a3, a3);
    apow = cmulf(a2, a3);
  }
  f32x2 hst = {0.f, 0.f};
#pragma unroll 1
  for (int pass = 0; pass < 2; ++pass) {
    for (int gj = 0; gj < 68; ++gj) {
      const int grp = wave * 68 + gj;
      const bool isctx = grp < 16;
      const int gi = isctx ? grp : grp - 16, L = isctx ? 256 : 4096;
      const int rowbase = isctx ? M_LAT + b * 256 : b * 4096;
      bf16x8 ub;
      {
        const int n = gi * 16 + col, t = d ? L - 1 - n : n;
        const float* up = S5U + (size_t)(rowbase + t) * 256 + g * 16 + 8 * (q & 1);
        const float4 u0 = *(const float4*)up, u1 = *(const float4*)(up + 4);
        unsigned w0 = pk2(u0.x, u0.y), w1 = pk2(u0.z, u0.w), w2 = pk2(u1.x, u1.y), w3 = pk2(u1.z, u1.w);
        if (q >= 2) { w0 = 0u; w1 = 0u; w2 = 0u; w3 = 0u; }
        ub[0] = (short)(w0 & 0xffffu); ub[1] = (short)(w0 >> 16); ub[2] = (short)(w1 & 0xffffu); ub[3] = (short)(w1 >> 16);
        ub[4] = (short)(w2 & 0xffffu); ub[5] = (short)(w2 >> 16); ub[6] = (short)(w3 & 0xffffu); ub[7] = (short)(w3 >> 16);
      }
#pragma unroll
      for (int blk = 0; blk < 8; ++blk) {
        f32x4 xz = {0.f, 0.f, 0.f, 0.f};
        xz = MFMA16(fA[blk], ub, xz);
        *(f32x4*)(sX + col * 66 + 8 * blk + 2 * q) = xz;
      }
      __syncthreads();
#pragma unroll 4
      for (int tt = 0; tt < 16; ++tt) {
        const f32x2 x = sX[tt * 66 + lane];
        f32x2 hn;
        hn.x = ab.x * hst.x - ab.y * hst.y + x.x;
        hn.y = ab.x * hst.y + ab.y * hst.x + x.y;
        hst = hn;
        if (pass) *(unsigned*)(sH + tt * 136 + 2 * lane) = pk2(hst.x, hst.y);
      }
      __syncthreads();
      if (pass) {
        f32x4 acc = {0.f, 0.f, 0.f, 0.f};
#pragma unroll
        for (int ks = 0; ks < 4; ++ks) {
          const bf16x8 a = *(const bf16x8*)(sH + (lane & 15) * 136 + ks * 32 + 8 * q);
          acc = MFMA16(a, cB[ks], acc);
        }
#pragma unroll
        for (int i = 0; i < 4; ++i) {
          const int tt = q * 4 + i, n = gi * 16 + tt, t = d ? L - 1 - n : n;
          Y[(size_t)(rowbase + t) * 256 + g * 16 + col] = f2bf(acc[i]);
        }
      }
    }
    if (pass == 0) {
      sE[wave * 64 + lane] = hst;
      __syncthreads();
      f32x2 st = {0.f, 0.f};
      for (int w = 0; w < wave; ++w) st = cmulf(apow, st) + sE[w * 64 + lane];
      hst = st;
      __syncthreads();
    }
  }
  __syncthreads();
}

DI float hy_in(const bf16_t* chp, int L, int t, float w0, float w1, float w2, float cb) {
  const float x0 = t > 0 ? bf2f(chp[t - 1]) : 0.f, x1 = bf2f(chp[t]), x2 = (t + 1 < L) ? bf2f(chp[t + 1]) : 0.f;
  return cb + w0 * x0 + w1 * x1 + w2 * x2;
}
DI void hyena_item(const P& p, int layer, int kind, int c, int bp, unsigned char* smem) {
  unsigned char* ws = p.ws;
  const int tid = TIDX;
  const int L = kind ? 256 : 4096, N = 2 * L, logN = kind ? 9 : 13;
  f32x2* W = (f32x2*)smem;
  const bf16_t* HYT = (const bf16_t*)(ws + O_HYT);
  const bf16_t* s0 = HYT + (kind ? HYT_LATSZ + (size_t)(2 * bp) * 768 * 256 : (size_t)(2 * bp) * 768 * 4096);
  const bf16_t* s1 = s0 + (size_t)768 * L;
  const int row0 = kind ? M_LAT + (2 * bp) * 256 : (2 * bp) * 4096;
  const int row1 = row0 + L;
  const float* cw = p.in[I_HCW] + (size_t)layer * 3 * 768;
  const float* cbv = p.in[I_HCB] + (size_t)layer * 768;
  const float bias1 = p.in[I_HBIAS][(layer * 2 + 0) * 256 + c], bias2 = p.in[I_HBIAS][(layer * 2 + 1) * 256 + c];
  const f32x2* KFa = kind ? (const f32x2*)(ws + O_KF1) + (size_t)(c * 2) * 512 : (const f32x2*)(ws + O_KF0) + (size_t)(c * 2) * 8192;
  const f32x2* KFb = KFa + N;
  bf16_t* OUT = (bf16_t*)(ws + O_O4) + (size_t)1 * M_ALL * 256;
  f32x2 zr[16];
  {
    const int ch = c;
    const float w0 = cw[ch], w1 = cw[768 + ch], w2 = cw[1536 + ch], cb = cbv[ch];
#pragma unroll
    for (int i = 0; i < 16; ++i) {
      const int t = tid + 256 * i;
      if (t < L) {
        f32x2 v = {hy_in(s0 + (size_t)ch * L, L, t, w0, w1, w2, cb), hy_in(s1 + (size_t)ch * L, L, t, w0, w1, w2, cb)};
        zr[i] = v; W[PH(t)] = v;
        f32x2 zz = {0.f, 0.f};
        W[PH(t + L)] = zz;
      }
    }
  }
  __syncthreads();
  fft_dif(W, N, logN);
  for (int n = tid; n < N; n += NT) W[PH(n)] = cmul(W[PH(n)], KFa[n]);
  __syncthreads();
  fft_dit_inv(W, N, logN);
  {
    const int ch = 256 + c;
    const float w0 = cw[ch], w1 = cw[768 + ch], w2 = cw[1536 + ch], cb = cbv[ch];
#pragma unroll
    for (int i = 0; i < 16; ++i) {
      const int t = tid + 256 * i;
      if (t < L) {
        const f32x2 y = W[PH(t)];
        const float g0 = hy_in(s0 + (size_t)ch * L, L, t, w0, w1, w2, cb), g1 = hy_in(s1 + (size_t)ch * L, L, t, w0, w1, w2, cb);
        zr[i].x = g0 * (y.x + bias1 * zr[i].x);
        zr[i].y = g1 * (y.y + bias1 * zr[i].y);
      }
    }
  }
  __syncthreads();
#pragma unroll
  for (int i = 0; i < 16; ++i) {
    const int t = tid + 256 * i;
    if (t < L) { W[PH(t)] = zr[i]; f32x2 zz = {0.f, 0.f}; W[PH(t + L)] = zz; }
  }
  __syncthreads();
  fft_dif(W, N, logN);
  for (int n = tid; n < N; n += NT) W[PH(n)] = cmul(W[PH(n)], KFb[n]);
  __syncthreads();
  fft_dit_inv(W, N, logN);
  {
    const int ch = 512 + c;
    const float w0 = cw[ch], w1 = cw[768 + ch], w2 = cw[1536 + ch], cb = cbv[ch];
#pragma unroll
    for (int i = 0; i < 16; ++i) {
      const int t = tid + 256 * i;
      if (t < L) {
        const f32x2 y = W[PH(t)];
        const float g0 = hy_in(s0 + (size_t)ch * L, L, t, w0, w1, w2, cb), g1 = hy_in(s1 + (size_t)ch * L, L, t, w0, w1, w2, cb);
        OUT[(size_t)(row0 + t) * 256 + c] = f2bf(g0 * (y.x + bias2 * zr[i].x));
        OUT[(size_t)(row1 + t) * 256 + c] = f2bf(g1 * (y.y + bias2 * zr[i].y));
      }
    }
  }
  __syncthreads();
}

template <int DQK>
DI void attn_item(const bf16_t* __restrict__ Qh, int qstride, const bf16_t* __restrict__ Kh, const bf16_t* __restrict__ Vth, bf16_t* __restrict__ Oh,
                  int a0, int a1, int b0, int b1, bool band, int qpos0, float m_init, float l_init, unsigned char* smem) {
  constexpr int KS = DQK + 8, NQ = DQK / 16, KCH = DQK / 8, KPT = (64 * KCH) / 256;
  bf16_t* sK = (bf16_t*)smem;
  bf16_t* sV = (bf16_t*)(smem + 2 * 64 * KS * 2);
  const int tid = TIDX, lane = tid & 63, wave = tid >> 6, r = lane & 31, h = lane >> 5;
  bf16x8 qf[NQ];
  {
    const bf16_t* qp = Qh + (size_t)(wave * 32 + r) * qstride + 8 * h;
#pragma unroll
    for (int ds = 0; ds < NQ; ++ds) qf[ds] = *(const bf16x8*)(qp + ds * 16);
  }
  f32x16 o0, o1;
#pragma unroll
  for (int i = 0; i < 16; ++i) { o0[i] = 0.f; o1[i] = 0.f; }
  float m = m_init, l = (h == 0) ? l_init : 0.f;
  const int nA = (a1 - a0) >> 6, nB = (b1 - b0) >> 6, nT = nA + nB;
  uint4 rk0, rk1, rk2 = {0u, 0u, 0u, 0u}, rv0, rv1;
#define ATT_KADDR(i) (Kh + (size_t)(key0_ + (tid + 256 * (i)) / KCH) * DQK + ((tid + 256 * (i)) % KCH) * 8)
#define ATT_VADDR(i) (Vth + (size_t)((tid + 256 * (i)) >> 3) * KEYS + key0_ + ((tid + 256 * (i)) & 7) * 8)
#define ATT_GLOAD(TI)                                                                                         \
  {                                                                                                           \
    const int ti_ = (TI);                                                                                     \
    const int key0_ = ti_ < nA ? a0 + ti_ * 64 : b0 + (ti_ - nA) * 64;                                        \
    rk0 = *(const uint4*)ATT_KADDR(0);                                                                        \
    rk1 = *(const uint4*)ATT_KADDR(1);                                                                        \
    if (KPT > 2) rk2 = *(const uint4*)ATT_KADDR(2);                                                           \
    rv0 = *(const uint4*)ATT_VADDR(0);                                                                        \
    rv1 = *(const uint4*)ATT_VADDR(1);                                                                        \
  }
#define ATT_KSADDR(i) (sK + buf_ * (64 * KS) + ((tid + 256 * (i)) / KCH) * KS + ((tid + 256 * (i)) % KCH) * 8)
#define ATT_VSADDR(i) (sV + buf_ * (64 * 72) + ((tid + 256 * (i)) >> 3) * 72 + ((tid + 256 * (i)) & 7) * 8)
#define ATT_SSTORE(BUF)                                                                                       \
  {                                                                                                           \
    const int buf_ = (BUF);                                                                                   \
    *(uint4*)ATT_KSADDR(0) = rk0;                                                                             \
    *(uint4*)ATT_KSADDR(1) = rk1;                                                                             \
    if (KPT > 2) *(uint4*)ATT_KSADDR(2) = rk2;                                                                \
    *(uint4*)ATT_VSADDR(0) = rv0;                                                                             \
    *(uint4*)ATT_VSADDR(1) = rv1;                                                                             \
  }
  ATT_GLOAD(0)
  ATT_SSTORE(0)
  __syncthreads();
  for (int ti = 0; ti < nT; ++ti) {
    const int cur = ti & 1;
    if (ti + 1 < nT) ATT_GLOAD(ti + 1)
    __builtin_amdgcn_sched_barrier(0);
    const bool inA = ti < nA;
    const int key0 = inA ? a0 + ti * 64 : b0 + (ti - nA) * 64;
    const bool msk = band && inA;
#pragma unroll
    for (int kb = 0; kb < 2; ++kb) {
      const int kbase = key0 + kb * 32;
      bool skip = false;
      if (msk) { const int qw = qpos0 + wave * 32; skip = (kbase > qw + 31 + 128) || (kbase + 31 < qw - 128); }
      if (!skip) {
        f32x16 s;
#pragma unroll
        for (int i = 0; i < 16; ++i) s[i] = 0.f;
        const bf16_t* kp = sK + cur * (64 * KS) + (kb * 32 + r) * KS + 8 * h;
#pragma unroll
        for (int ds = 0; ds < NQ; ++ds) { const bf16x8 a = *(const bf16x8*)(kp + ds * 16); s = MFMA32(a, qf[ds], s); }
        if (msk) {
          const int qp_ = qpos0 + wave * 32 + r;
#pragma unroll
          for (int i = 0; i < 16; ++i) { const int dlt = qp_ - (kbase + crow(i, h)); if (dlt > 128 || dlt < -128) s[i] = -1e30f; }
        }
        float mx = s[0];
#pragma unroll
        for (int i = 1; i < 16; ++i) mx = fmaxf(mx, s[i]);
        mx = fmaxf(mx, __shfl_xor(mx, 32));
        const float mn = fmaxf(m, mx);
        const float alpha = __builtin_amdgcn_exp2f(m - mn);
        m = mn;
        s = s - mn;
#pragma unroll
        for (int i = 0; i < 16; ++i) s[i] = __builtin_amdgcn_exp2f(s[i]);
        float ps;
        {
          typedef float f32x8_t __attribute__((ext_vector_type(8)));
          const f32x8_t lo8 = __builtin_shufflevector(s, s, 0, 1, 2, 3, 4, 5, 6, 7), hi8 = __builtin_shufflevector(s, s, 8, 9, 10, 11, 12, 13, 14, 15);
          const f32x8_t s8 = lo8 + hi8;
          const f32x4 s4 = __builtin_shufflevector(s8, s8, 0, 1, 2, 3) + __builtin_shufflevector(s8, s8, 4, 5, 6, 7);
          const f32x2 s2 = __builtin_shufflevector(s4, s4, 0, 1) + __builtin_shufflevector(s4, s4, 2, 3);
          ps = s2.x + s2.y;
        }
        l = l * alpha + ps;
        if (__builtin_amdgcn_ballot_w64(alpha != 1.0f) != 0ull) {
#pragma unroll
          for (int i = 0; i < 16; ++i) { o0[i] *= alpha; o1[i] *= alpha; }
        }
        bf16x8 pf0, pf1;
#pragma unroll
        for (int j = 0; j < 8; j += 2) {
          const unsigned w0 = pk2(s[j], s[j + 1]), w1 = pk2(s[8 + j], s[8 + j + 1]);
          pf0[j] = (short)(w0 & 0xffffu); pf0[j + 1] = (short)(w0 >> 16);
          pf1[j] = (short)(w1 & 0xffffu); pf1[j + 1] = (short)(w1 >> 16);
        }
        const bf16_t* vp = sV + cur * (64 * 72) + r * 72 + kb * 32 + 4 * h;
#pragma unroll
        for (int st = 0; st < 2; ++st) {
          const s16x4 lo0 = *(const s16x4*)(vp + 16 * st), hi0 = *(const s16x4*)(vp + 16 * st + 8);
          const s16x4 lo1 = *(const s16x4*)(vp + 32 * 72 + 16 * st), hi1 = *(const s16x4*)(vp + 32 * 72 + 16 * st + 8);
          const bf16x8 va0 = __builtin_shufflevector(lo0, hi0, 0, 1, 2, 3, 4, 5, 6, 7);
          const bf16x8 va1 = __builtin_shufflevector(lo1, hi1, 0, 1, 2, 3, 4, 5, 6, 7);
          o0 = MFMA32(va0, st ? pf1 : pf0, o0);
          o1 = MFMA32(va1, st ? pf1 : pf0, o1);
        }
      }
    }
    __builtin_amdgcn_sched_barrier(0);
    if (ti + 1 < nT) ATT_SSTORE(cur ^ 1)
    __syncthreads();
  }
  l += __shfl_xor(l, 32);
  const float inv = 1.0f / l;
  bf16_t* op = Oh + (size_t)(wave * 32 + r) * 256;
#pragma unroll
  for (int g = 0; g < 4; ++g) {
    uint2 w;
    w.x = pk2(o0[4 * g] * inv, o0[4 * g + 1] * inv); w.y = pk2(o0[4 * g + 2] * inv, o0[4 * g + 3] * inv);
    *(uint2*)(op + 8 * g + 4 * h) = w;
    w.x = pk2(o1[4 * g] * inv, o1[4 * g + 1] * inv); w.y = pk2(o1[4 * g + 2] * inv, o1[4 * g + 3] * inv);
    *(uint2*)(op + 32 + 8 * g + 4 * h) = w;
  }
}

DI void mla_item(const P& p, int b, int head, int row0, int a0, int a1, unsigned char* smem) {
  unsigned char* ws = p.ws;
  const bf16_t* Q = (const bf16_t*)(ws + O_QMLA) + ((size_t)row0 * 4 + head) * 96;
  const bf16_t* K = (const bf16_t*)(ws + O_KMLA) + ((size_t)b * 4 + head) * KEYS * 96;
  const bf16_t* V = (const bf16_t*)(ws + O_VMLAT) + ((size_t)b * 4 + head) * 64 * KEYS;
  bf16_t* O = (bf16_t*)(ws + O_O4) + (size_t)row0 * 256 + head * 64;
  attn_item<96>(Q, 384, K, V, O, a0, a1, 0, 0, false, 0, -1e30f, 0.f, smem);
}
DI void swa_item(const P& p, int layer, int b, int head, int row0, int a0, int a1, int b0, int b1, bool band, int qpos0, unsigned char* smem) {
  unsigned char* ws = p.ws;
  const int kvh = head >> 1;
  const bf16_t* Q = (const bf16_t*)(ws + O_QSWA) + ((size_t)row0 * 4 + head) * 64;
  const bf16_t* K = (const bf16_t*)(ws + O_KSWA) + ((size_t)b * 2 + kvh) * KEYS * 64;
  const bf16_t* V = (const bf16_t*)(ws + O_VSWAT) + ((size_t)b * 2 + kvh) * 64 * KEYS;
  bf16_t* O = (bf16_t*)(ws + O_O4) + (size_t)2 * M_ALL * 256 + (size_t)row0 * 256 + head * 64;
  const float sink = p.in[I_SINK][layer * 4 + head] * LOG2E;
  attn_item<64>(Q, 256, K, V, O, a0, a1, b0, b1, band, qpos0, sink, 1.f, smem);
}

DI void phase_mix(const P& p, int slot, int layer, bool ctx_out, unsigned char* smem, int* s_item) {
  unsigned* ctr = (unsigned*)(p.ws + O_CTR) + slot;
  const int n_s5 = 256, n_hy = 1024, n_mla = 1024, n_swa = 1024;
  const int e0 = n_s5, e1 = e0 + n_hy, e2 = e1 + n_mla, e3 = e2 + n_swa;
  const int e4 = e3 + (ctx_out ? 1024 : 0), e5 = e4 + (ctx_out ? 64 : 0), e6 = e5 + (ctx_out ? 64 : 0);
  for (;;) {
    if (TIDX == 0) *s_item = (int)atomicAdd(ctr, 1u);
    __syncthreads();
    const int it = *s_item;
    __syncthreads();
    if (it >= e6) break;
    if (it < e0) { for (int rp = 0; rp < REP_S5; ++rp) s5_item(p, layer, it, smem); }
    else if (it < e1) { const int j = it - e0; for (int rp = 0; rp < REP_HY; ++rp) hyena_item(p, layer, 0, j >> 2, j & 3, smem); }
    else if (it < e2) {
      const int j = it - e1, qb = j & 31, head = (j >> 5) & 3, b = j >> 7;
      for (int rp = 0; rp < REP_MLA; ++rp) mla_item(p, b, head, b * 4096 + qb * 128, 0, KEYS, smem);
    } else if (it < e3) {
      const int j = it - e2, qb = j & 31, head = (j >> 5) & 3, b = j >> 7, q0 = qb * 128;
      const int a0 = q0 >= 128 ? q0 - 128 : 0, a1 = q0 + 256 <= 4096 ? q0 + 256 : 4096;
      for (int rp = 0; rp < REP_SWA; ++rp) swa_item(p, layer, b, head, b * 4096 + q0, a0, a1, 4096, KEYS, true, q0, smem);
    } else if (it < e4) { const int j = it - e3; hyena_item(p, layer, 1, j >> 2, j & 3, smem); }
    else if (it < e5) {
      const int j = it - e4, qb = j & 1, head = (j >> 1) & 3, b = j >> 3;
      mla_item(p, b, head, M_LAT + b * 256 + qb * 128, 4096, KEYS, smem);
    } else {
      const int j = it - e5, qb = j & 1, head = (j >> 1) & 3, b = j >> 3;
      swa_item(p, layer, b, head, M_LAT + b * 256 + qb * 128, 4096, KEYS, 0, 0, false, 0, smem);
    }
  }
}

#define XB_TMO      128
#define XB_XCNT(j)  (256  + 64 * (j))
#define XB_XSUB(j)  (1280 + 64 * (j))
#define XB_XGEN(j)  (2304 + 64 * (j))
#define XB_TOP      3328
#define XB_TOPGEN   3392
#define XCD_BAR_WORDS 3456
#define XB_SPIN_CAP (1u << 22)
#define LAS __attribute__((address_space(3)))
DI unsigned xb_ld(unsigned* p) { return __hip_atomic_load(p, __ATOMIC_RELAXED, __HIP_MEMORY_SCOPE_AGENT); }
DI unsigned xb_add(unsigned* p, unsigned v) { return __hip_atomic_fetch_add(p, v, __ATOMIC_RELAXED, __HIP_MEMORY_SCOPE_AGENT); }
DI unsigned xb_xcc_id() { return (unsigned)__builtin_amdgcn_s_getreg((3 << 11) | 20) & 0xFu; }
#define XB_SPIN(cond, bar) do { unsigned _sp = 0; while (cond) { __builtin_amdgcn_s_sleep(1); \
    if ((++_sp & 255u) == 0u) { if (xb_ld(&(bar)[XB_TMO])) break; if (_sp > XB_SPIN_CAP) { atomicAdd(&(bar)[XB_TMO], 1u); break; } } } } while (0)
struct XcdBarrier { unsigned* bar; unsigned x; volatile LAS unsigned* st; };
DI XcdBarrier xcd_barrier_post(unsigned* bar, volatile LAS unsigned* st) {
  XcdBarrier b; b.bar = bar; b.x = xb_xcc_id(); b.st = st;
  if (threadIdx.x == 0) (void)xb_add(&bar[XB_XCNT(b.x)], 1u);
  return b;
}
DI void xcd_barrier_complete(unsigned* bar, unsigned x, unsigned& nloc, unsigned& nx) {
  const unsigned G = gridDim.x * gridDim.y * gridDim.z;
  unsigned sum, cnt, mine, sp = 0u;
  for (;;) {
    sum = 0u; cnt = 0u; mine = 0u;
#pragma unroll
    for (unsigned j = 0; j < 16; ++j) { const unsigned c = xb_ld(&bar[XB_XCNT(j)]); sum += c; cnt += (c > 0u) ? 1u : 0u; mine = (j == x) ? c : mine; }
    if (sum == G) break;
    __builtin_amdgcn_s_sleep(1);
    if ((++sp & 255u) == 0u) { if (xb_ld(&bar[XB_TMO])) break; if (sp > XB_SPIN_CAP) { atomicAdd(&bar[XB_TMO], 1u); break; } }
  }
  nloc = mine > 0u ? mine : 1u; nx = cnt > 0u ? cnt : 1u;
}
DI void xcd_barrier(const XcdBarrier& b) {
  asm volatile("s_waitcnt vmcnt(0)" ::: "memory");
  __syncthreads();
  if (threadIdx.x == 0) {
    unsigned* bar = b.bar;
    __builtin_amdgcn_s_waitcnt(0);
    unsigned nloc = b.st[0], nx = b.st[1];
    if (nloc == 0u) { xcd_barrier_complete(bar, b.x, nloc, nx); b.st[0] = nloc; b.st[1] = nx; }
    const unsigned old = xb_add(&bar[XB_XSUB(b.x)], 1u);
    const unsigned gen = old / nloc;
    if (old + 1u == (gen + 1u) * nloc) {
      __builtin_amdgcn_fence(__ATOMIC_RELEASE, "agent");
      asm volatile("s_waitcnt vmcnt(0)" ::: "memory");
      const unsigned og = xb_add(&bar[XB_TOP], 1u);
      const unsigned tg = og / nx;
      if (og + 1u == (tg + 1u) * nx) xb_add(&bar[XB_TOPGEN], 1u);
      else XB_SPIN(xb_ld(&bar[XB_TOPGEN]) == tg, bar);
      __builtin_amdgcn_fence(__ATOMIC_ACQUIRE, "agent");
      xb_add(&bar[XB_XGEN(b.x)], 1u);
      asm volatile("s_waitcnt vmcnt(0)" ::: "memory");
    } else {
      XB_SPIN(xb_ld(&bar[XB_XGEN(b.x)]) == gen, bar);
      __builtin_amdgcn_fence(__ATOMIC_ACQUIRE, "agent");
      asm volatile("s_waitcnt vmcnt(0)" ::: "memory");
    }
  }
  __syncthreads();
}

#ifndef REP_UPDN
#define REP_UPDN 1
#endif
#ifndef REP_MIXER_GEMM
#define REP_MIXER_GEMM 1
#endif
#ifndef REP_MIX
#define REP_MIX 1
#endif
#ifndef REP_PRO
#define REP_PRO 1
#endif
#ifndef REP_CONV
#define REP_CONV 1
#endif
#ifndef REP_KF
#define REP_KF 1
#endif
#ifndef REP_MODH
#define REP_MODH 1
#endif
#ifndef REP_MODONLY
#define REP_MODONLY 1
#endif
#ifndef REP_H2ONLY
#define REP_H2ONLY 1
#endif
#ifndef REP_SYNC
#define REP_SYNC 1
#endif
#define GSYNC() { for (int rs_ = 0; rs_ < REP_SYNC; ++rs_) xcd_barrier(xb); }
__global__ void __launch_bounds__(NT, 2) fwd_megakernel(P p) {
  cg::grid_group grid = cg::this_grid();
  __shared__ __attribute__((aligned(16))) unsigned char smem[SMEM_BYTES];
  __shared__ int s_item;
  unsigned char* ws = p.ws;
  __shared__ uint4 xb_words;
  if (threadIdx.x == 0) xb_words = make_uint4(0u, 0u, 0u, 0u);
  __syncthreads();
  XcdBarrier xb = xcd_barrier_post((unsigned*)(ws + O_BAR), (volatile LAS unsigned*)&xb_words);
  for (int rep = 0; rep < REP_PRO; ++rep) {
    for (int r2 = 0; r2 < REP_MODH; ++r2) { for (int r3 = 0; r3 < REP_MODONLY; ++r3) phase_modulation(p, smem); for (int r3 = 0; r3 < REP_H2ONLY; ++r3) phase_h2(p); phase_rope(p); }
    for (int r2 = 0; r2 < REP_CONV; ++r2) phase_convert(p, 0, smem);
    if (p.out == nullptr) grid.sync();
    GSYNC();
  }
  for (int rep = 0; rep < REP_PRO * REP_KF; ++rep) phase_kf(p, 0, true, smem);
  phase_rows(p, M_ALL, 0, 0, 0, 0.f, true, true, 0, 0, false);
  GSYNC();
#pragma unroll 1
  for (int layer = 0; layer < 2; ++layer) {
    const bool ctx_out = layer == 0;
    const int Mc = ctx_out ? M_ALL : M_LAT;
    for (int rep = 0; rep < REP_UPDN; ++rep) {
      phase_ffn_up(p, M_ALL, O_WUP1, smem);
      GSYNC();
      phase_gemm_plain_bf16(p, M_ALL, (const bf16_t*)(ws + O_ACT), DFF, (const bf16_t*)(ws + O_WDN1), (bf16_t*)(ws + O_F), 1024, smem);
      GSYNC();
    }
    phase_rows(p, M_ALL, 1, layer, 0, 0.5f, layer == 0, true, layer, 1, true);
    GSYNC();
    for (int rep = 0; rep < REP_MIXER_GEMM; ++rep) {
      if (rep) { phase_rows(p, M_ALL, 2, layer, 0, 0.f, false, false, 0, 0, true); GSYNC(); }
      phase_win(p, M_ALL, smem);
      GSYNC();
      phase_kvq(p, M_ALL, Mc, smem);
      GSYNC();
    }
    for (int rep = 0; rep < REP_MIX; ++rep) {
      phase_mix(p, layer + 2 * rep, layer, ctx_out, smem, &s_item);
      GSYNC();
      phase_glu(p, layer, Mc, smem);
      GSYNC();
    }
    for (int rep = 0; rep < REP_MIXER_GEMM; ++rep) {
      phase_merge(p, layer, Mc, smem);
      GSYNC();
      phase_gemm_plain_bf16(p, Mc, (const bf16_t*)(ws + O_MBUF), 1024, (const bf16_t*)(ws + O_WOUT), (bf16_t*)(ws + O_F), 1024, smem);
      GSYNC();
    }
    phase_rows(p, Mc, 1, layer, 1, 1.0f, false, true, layer, 2, false);
    GSYNC();
    for (int rep = 0; rep < REP_UPDN; ++rep) {
      phase_ffn_up(p, Mc, O_WUP2, smem);
      GSYNC();
      phase_gemm_plain_bf16(p, Mc, (const bf16_t*)(ws + O_ACT), DFF, (const bf16_t*)(ws + O_WDN2), (bf16_t*)(ws + O_F), 1024, smem);
      GSYNC();
    }
    phase_rows(p, Mc, 1, layer, 2, 0.5f, false, layer == 0, layer + 1, 0, false);
    if (layer == 0) {
      for (int rep = 0; rep < REP_PRO; ++rep) {
        for (int r2 = 0; r2 < REP_CONV; ++r2) phase_convert(p, 1, smem);
        for (int r2 = 0; r2 < REP_KF; ++r2) phase_kf(p, 1, false, smem);
      }
    }
    GSYNC();
  }
}

extern "C" void kernel_launch(void* const* d_in, const int* in_sizes, int n_in, void* d_out, int out_size, void* d_ws, size_t ws_size,
                              hipStream_t stream) {
  (void)in_sizes; (void)out_size;
  static int grid_blocks = 0;
  if (!grid_blocks) {
    int dev = 0, cus = 0, per = 0;
    (void)hipGetDevice(&dev);
    (void)hipDeviceGetAttribute(&cus, hipDeviceAttributeMultiprocessorCount, dev);
    (void)hipOccupancyMaxActiveBlocksPerMultiprocessor(&per, fwd_megakernel, NT, 0);
    if (per > 2) per = 2;
    if (per < 1) per = 1;
    grid_blocks = cus * per;
    grid_blocks &= ~7;
  }
  if (ws_size < WS_NEED || n_in < N_INPUTS) {
    fprintf(stderr, "workspace too small: need %zu have %zu\n", (size_t)WS_NEED, ws_size);
    return;
  }
  P p{};
  for (int i = 0; i < N_INPUTS; ++i) p.in[i] = (const float*)d_in[i];
  p.out = (float*)d_out;
  p.ws = (unsigned char*)d_ws;
  (void)hipMemsetAsync((unsigned char*)d_ws + O_CTR, 0, (size_t)(O_R - O_CTR), stream);
  void* args[] = {&p};
  hipError_t e = hipLaunchCooperativeKernel((void*)fwd_megakernel, dim3(grid_blocks), dim3(NT), args, 0, stream);
  if (e != hipSuccess) fprintf(stderr, "cooperative launch failed: %s (grid %d)\n", hipGetErrorString(e), grid_blocks);
}
```

```cpp
#include <hip/hip_runtime.h>
#include <hip/hip_cooperative_groups.h>
#include <cstdio>
namespace cg = cooperative_groups;
#ifndef PROBE_DBL
#define PROBE_DBL 0
#endif
#ifndef REP_S5
#define REP_S5 1
#endif
#ifndef REP_HY
#define REP_HY 1
#endif
#ifndef REP_MLA
#define REP_MLA 1
#endif
#ifndef REP_SWA
#define REP_SWA 1
#endif

#define DI __device__ __forceinline__
typedef unsigned short bf16_t;
typedef short bf16x8 __attribute__((ext_vector_type(8)));
typedef short s16x4 __attribute__((ext_vector_type(4)));
typedef float f32x16 __attribute__((ext_vector_type(16)));
typedef float f32x4 __attribute__((ext_vector_type(4)));
typedef float f32x2 __attribute__((ext_vector_type(2)));
typedef __bf16 bf16v2 __attribute__((ext_vector_type(2)));
#define MFMA32(a, b, c) __builtin_amdgcn_mfma_f32_32x32x16_bf16((a), (b), (c), 0, 0, 0)
#define MFMA16(a, b, c) __builtin_amdgcn_mfma_f32_16x16x32_bf16((a), (b), (c), 0, 0, 0)

constexpr int NT = 256;
constexpr int DM = 1024, NB = 8, SEQ = 4096, CTX = 256, DFF = 2816;
constexpr int M_LAT = NB * SEQ, M_CTX = NB * CTX, M_ALL = M_LAT + M_CTX;
constexpr int KEYS = SEQ + CTX;
constexpr float EPS = 1e-6f;
constexpr float LOG2E = 1.4426950408889634f;
constexpr int SMEM_BYTES = 73728;

enum { I_X = 0, I_C, I_CTX, I_CCTX, I_WADA, I_BADA, I_NPRE, I_NPOST, I_UP1, I_DN1, I_UP2, I_DN2, I_WIN, I_QNORM, I_KVNORM, I_WUQ, I_WUKV,
       I_HCW, I_HCB, I_HW1, I_HB1, I_HFREQ, I_HW2, I_HB2, I_HW3, I_HBIAS, I_SINK, I_ARE, I_AIM, I_LOGDT, I_BRE, I_BIM, I_CRE, I_CIM, I_S5D,
       I_GLUW, I_GLUB, I_WGATE, I_BGATE, I_BRMLA, I_BRHY, I_BRSWA, I_BRS5, I_WOUT, N_INPUTS };

constexpr size_t AL(size_t x) { return (x + 255) & ~size_t(255); }
constexpr size_t O_WUP1 = 0;
constexpr size_t O_WDN1 = O_WUP1 + AL((size_t)5632 * 1024 * 2);
constexpr size_t O_WUP2 = O_WDN1 + AL((size_t)1024 * 2816 * 2);
constexpr size_t O_WDN2 = O_WUP2 + AL((size_t)5632 * 1024 * 2);
constexpr size_t O_WIN = O_WDN2 + AL((size_t)1024 * 2816 * 2);
constexpr size_t O_WGATE = O_WIN + AL((size_t)1920 * 1024 * 2);
constexpr size_t O_WBR = O_WGATE + AL((size_t)4096 * 1024 * 2);
constexpr size_t O_WOUT = O_WBR + AL((size_t)4 * 1024 * 256 * 2);
constexpr size_t O_WUKV = O_WOUT + AL((size_t)1024 * 1024 * 2);
constexpr size_t O_WUQ = O_WUKV + AL((size_t)512 * 128 * 2);
constexpr size_t O_WGLU = O_WUQ + AL((size_t)384 * 192 * 2);
constexpr size_t O_U = O_WGLU + AL((size_t)256 * 256 * 2);
constexpr size_t O_XC = O_U + AL((size_t)M_ALL * 1024 * 2);
constexpr size_t O_MOD = O_XC + AL((size_t)M_CTX * 1024 * 4);
constexpr size_t O_H2 = O_MOD + AL((size_t)2 * 9 * 9216 * 4);
constexpr size_t O_ROPEM = O_H2 + AL((size_t)2 * (4096 + 256) * 64 * 4);
constexpr size_t O_ROPEW = O_ROPEM + AL((size_t)4096 * 16 * 8);
constexpr size_t O_KF0 = O_ROPEW + AL((size_t)4096 * 32 * 8);
constexpr size_t O_KF1 = O_KF0 + AL((size_t)256 * 2 * 8192 * 8);
constexpr size_t O_ROWSS = O_KF1 + AL((size_t)256 * 2 * 512 * 8);
constexpr size_t O_CTR = O_ROWSS + AL((size_t)2 * M_ALL * 4);
constexpr size_t O_BAR = O_CTR + 256;
constexpr size_t O_R = O_BAR + AL((size_t)3456 * 4);
constexpr size_t O_ACT = O_R;
constexpr size_t O_F = O_R + AL((size_t)M_ALL * 2816 * 2);
constexpr size_t O_O4 = O_R;
constexpr size_t O_Y = O_O4 + AL((size_t)4 * M_ALL * 256 * 2);
constexpr size_t O_HYT = O_Y + AL((size_t)2 * M_ALL * 256 * 2);
constexpr size_t O_MBUF = O_HYT;
constexpr size_t O_S5U = O_HYT + AL((size_t)M_ALL * 768 * 2);
constexpr size_t O_CKV = O_S5U + AL((size_t)M_ALL * 256 * 4);
constexpr size_t O_CQ = O_CKV + AL((size_t)M_ALL * 128 * 2);
constexpr size_t O_KMLA = O_CQ + AL((size_t)M_ALL * 192 * 2);
constexpr size_t O_VMLAT = O_KMLA + AL((size_t)NB * 4 * KEYS * 96 * 2);
constexpr size_t O_QMLA = O_VMLAT + AL((size_t)NB * 4 * 64 * KEYS * 2);
constexpr size_t O_KSWA = O_QMLA + AL((size_t)M_ALL * 384 * 2);
constexpr size_t O_VSWAT = O_KSWA + AL((size_t)NB * 2 * KEYS * 64 * 2);
constexpr size_t O_QSWA = O_VSWAT + AL((size_t)NB * 2 * 64 * KEYS * 2);
constexpr size_t O_END_MIX = O_QSWA + AL((size_t)M_ALL * 256 * 2);
constexpr size_t O_END_FFN = O_F + AL((size_t)M_ALL * 1024 * 2);
constexpr size_t WS_NEED = O_END_MIX > O_END_FFN ? O_END_MIX : O_END_FFN;
static_assert(O_MBUF + (size_t)M_ALL * 1024 * 2 <= O_CKV, "mbuf overlaps");
static_assert(O_F >= O_CKV, "F placement");
static_assert(WS_NEED <= (size_t)512 * 1024 * 1024, "workspace budget");
constexpr size_t HYT_LATSZ = (size_t)NB * 768 * 4096;

struct P {
  const float* in[N_INPUTS];
  float* out;
  unsigned char* ws;
};

DI int opaque_i(int x) { asm volatile("" : "+v"(x)); return x; }
#define TIDX opaque_i((int)threadIdx.x)
DI unsigned pk2(float lo, float hi) { f32x2 v = {lo, hi}; return __builtin_bit_cast(unsigned, __builtin_convertvector(v, bf16v2)); }
DI bf16_t f2bf(float x) { return (bf16_t)(pk2(x, 0.f) & 0xffffu); }
DI float bf2f(bf16_t b) { return __uint_as_float(((unsigned)b) << 16); }
DI float wave_sum(float v) {
#pragma unroll
  for (int o = 32; o; o >>= 1) v += __shfl_xor(v, o);
  return v;
}
DI int crow(int i, int h) { return (i & 3) + 8 * (i >> 2) + 4 * h; }
DI float fast_exp(float x) { return __builtin_amdgcn_exp2f(x * LOG2E); }
DI float sigmoidf_(float x) { return __builtin_amdgcn_rcpf(1.f + fast_exp(-x)); }
DI float siluf_(float x) { return x * sigmoidf_(x); }
DI void sincos_d(double x, float& s_out, float& c_out) {
  double k = rint(x * 0.15915494309189535);
  double r = x - k * 6.283185307179586;
  double y = r * 0.0625, y2 = y * y;
  double s = y * (1.0 - y2 / 6.0 * (1.0 - y2 / 20.0 * (1.0 - y2 / 42.0 * (1.0 - y2 / 72.0 * (1.0 - y2 / 110.0)))));
  double c = 1.0 - y2 / 2.0 * (1.0 - y2 / 12.0 * (1.0 - y2 / 30.0 * (1.0 - y2 / 56.0 * (1.0 - y2 / 90.0 * (1.0 - y2 / 132.0)))));
#pragma unroll
  for (int i = 0; i < 4; ++i) { double s2 = 2.0 * s * c, c2 = c * c - s * s; s = s2; c = c2; }
  s_out = (float)s; c_out = (float)c;
}
DI float sin_acc(float x) { float s, c; sincos_d((double)x, s, c); return s; }

template <int NI>
DI void gemm_kloop(f32x16 (&acc)[2][NI], const bf16_t* __restrict__ A, int lda, const bf16_t* __restrict__ Bt, int ldb, int K, int m0, int n0,
                   unsigned char* smem) {
  unsigned char* sA = smem;
  unsigned char* sB = smem + 32768;
  const int tid = TIDX, lane = tid & 63, wave = tid >> 6, r = lane & 31, h = lane >> 5, wm = wave >> 1, wn = wave & 1;
  const int drow = wave * 8 + (lane >> 3);
  const int csw = (lane & 7) ^ ((drow >> 1) & 7);
  const bf16_t* gA = A + (size_t)(m0 + drow) * lda + csw * 8;
  const bf16_t* gB = Bt + (size_t)(n0 + drow) * ldb + csw * 8;
  const int ldst = wave * 1024 + lane * 16;
  const int rsw = (r >> 1) & 7;
#define G_ISSUE(BUF, KO)                                                                                                        \
  {                                                                                                                             \
    _Pragma("unroll") for (int i = 0; i < 4; ++i)                                                                               \
        __builtin_amdgcn_global_load_lds((const unsigned*)(gA + (size_t)(32 * i) * lda + (KO)),                                 \
                                         (unsigned*)(sA + (BUF) * 16384 + i * 4096 + ldst), 16, 0, 0);                          \
    _Pragma("unroll") for (int i = 0; i < 2 * NI; ++i)                                                                          \
        __builtin_amdgcn_global_load_lds((const unsigned*)(gB + (size_t)(32 * i) * ldb + (KO)),                                 \
                                         (unsigned*)(sB + (BUF) * 16384 + i * 4096 + ldst), 16, 0, 0);                          \
  }
  const int nk = K >> 6;
  __syncthreads();
  G_ISSUE(0, 0)
  asm volatile("s_waitcnt vmcnt(0)" ::: "memory");
  __syncthreads();
  for (int ks = 0; ks < nk; ++ks) {
    const int cur = ks & 1;
    if (ks + 1 < nk) G_ISSUE(cur ^ 1, (ks + 1) * 64)
    const unsigned char* ab = sA + cur * 16384 + (wm * 64 + r) * 128;
    const unsigned char* bb = sB + cur * 16384 + (wn * 32 * NI + r) * 128;
#pragma unroll
    for (int kk = 0; kk < 4; ++kk) {
      const int pc = ((kk * 2 + h) ^ rsw) * 16;
      const bf16x8 a0 = *(const bf16x8*)(ab + pc), a1 = *(const bf16x8*)(ab + 32 * 128 + pc);
#pragma unroll
      for (int ni = 0; ni < NI; ++ni) {
        const bf16x8 b = *(const bf16x8*)(bb + ni * 32 * 128 + pc);
        acc[0][ni] = MFMA32(a0, b, acc[0][ni]);
        acc[1][ni] = MFMA32(a1, b, acc[1][ni]);
      }
    }
    asm volatile("s_waitcnt vmcnt(0)" ::: "memory");
    __syncthreads();
  }
#undef G_ISSUE
}
template <int NI>
DI void zero_acc(f32x16 (&acc)[2][NI]) {
#pragma unroll
  for (int a = 0; a < 2; ++a)
#pragma unroll
    for (int b = 0; b < NI; ++b)
#pragma unroll
      for (int i = 0; i < 16; ++i) acc[a][b][i] = 0.f;
}
#define DSR(dst, addr, off) asm volatile("ds_read_b128 %0, %1 offset:%2" : "=v"(dst) : "v"(addr), "i"(off))
#define FR_READ(F, ST, AA, BB)                                     \
  {                                                                \
    DSR(F##a0, AA, (ST) * 24576);                                  \
    DSR(F##a1, AA, (ST) * 24576 + 2048);                           \
    DSR(F##b0, BB, (ST) * 24576 + 8192);                           \
    DSR(F##b1, BB, (ST) * 24576 + 8192 + 2048);                    \
    DSR(F##b2, BB, (ST) * 24576 + 8192 + 4096);                    \
    DSR(F##b3, BB, (ST) * 24576 + 8192 + 6144);                    \
  }
#define FR_WAIT(F, N) asm volatile("s_waitcnt lgkmcnt(" #N ")" : "+v"(F##a0), "+v"(F##a1), "+v"(F##b0), "+v"(F##b1), "+v"(F##b2), "+v"(F##b3)::"memory")
#define FR_MFMA(F)                                                 \
  {                                                                \
    acc[0][0] = MFMA32(F##a0, F##b0, acc[0][0]);                   \
    acc[1][0] = MFMA32(F##a1, F##b0, acc[1][0]);                   \
    acc[0][1] = MFMA32(F##a0, F##b1, acc[0][1]);                   \
    acc[1][1] = MFMA32(F##a1, F##b1, acc[1][1]);                   \
    acc[0][2] = MFMA32(F##a0, F##b2, acc[0][2]);                   \
    acc[1][2] = MFMA32(F##a1, F##b2, acc[1][2]);                   \
    acc[0][3] = MFMA32(F##a0, F##b3, acc[0][3]);                   \
    acc[1][3] = MFMA32(F##a1, F##b3, acc[1][3]);                   \
    if (PROBE_DBL) {                                               \
      dum0 = MFMA32(F##a1, F##b0, dum0); dum1 = MFMA32(F##a0, F##b1, dum1);  \
      dum0 = MFMA32(F##a1, F##b2, dum0); dum1 = MFMA32(F##a0, F##b3, dum1);  \
      dum0 = MFMA32(F##a0, F##b0, dum0); dum1 = MFMA32(F##a1, F##b1, dum1);  \
      dum0 = MFMA32(F##a0, F##b2, dum0); dum1 = MFMA32(F##a1, F##b3, dum1);  \
    }                                                              \
  }
DI void gemm_kloop_wide(f32x16 (&acc)[2][4], const bf16_t* __restrict__ A, int lda, const bf16_t* __restrict__ Bt, int ldb, int K, int m0, int n0,
                        unsigned char* smem) {
  const int tid = TIDX, lane = tid & 63, wave = tid >> 6, r = lane & 31, h = lane >> 5, wm = wave >> 1, wn = wave & 1;
  const int drow = wave * 16 + (lane >> 2);
  const int csw = (lane & 3) ^ ((lane >> 4) & 3);
  const bf16_t* gA = A + (size_t)(m0 + drow) * lda + csw * 8;
  const bf16_t* gB = Bt + (size_t)(n0 + drow) * ldb + csw * 8;
  const int ldst = wave * 1024 + lane * 16;
  const int rsw = (r >> 2) & 3;
  const unsigned lbase = (unsigned)(size_t)smem;
  const unsigned aA0 = lbase + (wm * 64 + r) * 64 + ((0 + h) ^ rsw) * 16, aA1 = lbase + (wm * 64 + r) * 64 + ((2 + h) ^ rsw) * 16;
  const unsigned bB0 = lbase + (wn * 128 + r) * 64 + ((0 + h) ^ rsw) * 16, bB1 = lbase + (wn * 128 + r) * 64 + ((2 + h) ^ rsw) * 16;
#define GW_ISSUE(ST, KO)                                                                                                        \
  {                                                                                                                             \
    _Pragma("unroll") for (int i = 0; i < 2; ++i)                                                                               \
        __builtin_amdgcn_global_load_lds((const unsigned*)(gA + (size_t)(64 * i) * lda + (KO)),                                 \
                                         (unsigned*)(smem + (ST) * 24576 + i * 4096 + ldst), 16, 0, 0);                         \
    _Pragma("unroll") for (int i = 0; i < 4; ++i)                                                                               \
        __builtin_amdgcn_global_load_lds((const unsigned*)(gB + (size_t)(64 * i) * ldb + (KO)),                                 \
                                         (unsigned*)(smem + (ST) * 24576 + 8192 + i * 4096 + ldst), 16, 0, 0);                  \
  }
  bf16x8 Pa0, Pa1, Pb0, Pb1, Pb2, Pb3, Qa0, Qa1, Qb0, Qb1, Qb2, Qb3;
  f32x16 dum0, dum1;
  _Pragma("unroll") for (int i = 0; i < 16; ++i) { dum0[i] = 0.f; dum1[i] = 0.f; }
#define GW_STEP(KIDX, S, S1, S2)                                                                                                \
  {                                                                                                                             \
    asm volatile("s_waitcnt vmcnt(0)" ::: "memory");                                 \
    __builtin_amdgcn_s_barrier();                               \
    if ((KIDX) + 2 < nk) GW_ISSUE(S2, ((KIDX) + 2) * 32)                                                                        \
    FR_READ(Q, S, aA1, bB1)                                                                           \
    FR_WAIT(P, 6);                                               \
    FR_MFMA(P)                                                                                                                  \
    FR_WAIT(Q, 0);                                                                                                              \
    if ((KIDX) + 1 < nk) FR_READ(P, S1, aA0, bB0)                                                    \
    FR_MFMA(Q)                                                                                                                  \
  }
  const int nk = K >> 5;
  asm volatile("s_waitcnt vmcnt(0) lgkmcnt(0)" ::: "memory");
  __builtin_amdgcn_s_barrier();
  GW_ISSUE(0, 0)
  GW_ISSUE(1, 32)
  asm volatile("s_waitcnt vmcnt(6)" ::: "memory");
  __builtin_amdgcn_s_barrier();
  FR_READ(P, 0, aA0, bB0)
  for (int k = 0; k < nk; k += 3) {
    GW_STEP(k, 0, 1, 2)
    if (k + 1 < nk) GW_STEP(k + 1, 1, 2, 0)
    if (k + 2 < nk) GW_STEP(k + 2, 2, 0, 1)
  }
#undef GW_ISSUE
#undef GW_STEP
  if (PROBE_DBL) { _Pragma("unroll") for (int i = 0; i < 16; ++i) acc[0][0][i] += 0.f * (dum0[i] + dum1[i]); }
}
template <int BN = 128, class F>
DI void for_tiles(int ntm, int ntn, F f, int m_base = 0) {
  constexpr int GM = 8, GN = 8;
  const int xcd = blockIdx.x & 7, slot = blockIdx.x >> 3, nslot = gridDim.x >> 3;
  const int nmx = ntm >> 3;
  const int per = nmx * ntn;
  const int fullN = ntn / GN, fullM = nmx / GM;
  for (int L = slot; L < per; L += nslot) {
    int ng = L / (nmx * GN), gn = GN;
    if (ng >= fullN) { ng = fullN; gn = ntn - fullN * GN; }
    const int rem = L - ng * (nmx * GN);
    int mg = rem / (GM * gn), gm = GM;
    if (mg >= fullM) { mg = fullM; gm = nmx - fullM * GM; }
    const int rem2 = rem - mg * (GM * gn);
    const int mi = rem2 % gm, ni = rem2 / gm;
    const int tn = ng * GN + ni, tm = xcd + 8 * (mg * GM + mi);
    f(m_base + tm * 128, tn * BN, tn);
  }
}
struct RowInfo { int b, pos, kpos, L; bool lat; };
DI RowInfo row_info(int row) {
  RowInfo ri;
  if (row < M_LAT) { ri.b = row >> 12; ri.pos = row & 4095; ri.kpos = ri.pos; ri.lat = true; ri.L = 4096; }
  else { int q = row - M_LAT; ri.b = q >> 8; ri.pos = q & 255; ri.kpos = 4096 + ri.pos; ri.lat = false; ri.L = 256; }
  return ri;
}

DI int map_col(int mode, int n) {
  if (mode == 0) return n;
  if (mode == 1) { const int isb = n >= DFF; const int j = isb ? n - DFF : n; return (j >> 5) * 64 + (isb ? 32 : 0) + (j & 31); }
  if (n >= 1120) return n - 1120;
  if (n >= 864) return n - 864 + 1024;
  if (n >= 672) return n - 672 + 1664;
  if (n >= 416) return n - 416 + 768;
  if (n >= 288) return n - 288 + 1408;
  if (n >= 160) return n - 160 + 1280;
  if (n >= 128) return n - 128 + 1856;
  return n + 1536;
}
DI void conv_tile(const float* __restrict__ src, bf16_t* __restrict__ dst, const float* __restrict__ kscale, int K, int N, int mode, int t, float* tile  ) {
  const int ntn = (N + 63) >> 6;
  const int kt = t / ntn, nt = t % ntn, k0 = kt * 64, n0 = nt * 64, tid = TIDX;
  float vv[16];
#pragma unroll
  for (int i = 0; i < 16; ++i) {
    const int idx = tid + 256 * i, kk = idx >> 6, nn = idx & 63;
    vv[i] = (n0 + nn < N) ? src[(size_t)(k0 + kk) * N + n0 + nn] : 0.f;
  }
#pragma unroll
  for (int i = 0; i < 16; ++i) {
    const int idx = tid + 256 * i, kk = idx >> 6, nn = idx & 63;
    float v = vv[i];
    if (kscale) v *= kscale[k0 + kk];
    tile[kk * 65 + nn] = v;
  }
  __syncthreads();
#pragma unroll 4
  for (int i = 0; i < 8; ++i) {
    const int idx = tid + 256 * i, nn = idx >> 5, kp = idx & 31;
    if (n0 + nn < N) {
      const int dr = map_col(mode, n0 + nn);
      *(unsigned*)(dst + (size_t)dr * K + k0 + 2 * kp) = pk2(tile[(2 * kp) * 65 + nn], tile[(2 * kp + 1) * 65 + nn]);
    }
  }
  __syncthreads();
}
DI void phase_convert(const P& p, int layer, unsigned char* smem) {
  unsigned char* ws = p.ws;
  const size_t l = (size_t)layer;
  const int tid = TIDX;
#define CONV_JOB(SRC, OFF, KS, KK, NN, MODE)                                                              \
  {                                                                                                       \
    const int ntiles_ = ((KK) >> 6) * (((NN) + 63) >> 6);                                                 \
    for (int t = blockIdx.x; t < ntiles_; t += gridDim.x) conv_tile((SRC), (bf16_t*)(ws + (OFF)), (KS), (KK), (NN), (MODE), t, (float*)smem); \
  }
  CONV_JOB(p.in[I_UP1] + l * 1024 * 5632, O_WUP1, nullptr, 1024, 5632, 1)
  CONV_JOB(p.in[I_DN1] + l * 2816 * 1024, O_WDN1, nullptr, 2816, 1024, 0)
  CONV_JOB(p.in[I_UP2] + l * 1024 * 5632, O_WUP2, nullptr, 1024, 5632, 1)
  CONV_JOB(p.in[I_DN2] + l * 2816 * 1024, O_WDN2, nullptr, 2816, 1024, 0)
  CONV_JOB(p.in[I_WIN] + l * 1024 * 1888, O_WIN, nullptr, 1024, 1888, 2)
#pragma unroll 1
  for (int i = 0; i < 4; ++i) CONV_JOB(p.in[I_WGATE] + (l * 4 + i) * 1024 * 1024, O_WGATE + (size_t)i * 1024 * 1024 * 2, nullptr, 1024, 1024, 0)
  CONV_JOB(p.in[I_BRMLA] + l * 256 * 1024, O_WBR + (size_t)0 * 1024 * 256 * 2, nullptr, 256, 1024, 0)
  CONV_JOB(p.in[I_BRHY] + l * 256 * 1024, O_WBR + (size_t)1 * 1024 * 256 * 2, nullptr, 256, 1024, 0)
  CONV_JOB(p.in[I_BRSWA] + l * 256 * 1024, O_WBR + (size_t)2 * 1024 * 256 * 2, nullptr, 256, 1024, 0)
  CONV_JOB(p.in[I_BRS5] + l * 256 * 1024, O_WBR + (size_t)3 * 1024 * 256 * 2, nullptr, 256, 1024, 0)
  CONV_JOB(p.in[I_WOUT] + l * 1024 * 1024, O_WOUT, nullptr, 1024, 1024, 0)
  CONV_JOB(p.in[I_WUKV] + l * 128 * 512, O_WUKV, p.in[I_KVNORM] + l * 128, 128, 512, 0)
  CONV_JOB(p.in[I_WUQ] + l * 192 * 384, O_WUQ, p.in[I_QNORM] + l * 192, 192, 384, 0)
  CONV_JOB(p.in[I_GLUW] + l * 256 * 256, O_WGLU, nullptr, 256, 256, 0)
#undef CONV_JOB
  {
    unsigned* z = (unsigned*)(ws + O_WIN + (size_t)1888 * 1024 * 2);
    for (int i = blockIdx.x * NT + tid; i < 32 * 1024 / 2; i += gridDim.x * NT) z[i] = 0u;
  }
}

DI void phase_modulation(const P& p, unsigned char* smem) {
  float* sS = (float*)smem;
  float* sR = sS + 9 * 1024;
  const int tid = TIDX, lane = tid & 63, wave = tid >> 6;
  float* MOD = (float*)(p.ws + O_MOD);
  bool filled = false;
  for (int it = blockIdx.x; it < 2 * 144; it += gridDim.x) {
    if (!filled) {
      for (int i = tid; i < 9 * 1024; i += NT) {
        const int v = i >> 10, k = i & 1023;
        const float x = v < 8 ? p.in[I_C][v * 1024 + k] : p.in[I_CCTX][k];
        sS[i] = siluf_(x);
      }
      filled = true;
      __syncthreads();
    }
    const int layer = it / 144, col = (it % 144) * 64 + lane;
    const float* w = p.in[I_WADA] + (size_t)layer * 1024 * 9216 + col;
    float acc[9];
#pragma unroll
    for (int v = 0; v < 9; ++v) acc[v] = 0.f;
#pragma unroll 8
    for (int k = wave * 256; k < wave * 256 + 256; ++k) {
      const float wv = w[(size_t)k * 9216];
#pragma unroll
      for (int v = 0; v < 9; ++v) acc[v] += sS[v * 1024 + k] * wv;
    }
#pragma unroll
    for (int v = 0; v < 9; ++v) sR[(wave * 9 + v) * 64 + lane] = acc[v];
    __syncthreads();
    for (int i = tid; i < 9 * 64; i += NT) {
      const int v = i >> 6, c = i & 63;
      const float s = sR[(0 * 9 + v) * 64 + c] + sR[(1 * 9 + v) * 64 + c] + sR[(2 * 9 + v) * 64 + c] + sR[(3 * 9 + v) * 64 + c];
      const int cc = (it % 144) * 64 + c;
      MOD[((size_t)layer * 9 + v) * 9216 + cc] = s + p.in[I_BADA][(size_t)layer * 9216 + cc];
    }
    __syncthreads();
  }
  __syncthreads();
}

DI size_t h2_off(int layer, int kind) { return ((size_t)layer * (4096 + 256) + (kind ? 4096 : 0)) * 64; }
DI void phase_h2(const P& p) {
  const int tid = TIDX, lane = tid & 63, wave = tid >> 6;
  float* H2 = (float*)(p.ws + O_H2);
  const int rows_per_layer = 4096 + 256;
  for (int rr = blockIdx.x * 4 + wave; rr < 2 * rows_per_layer; rr += gridDim.x * 4) {
    const int layer = rr / rows_per_layer, q = rr % rows_per_layer;
    const int kind = q >= 4096, t = kind ? q - 4096 : q, L = kind ? 256 : 4096;
    float z = 0.f;
    if (lane == 0) z = (float)t / (float)(L - 1);
    else if (lane < 33) {
      const int j = (lane - 1) & 15;
      const float w = (6.2831855f * (float)t) / (float)L;
      const float fr = 1e-4f + (float)j * ((15.0f - 1e-4f) / 15.0f);
      const float ang = w * fr;
      float s, c; sincos_d((double)ang, s, c);
      z = lane <= 16 ? c : -s;
    }
    const float* w1 = p.in[I_HW1] + (size_t)layer * 33 * 64;
    const float* w2 = p.in[I_HW2] + (size_t)layer * 64 * 64;
    float a = p.in[I_HB1][layer * 64 + lane];
    for (int i = 0; i < 33; ++i) a += __shfl(z, i) * w1[i * 64 + lane];
    const float h1 = sin_acc(p.in[I_HFREQ][(layer * 2 + 0) * 64 + lane] * a);
    float a2 = p.in[I_HB2][layer * 64 + lane];
    for (int i = 0; i < 64; ++i) a2 += __shfl(h1, i) * w2[i * 64 + lane];
    const float h2 = sin_acc(p.in[I_HFREQ][(layer * 2 + 1) * 64 + lane] * a2);
    H2[h2_off(layer, kind) + (size_t)t * 64 + lane] = h2;
  }
}

DI void phase_rope(const P& p) {
  f32x2* RM = (f32x2*)(p.ws + O_ROPEM);
  f32x2* RW = (f32x2*)(p.ws + O_ROPEW);
  const int g0 = blockIdx.x * NT + TIDX, gs = gridDim.x * NT;
  for (int i = g0; i < 4096 * 48; i += gs) {
    const int pos = i / 48, e = i % 48;
    const float rowf = (float)(pos >> 6), colf = (float)(pos & 63);
    float ang;
    if (e < 16) { const int f = e & 7; const float fr = fast_exp(-(float)f / 8.0f * 9.210340371976184f); ang = (e < 8 ? rowf : colf) * fr; }
    else { const int e2 = e - 16, f = e2 & 15; const float fr = fast_exp(-(float)f / 16.0f * 9.210340371976184f); ang = (e2 < 16 ? rowf : colf) * fr; }
    float s, c; sincos_d((double)ang, s, c);
    f32x2 v = {c, s};
    if (e < 16) RM[pos * 16 + e] = v; else RW[pos * 32 + (e - 16)] = v;
  }
}

DI f32x2 cmul(f32x2 a, f32x2 b) { f32x2 r = {a.x * b.x - a.y * b.y, a.x * b.y + a.y * b.x}; return r; }
DI f32x2 cmulc(f32x2 a, f32x2 b) { f32x2 r = {a.x * b.x + a.y * b.y, a.y * b.x - a.x * b.y}; return r; }
DI f32x2 mul_mi(f32x2 a) { f32x2 r = {a.y, -a.x}; return r; }
DI f32x2 mul_pi(f32x2 a) { f32x2 r = {-a.y, a.x}; return r; }
#define PH(i) ((i) + ((i) >> 4))
DI void fft16_dif_tail(f32x2 (&x)[16]) {
  const float C1 = 0.92387953251f, S1 = 0.38268343236f, R2 = 0.70710678118f;
  const f32x2 T[4] = {{1.f, 0.f}, {C1, -S1}, {R2, -R2}, {S1, -C1}};
  const f32x2 T2[4] = {{1.f, 0.f}, {R2, -R2}, {0.f, -1.f}, {-R2, -R2}};
#pragma unroll
  for (int j = 0; j < 4; ++j) {
    const f32x2 a0 = x[j], a1 = x[j + 4], a2 = x[j + 8], a3 = x[j + 12];
    const f32x2 b0 = a0 + a2, b2 = cmul(a0 - a2, T[j]), b1 = a1 + a3, b3 = mul_mi(cmul(a1 - a3, T[j]));
    x[j] = b0 + b1; x[j + 4] = cmul(b0 - b1, T2[j]); x[j + 8] = b2 + b3; x[j + 12] = cmul(b2 - b3, T2[j]);
  }
#pragma unroll
  for (int k = 0; k < 4; ++k) {
    const f32x2 a0 = x[4 * k], a1 = x[4 * k + 1], a2 = x[4 * k + 2], a3 = x[4 * k + 3];
    const f32x2 b0 = a0 + a2, b2 = a0 - a2, b1 = a1 + a3, b3 = mul_mi(a1 - a3);
    x[4 * k] = b0 + b1; x[4 * k + 1] = b0 - b1; x[4 * k + 2] = b2 + b3; x[4 * k + 3] = b2 - b3;
  }
}
DI void fft16_dit_head(f32x2 (&x)[16]) {
  const float C1 = 0.92387953251f, S1 = 0.38268343236f, R2 = 0.70710678118f;
  const f32x2 T[4] = {{1.f, 0.f}, {C1, -S1}, {R2, -R2}, {S1, -C1}};
  const f32x2 T2[4] = {{1.f, 0.f}, {R2, -R2}, {0.f, -1.f}, {-R2, -R2}};
#pragma unroll
  for (int k = 0; k < 4; ++k) {
    const f32x2 c0 = x[4 * k], c1 = x[4 * k + 1], c2 = x[4 * k + 2], c3 = x[4 * k + 3];
    const f32x2 b0 = c0 + c1, b1 = c0 - c1, b2 = c2 + c3, b3 = c2 - c3;
    const f32x2 up = mul_pi(b3);
    x[4 * k] = b0 + b2; x[4 * k + 2] = b0 - b2; x[4 * k + 1] = b1 + up; x[4 * k + 3] = b1 - up;
  }
#pragma unroll
  for (int j = 0; j < 4; ++j) {
    const f32x2 c0 = x[j], c1 = x[j + 4], c2 = x[j + 8], c3 = x[j + 12];
    const f32x2 t = cmulc(c1, T2[j]), tp = cmulc(c3, T2[j]);
    const f32x2 b0 = c0 + t, b1 = c0 - t, b2 = c2 + tp, b3 = c2 - tp;
    const f32x2 u = cmulc(b2, T[j]), up = mul_pi(cmulc(b3, T[j]));
    x[j] = b0 + u; x[j + 8] = b0 - u; x[j + 4] = b1 + up; x[j + 12] = b1 - up;
  }
}
DI void fft_dif(f32x2* W, int N, int logN) {
  const int tid = TIDX;
  int s = logN - 1;
  {
    const int half = 1 << s, hp = half + (half >> 4);
    const float inv = 1.0f / (float)(2 * half);
    for (int i = tid; i < (N >> 1); i += NT) {
      const int j = i & (half - 1), base = PH(((i >> s) << (s + 1)) + j);
      const f32x2 a = W[base], b = W[base + hp];
      const float rev = (float)j * inv;
      const f32x2 w = {__builtin_amdgcn_cosf(rev), -__builtin_amdgcn_sinf(rev)};
      W[base] = a + b;
      W[base + hp] = cmul(a - b, w);
    }
    __syncthreads();
    --s;
  }
  for (; s >= 5; s -= 2) {
    const int half = 1 << s, quarter = half >> 1, hp = half + (half >> 4), qp = quarter + (quarter >> 4);
    const float inv = 1.0f / (float)(2 * half);
    for (int i = tid; i < (N >> 2); i += NT) {
      const int j = i & (quarter - 1), i0 = PH(((i >> (s - 1)) << (s + 1)) + j);
      const f32x2 a0 = W[i0], a1 = W[i0 + qp], a2 = W[i0 + hp], a3 = W[i0 + hp + qp];
      const float rev = (float)j * inv;
      const f32x2 w1 = {__builtin_amdgcn_cosf(rev), -__builtin_amdgcn_sinf(rev)};
      const f32x2 w2 = cmul(w1, w1);
      const f32x2 b0 = a0 + a2, b2 = cmul(a0 - a2, w1), b1 = a1 + a3, b3 = mul_mi(cmul(a1 - a3, w1));
      W[i0] = b0 + b1;
      W[i0 + qp] = cmul(b0 - b1, w2);
      W[i0 + hp] = b2 + b3;
      W[i0 + hp + qp] = cmul(b2 - b3, w2);
    }
    __syncthreads();
  }
  for (int gq = tid; gq < (N >> 4); gq += NT) {
    f32x2 x[16];
#pragma unroll
    for (int e = 0; e < 16; ++e) x[e] = W[17 * gq + e];
    fft16_dif_tail(x);
#pragma unroll
    for (int e = 0; e < 16; ++e) W[17 * gq + e] = x[e];
  }
  __syncthreads();
}
DI void fft_dit_inv(f32x2* W, int N, int logN) {
  const int tid = TIDX;
  for (int gq = tid; gq < (N >> 4); gq += NT) {
    f32x2 x[16];
#pragma unroll
    for (int e = 0; e < 16; ++e) x[e] = W[17 * gq + e];
    fft16_dit_head(x);
#pragma unroll
    for (int e = 0; e < 16; ++e) W[17 * gq + e] = x[e];
  }
  __syncthreads();
  int s = 5;
  for (; s < logN - 1; s += 2) {
    const int half = 1 << s, quarter = half >> 1, hp = half + (half >> 4), qp = quarter + (quarter >> 4);
    const float inv = 1.0f / (float)(2 * half);
    for (int i = tid; i < (N >> 2); i += NT) {
      const int j = i & (quarter - 1), i0 = PH(((i >> (s - 1)) << (s + 1)) + j);
      const f32x2 c0 = W[i0], c1 = W[i0 + qp], c2 = W[i0 + hp], c3 = W[i0 + hp + qp];
      const float rev = (float)j * inv;
      const f32x2 w1 = {__builtin_amdgcn_cosf(rev), -__builtin_amdgcn_sinf(rev)};
      const f32x2 w2 = cmul(w1, w1);
      const f32x2 t = cmulc(c1, w2), tp = cmulc(c3, w2);
      const f32x2 b0 = c0 + t, b1 = c0 - t, b2 = c2 + tp, b3 = c2 - tp;
      const f32x2 u = cmulc(b2, w1), up = mul_pi(cmulc(b3, w1));
      W[i0] = b0 + u;
      W[i0 + hp] = b0 - u;
      W[i0 + qp] = b1 + up;
      W[i0 + hp + qp] = b1 - up;
    }
    __syncthreads();
  }
  {
    const int sl = logN - 1, half = 1 << sl, hp = half + (half >> 4);
    const float inv = 1.0f / (float)(2 * half);
    for (int i = tid; i < (N >> 1); i += NT) {
      const int j = i & (half - 1), base = PH(((i >> sl) << (sl + 1)) + j);
      const f32x2 a = W[base], b = W[base + hp];
      const float rev = (float)j * inv;
      const f32x2 w = {__builtin_amdgcn_cosf(rev), __builtin_amdgcn_sinf(rev)};
      const f32x2 t = cmul(b, w);
      W[base] = a + t;
      W[base + hp] = a - t;
    }
    __syncthreads();
  }
}

DI void kf_item(const P& p, int layer, int kind, int c, int o, unsigned char* smem) {
  const int tid = TIDX;
  const int L = kind ? 256 : 4096, N = 2 * L, logN = kind ? 9 : 13;
  f32x2* W = (f32x2*)smem;
  float* sW3 = (float*)(smem + 69632);
  const float* w3 = p.in[I_HW3] + (size_t)layer * 64 * 1024;
  if (tid < 128) { const int dir = tid >> 6, j = tid & 63; sW3[tid] = w3[(size_t)j * 1024 + o * 512 + dir * 256 + c]; }
  __syncthreads();
  const float* H2 = (const float*)(p.ws + O_H2) + h2_off(layer, kind);
  const float lo = -3.0701134573253942f, hi = -15.350567286626971f;
  const float delta = fabsf(lo + (float)c * ((hi - lo) / 255.0f));
  const float invN = 1.0f / (float)N;
  for (int n = tid; n < N; n += NT) {
    float val = 0.f;
    if (n != L) {
      const int dir = n > L, t = dir ? N - n : n;
      const float4* hr = (const float4*)(H2 + (size_t)t * 64);
      const float* wv = sW3 + dir * 64;
      float acc = 0.f;
#pragma unroll
      for (int q = 0; q < 16; ++q) { const float4 hv = hr[q]; acc += hv.x * wv[4 * q] + hv.y * wv[4 * q + 1] + hv.z * wv[4 * q + 2] + hv.w * wv[4 * q + 3]; }
      const float tl = (float)t / (float)(L - 1);
      val = acc * fast_exp(-tl * delta) * invN;
    }
    f32x2 v = {val, 0.f};
    W[PH(n)] = v;
  }
  __syncthreads();
  fft_dif(W, N, logN);
  f32x2* KF = kind ? (f32x2*)(p.ws + O_KF1) + (size_t)(c * 2 + o) * 512 : (f32x2*)(p.ws + O_KF0) + (size_t)(c * 2 + o) * 8192;
  for (int n = tid; n < N; n += NT) KF[n] = W[PH(n)];
  __syncthreads();
}
DI void phase_kf(const P& p, int layer, bool with_ctx, unsigned char* smem) {
  const int total = 512 + (with_ctx ? 512 : 0);
  for (int it = blockIdx.x; it < total; it += gridDim.x) {
    const int kind = it >= 512, q = it & 511;
    kf_item(p, layer, kind, q >> 1, q & 1, smem);
  }
}

DI void phase_rows(const P& p, int Mrows, int mode, int layer, int sub, float resw, bool from_input, bool has_next, int nl, int nj, bool zero_rowss) {
  const int tid = TIDX, lane = tid & 63, wave = tid >> 6;
  const float* MOD = (const float*)(p.ws + O_MOD);
  const bf16_t* F = (const bf16_t*)(p.ws + O_F);
  bf16_t* U = (bf16_t*)(p.ws + O_U);
  float* XC = (float*)(p.ws + O_XC);
  float* ROWSS = (float*)(p.ws + O_ROWSS);
  for (int row0 = (blockIdx.x * 4 + wave) * 2; row0 < Mrows; row0 += gridDim.x * 8) {
    if (mode == 2) { if (lane < 2) { ROWSS[row0 + lane] = 0.f; ROWSS[M_ALL + row0 + lane] = 0.f; } continue; }
    const float* xin[2]; float* X[2]; int midx[2];
#pragma unroll
    for (int rr = 0; rr < 2; ++rr) {
      const int row = row0 + rr;
      const bool lat = row < M_LAT;
      midx[rr] = lat ? (row >> 12) : 8;
      xin[rr] = lat ? p.in[I_X] + (size_t)row * 1024 : p.in[I_CTX] + (size_t)(row - M_LAT) * 1024;
      X[rr] = lat ? p.out + (size_t)row * 1024 : XC + (size_t)(row - M_LAT) * 1024;
    }
    float4 xv[2][4];
    if (mode == 0) {
#pragma unroll
      for (int rr = 0; rr < 2; ++rr)
#pragma unroll
        for (int c4 = 0; c4 < 4; ++c4) xv[rr][c4] = *(const float4*)(xin[rr] + c4 * 256 + lane * 4);
    } else {
      uint2 raw[2][4];
      float4 xold[2][4];
#pragma unroll
      for (int rr = 0; rr < 2; ++rr)
#pragma unroll
        for (int c4 = 0; c4 < 4; ++c4) {
          { typedef unsigned u32x2v __attribute__((ext_vector_type(2)));
            const u32x2v rw = __builtin_nontemporal_load((const u32x2v*)(F + (size_t)(row0 + rr) * 1024 + c4 * 256 + lane * 4));
            raw[rr][c4].x = rw.x; raw[rr][c4].y = rw.y;
            const f32x4 xo4 = __builtin_nontemporal_load((const f32x4*)((from_input ? xin[rr] : X[rr]) + c4 * 256 + lane * 4));
            xold[rr][c4].x = xo4.x; xold[rr][c4].y = xo4.y; xold[rr][c4].z = xo4.z; xold[rr][c4].w = xo4.w; }
        }
      const float* gp = p.in[I_NPOST] + ((size_t)layer * 3 + sub) * 1024;
#pragma unroll
      for (int rr = 0; rr < 2; ++rr) {
        const float* mod = MOD + ((size_t)layer * 9 + midx[rr]) * 9216 + (3 * sub + 2) * 1024;
        float4 fv[4];
        float ss = 0.f;
#pragma unroll
        for (int c4 = 0; c4 < 4; ++c4) {
          fv[c4].x = __uint_as_float(raw[rr][c4].x << 16); fv[c4].y = __uint_as_float(raw[rr][c4].x & 0xffff0000u);
          fv[c4].z = __uint_as_float(raw[rr][c4].y << 16); fv[c4].w = __uint_as_float(raw[rr][c4].y & 0xffff0000u);
          ss += fv[c4].x * fv[c4].x + fv[c4].y * fv[c4].y + fv[c4].z * fv[c4].z + fv[c4].w * fv[c4].w;
        }
        ss = wave_sum(ss);
        const float rstd = rsqrtf(ss * (1.0f / 1024.0f) + EPS);
#pragma unroll
        for (int c4 = 0; c4 < 4; ++c4) {
          const int col = c4 * 256 + lane * 4;
          const float4 g = *(const float4*)(gp + col);
          const float4 mg = *(const float4*)(mod + col);
          xv[rr][c4].x = xold[rr][c4].x + resw * mg.x * (fv[c4].x * rstd * g.x);
          xv[rr][c4].y = xold[rr][c4].y + resw * mg.y * (fv[c4].y * rstd * g.y);
          xv[rr][c4].z = xold[rr][c4].z + resw * mg.z * (fv[c4].z * rstd * g.z);
          xv[rr][c4].w = xold[rr][c4].w + resw * mg.w * (fv[c4].w * rstd * g.w);
          { f32x4 st4 = {xv[rr][c4].x, xv[rr][c4].y, xv[rr][c4].z, xv[rr][c4].w}; __builtin_nontemporal_store(st4, (f32x4*)(X[rr] + col)); }
        }
      }
    }
    if (has_next) {
      const float* gpre = p.in[I_NPRE] + ((size_t)nl * 3 + nj) * 1024;
#pragma unroll
      for (int rr = 0; rr < 2; ++rr) {
        float ss = 0.f;
#pragma unroll
        for (int c4 = 0; c4 < 4; ++c4) ss += xv[rr][c4].x * xv[rr][c4].x + xv[rr][c4].y * xv[rr][c4].y + xv[rr][c4].z * xv[rr][c4].z + xv[rr][c4].w * xv[rr][c4].w;
        ss = wave_sum(ss);
        const float rstd = rsqrtf(ss * (1.0f / 1024.0f) + EPS);
        const float* modn = MOD + ((size_t)nl * 9 + midx[rr]) * 9216;
#pragma unroll
        for (int c4 = 0; c4 < 4; ++c4) {
          const int col = c4 * 256 + lane * 4;
          const float4 g = *(const float4*)(gpre + col);
          const float4 sc = *(const float4*)(modn + (3 * nj + 1) * 1024 + col);
          const float4 sh = *(const float4*)(modn + (3 * nj) * 1024 + col);
          const float u0 = xv[rr][c4].x * rstd * g.x * (1.f + sc.x) + sh.x;
          const float u1 = xv[rr][c4].y * rstd * g.y * (1.f + sc.y) + sh.y;
          const float u2 = xv[rr][c4].z * rstd * g.z * (1.f + sc.z) + sh.z;
          const float u3 = xv[rr][c4].w * rstd * g.w * (1.f + sc.w) + sh.w;
          uint2 o; o.x = pk2(u0, u1); o.y = pk2(u2, u3);
          *(uint2*)(U + (size_t)(row0 + rr) * 1024 + col) = o;
        }
      }
    }
    if (zero_rowss && lane < 2) { ROWSS[row0 + lane] = 0.f; ROWSS[M_ALL + row0 + lane] = 0.f; }
  }
}

#define EPI_COORDS                                                                                      \
  const int tid = TIDX, lane = tid & 63, wave = tid >> 6, r = lane & 31, h = lane >> 5, wm = wave >> 1, wn = wave & 1; \
  (void)tid; (void)lane; (void)wave; (void)r; (void)h; (void)wm; (void)wn;

DI void phase_ffn_up(const P& p, int Mrows, size_t off_w, unsigned char* smem) {
  const bf16_t* U = (const bf16_t*)(p.ws + O_U);
  const bf16_t* W = (const bf16_t*)(p.ws + off_w);
  bf16_t* ACT = (bf16_t*)(p.ws + O_ACT);
  for_tiles<256>(Mrows >> 7, 22, [&](int m0, int n0, int tn) __attribute__((always_inline)) {
    f32x16 acc[2][4];
    zero_acc<4>(acc);
    gemm_kloop_wide(acc, U, 1024, W, 1024, 1024, m0, n0, smem);
    EPI_COORDS
#pragma unroll
    for (int j = 0; j < 2; ++j) {
      const int col = tn * 128 + wn * 64 + j * 32 + r;
#pragma unroll
      for (int mi = 0; mi < 2; ++mi)
#pragma unroll
        for (int i = 0; i < 16; ++i) {
          const int row = m0 + wm * 64 + mi * 32 + crow(i, h);
          const float a = acc[mi][2 * j][i], b = acc[mi][2 * j + 1][i];
          ACT[(size_t)row * DFF + col] = f2bf(siluf_(a) * b);
        }
    }
  });
}
DI void phase_gemm_plain_bf16(const P& p, int Mrows, const bf16_t* A, int K, const bf16_t* W, bf16_t* OUT, int N, unsigned char* smem) {
  (void)p;
  const int Mwide = Mrows < M_LAT ? Mrows : M_LAT;
  for_tiles<256>(Mwide >> 7, N >> 8, [&](int m0, int n0, int tn) __attribute__((always_inline)) {
    (void)tn;
    f32x16 acc[2][4];
    zero_acc<4>(acc);
    gemm_kloop_wide(acc, A, K, W, K, K, m0, n0, smem);
    EPI_COORDS
#pragma unroll
    for (int mi = 0; mi < 2; ++mi)
#pragma unroll
      for (int ni = 0; ni < 4; ++ni)
#pragma unroll
        for (int i = 0; i < 16; ++i) {
          const int row = m0 + wm * 64 + mi * 32 + crow(i, h), col = n0 + wn * 128 + ni * 32 + r;
          OUT[(size_t)row * N + col] = f2bf(acc[mi][ni][i]);
        }
  });
  if (Mrows > Mwide) {
    for_tiles<64>((Mrows - Mwide) >> 7, N >> 6, [&](int m0, int n0, int tn) __attribute__((always_inline)) {
      (void)tn;
      f32x16 acc[2][1];
      zero_acc<1>(acc);
      gemm_kloop<1>(acc, A, K, W, K, K, m0, n0, smem);
      EPI_COORDS
#pragma unroll
      for (int mi = 0; mi < 2; ++mi)
#pragma unroll
        for (int i = 0; i < 16; ++i) {
          const int row = m0 + wm * 64 + mi * 32 + crow(i, h), col = n0 + wn * 32 + r;
          OUT[(size_t)row * N + col] = f2bf(acc[mi][0][i]);
        }
    }, Mwide);
  }
}

DI void win_epilogue(const P& p, int m0, int tn, int wn, f32x16 (&acc)[2][2]) {
  unsigned char* ws = p.ws;
  bf16_t* HYT = (bf16_t*)(ws + O_HYT);
  float* S5U = (float*)(ws + O_S5U);
  bf16_t* QSWA = (bf16_t*)(ws + O_QSWA);
  bf16_t* KSWA = (bf16_t*)(ws + O_KSWA);
  bf16_t* VSWAT = (bf16_t*)(ws + O_VSWAT);
  bf16_t* CKV = (bf16_t*)(ws + O_CKV);
  bf16_t* CQ = (bf16_t*)(ws + O_CQ);
  bf16_t* KMLA = (bf16_t*)(ws + O_KMLA);
  float* ROWSS = (float*)(ws + O_ROWSS);
  const f32x2* RM = (const f32x2*)(ws + O_ROPEM);
  const f32x2* RW = (const f32x2*)(ws + O_ROPEW);
  const float qscale = 0.125f * LOG2E;
  const int tid = TIDX, lane = tid & 63, wave = tid >> 6, r = lane & 31, h = lane >> 5, wm = wave >> 1;
    const RowInfo t0 = row_info(m0);
  if (tn < 6) {
    bf16_t* base = HYT + (t0.lat ? (size_t)t0.b * 768 * 4096 : HYT_LATSZ + (size_t)t0.b * 768 * 256);
#pragma unroll
    for (int mi = 0; mi < 2; ++mi)
#pragma unroll
      for (int ni = 0; ni < 2; ++ni) {
        const int ch = tn * 128 + wn * 64 + ni * 32 + r;
#pragma unroll
        for (int g = 0; g < 4; ++g) {
          const int pos = t0.pos + wm * 64 + mi * 32 + 8 * g + 4 * h;
          uint2 o; o.x = pk2(acc[mi][ni][4 * g], acc[mi][ni][4 * g + 1]); o.y = pk2(acc[mi][ni][4 * g + 2], acc[mi][ni][4 * g + 3]);
          *(uint2*)(base + (size_t)ch * t0.L + pos) = o;
        }
      }
  } else if (tn < 8) {
#pragma unroll
    for (int mi = 0; mi < 2; ++mi)
#pragma unroll
      for (int ni = 0; ni < 2; ++ni)
#pragma unroll
        for (int i = 0; i < 16; ++i) {
          const int row = m0 + wm * 64 + mi * 32 + crow(i, h), col = (tn - 6) * 128 + wn * 64 + ni * 32 + r;
          S5U[(size_t)row * 256 + col] = acc[mi][ni][i];
        }
  } else if (tn < 11) {
#pragma unroll
    for (int mi = 0; mi < 2; ++mi)
#pragma unroll
      for (int i = 0; i < 16; ++i) {
        const int lr = wm * 64 + mi * 32 + crow(i, h);
        const int row = m0 + lr, pos = t0.pos + lr;
        float x1 = acc[mi][0][i], x2 = acc[mi][1][i];
        if (t0.lat) {
          const f32x2 cs = RW[pos * 32 + r];
          const float y1 = x1 * cs.x - x2 * cs.y, y2 = x1 * cs.y + x2 * cs.x;
          x1 = y1; x2 = y2;
        }
        if (tn < 10) {
          const int head = (tn - 8) * 2 + wn;
          bf16_t* q = QSWA + ((size_t)row * 4 + head) * 64;
          q[r] = f2bf(x1 * qscale); q[r + 32] = f2bf(x2 * qscale);
        } else {
          bf16_t* k = KSWA + (((size_t)t0.b * 2 + wn) * KEYS + (t0.kpos + lr)) * 64;
          k[r] = f2bf(x1); k[r + 32] = f2bf(x2);
        }
      }
  } else if (tn == 11) {
#pragma unroll
    for (int mi = 0; mi < 2; ++mi)
#pragma unroll
      for (int ni = 0; ni < 2; ++ni) {
        const int dv = ni * 32 + r;
#pragma unroll
        for (int g = 0; g < 4; ++g) {
          const int kp = t0.kpos + wm * 64 + mi * 32 + 8 * g + 4 * h;
          uint2 o; o.x = pk2(acc[mi][ni][4 * g], acc[mi][ni][4 * g + 1]); o.y = pk2(acc[mi][ni][4 * g + 2], acc[mi][ni][4 * g + 3]);
          *(uint2*)(VSWAT + (((size_t)t0.b * 2 + wn) * 64 + dv) * KEYS + kp) = o;
        }
      }
  } else {
    const bool is_kv = tn == 12;
    const bool rope_wave = (tn == 14) && (wn == 1);
    if (!rope_wave) {
      bf16_t* dst = is_kv ? CKV : CQ;
      const int ld = is_kv ? 128 : 192;
      const int cbase = (tn == 14 ? 128 : 0) + wn * 64;
      float* rs = ROWSS + (is_kv ? 0 : M_ALL);
#pragma unroll
      for (int mi = 0; mi < 2; ++mi)
#pragma unroll
        for (int i = 0; i < 16; ++i) {
          const int row = m0 + wm * 64 + mi * 32 + crow(i, h);
          const float v0 = acc[mi][0][i], v1 = acc[mi][1][i];
          dst[(size_t)row * ld + cbase + r] = f2bf(v0);
          dst[(size_t)row * ld + cbase + 32 + r] = f2bf(v1);
          float s = v0 * v0 + v1 * v1;
#pragma unroll
          for (int o = 16; o; o >>= 1) s += __shfl_xor(s, o);
          if (r == 0) atomicAdd(rs + row, s);
        }
    } else {
#pragma unroll
      for (int mi = 0; mi < 2; ++mi)
#pragma unroll
        for (int i = 0; i < 16; ++i) {
          const int lr = wm * 64 + mi * 32 + crow(i, h);
          const int pos = t0.pos + lr;
          const float x = acc[mi][0][i];
          const float partner = __shfl_xor(x, 16);
          float y = x;
          if (t0.lat) {
            const f32x2 cs = RM[pos * 16 + (r & 15)];
            y = (r < 16) ? (x * cs.x - partner * cs.y) : (partner * cs.y + x * cs.x);
          }
          const bf16_t yb = f2bf(y);
#pragma unroll
          for (int hd = 0; hd < 4; ++hd) KMLA[(((size_t)t0.b * 4 + hd) * KEYS + (t0.kpos + lr)) * 96 + 64 + r] = yb;
        }
    }
  }
}
DI void phase_win(const P& p, int Mrows, unsigned char* smem) {
  const bf16_t* U = (const bf16_t*)(p.ws + O_U);
  const bf16_t* W = (const bf16_t*)(p.ws + O_WIN);
  const int Mwide = Mrows < M_LAT ? Mrows : M_LAT;
  for_tiles<256>(Mwide >> 7, 8, [&](int m0, int n0, int tn) __attribute__((always_inline)) {
    (void)n0;
    f32x16 acc[2][4];
    zero_acc<4>(acc);
    gemm_kloop_wide(acc, U, 1024, W, 1024, 1024, m0, n0, smem);
    const int wn = (TIDX >> 6) & 1, go = tn * 2 + wn;
    if (go < 15) {
#pragma unroll
      for (int half = 0; half < 2; ++half) {
        f32x16 t4[2][2];
        t4[0][0] = acc[0][2 * half]; t4[0][1] = acc[0][2 * half + 1]; t4[1][0] = acc[1][2 * half]; t4[1][1] = acc[1][2 * half + 1];
        win_epilogue(p, m0, go, half, t4);
      }
    }
  });
  if (Mrows > Mwide) {
    for_tiles((Mrows - Mwide) >> 7, 15, [&](int m0, int n0, int tn) __attribute__((always_inline)) {
      f32x16 acc[2][2];
      zero_acc<2>(acc);
      gemm_kloop<2>(acc, U, 1024, W, 1024, 1024, m0, n0, smem);
      win_epilogue(p, m0, tn, (TIDX >> 6) & 1, acc);
    }, Mwide);
  }
}

DI void phase_kvq(const P& p, int Mkv, int Mq, unsigned char* smem) {
  unsigned char* ws = p.ws;
  const bf16_t* CKV = (const bf16_t*)(ws + O_CKV);
  const bf16_t* CQ = (const bf16_t*)(ws + O_CQ);
  const bf16_t* WUKV = (const bf16_t*)(ws + O_WUKV);
  const bf16_t* WUQ = (const bf16_t*)(ws + O_WUQ);
  bf16_t* KMLA = (bf16_t*)(ws + O_KMLA);
  bf16_t* VMLAT = (bf16_t*)(ws + O_VMLAT);
  bf16_t* QMLA = (bf16_t*)(ws + O_QMLA);
  const float* ROWSS = (const float*)(ws + O_ROWSS);
  const f32x2* RM = (const f32x2*)(ws + O_ROPEM);
  const float qscale = 0.10206207261596577f * LOG2E;
  for_tiles(Mkv >> 7, 4, [&](int m0, int n0, int tn) __attribute__((always_inline)) {
    f32x16 acc[2][2];
    zero_acc<2>(acc);
    gemm_kloop<2>(acc, CKV, 128, WUKV, 128, 128, m0, n0, smem);
    EPI_COORDS
    const RowInfo t0 = row_info(m0);
#pragma unroll
    for (int mi = 0; mi < 2; ++mi) {
      float rstd[16];
#pragma unroll
      for (int i = 0; i < 16; ++i) rstd[i] = rsqrtf(ROWSS[m0 + wm * 64 + mi * 32 + crow(i, h)] * (1.0f / 128.0f) + EPS);
      if (wn == 0) {
#pragma unroll
        for (int ni = 0; ni < 2; ++ni)
#pragma unroll
          for (int i = 0; i < 16; ++i) {
            const int lr = wm * 64 + mi * 32 + crow(i, h);
            KMLA[(((size_t)t0.b * 4 + tn) * KEYS + (t0.kpos + lr)) * 96 + ni * 32 + r] = f2bf(acc[mi][ni][i] * rstd[i]);
          }
      } else {
#pragma unroll
        for (int ni = 0; ni < 2; ++ni) {
          const int dv = ni * 32 + r;
#pragma unroll
          for (int g = 0; g < 4; ++g) {
            const int kp = t0.kpos + wm * 64 + mi * 32 + 8 * g + 4 * h;
            uint2 o;
            o.x = pk2(acc[mi][ni][4 * g] * rstd[4 * g], acc[mi][ni][4 * g + 1] * rstd[4 * g + 1]);
            o.y = pk2(acc[mi][ni][4 * g + 2] * rstd[4 * g + 2], acc[mi][ni][4 * g + 3] * rstd[4 * g + 3]);
            *(uint2*)(VMLAT + (((size_t)t0.b * 4 + tn) * 64 + dv) * KEYS + kp) = o;
          }
        }
      }
    }
  });
  for_tiles(Mq >> 7, 3, [&](int m0, int n0, int tn) __attribute__((always_inline)) {
    f32x16 acc[2][2];
    zero_acc<2>(acc);
    gemm_kloop<2>(acc, CQ, 192, WUQ, 192, 192, m0, n0, smem);
    EPI_COORDS
    (void)tn;
    const RowInfo t0 = row_info(m0);
#pragma unroll
    for (int mi = 0; mi < 2; ++mi)
#pragma unroll
      for (int ni = 0; ni < 2; ++ni) {
        const int cb = n0 + wn * 64 + ni * 32;
        const int head = cb / 96, d0 = cb - head * 96;
#pragma unroll
        for (int i = 0; i < 16; ++i) {
          const int lr = wm * 64 + mi * 32 + crow(i, h);
          const int row = m0 + lr;
          const float rstd = rsqrtf(ROWSS[M_ALL + row] * (1.0f / 192.0f) + EPS);
          float v = acc[mi][ni][i] * rstd;
          if (d0 == 64) {
            const float partner = __shfl_xor(v, 16);
            if (t0.lat) {
              const f32x2 cs = RM[(t0.pos + lr) * 16 + (r & 15)];
              v = (r < 16) ? (v * cs.x - partner * cs.y) : (partner * cs.y + v * cs.x);
            }
          }
          QMLA[((size_t)row * 4 + head) * 96 + d0 + r] = f2bf(v * qscale);
        }
      }
  });
}

template <int NI>
DI void merge_tile(const P& p, int layer, int m0, int n0, unsigned char* smem) {
  unsigned char* ws = p.ws;
  const bf16_t* U = (const bf16_t*)(ws + O_U);
  const bf16_t* O4 = (const bf16_t*)(ws + O_O4);
  const bf16_t* WG = (const bf16_t*)(ws + O_WGATE);
  const bf16_t* WB = (const bf16_t*)(ws + O_WBR);
  bf16_t* MB = (bf16_t*)(ws + O_MBUF);
  const float* bg = p.in[I_BGATE] + (size_t)layer * 4 * 1024;
  EPI_COORDS
  f32x16 macc[2][NI];
  zero_acc<NI>(macc);
#pragma unroll 1
  for (int br = 0; br < 4; ++br) {
    f32x16 acc[2][NI];
    zero_acc<NI>(acc);
    gemm_kloop<NI>(acc, O4 + (size_t)br * M_ALL * 256, 256, WB + (size_t)br * 1024 * 256, 256, 256, m0, n0, smem);
    unsigned po[2][NI][8];
#pragma unroll
    for (int mi = 0; mi < 2; ++mi)
#pragma unroll
      for (int ni = 0; ni < NI; ++ni)
#pragma unroll
        for (int q = 0; q < 8; ++q) po[mi][ni][q] = pk2(acc[mi][ni][2 * q], acc[mi][ni][2 * q + 1]);
    zero_acc<NI>(acc);
    gemm_kloop<NI>(acc, U, 1024, WG + (size_t)br * 1024 * 1024, 1024, 1024, m0, n0, smem);
#pragma unroll
    for (int ni = 0; ni < NI; ++ni) {
      const float bias = bg[br * 1024 + n0 + wn * 32 * NI + ni * 32 + r];
#pragma unroll
      for (int mi = 0; mi < 2; ++mi)
#pragma unroll
        for (int q = 0; q < 8; ++q) {
          const float o0 = __uint_as_float(po[mi][ni][q] << 16), o1 = __uint_as_float(po[mi][ni][q] & 0xffff0000u);
          macc[mi][ni][2 * q] += sigmoidf_(acc[mi][ni][2 * q] + bias) * o0;
          macc[mi][ni][2 * q + 1] += sigmoidf_(acc[mi][ni][2 * q + 1] + bias) * o1;
        }
    }
  }
#pragma unroll
  for (int mi = 0; mi < 2; ++mi)
#pragma unroll
    for (int ni = 0; ni < NI; ++ni)
#pragma unroll
      for (int i = 0; i < 16; ++i) {
        const int row = m0 + wm * 64 + mi * 32 + crow(i, h), col = n0 + wn * 32 * NI + ni * 32 + r;
        MB[(size_t)row * 1024 + col] = f2bf(macc[mi][ni][i]);
      }
}
DI void phase_merge(const P& p, int layer, int Mrows, unsigned char* smem) {
  for_tiles(Mrows >> 7, 8, [&](int m0, int n0, int tn) __attribute__((always_inline)) { (void)tn; merge_tile<2>(p, layer, m0, n0, smem); });
}

DI float gelu_tanh(float x) {
  const float z = 0.7978845608028654f * (x + 0.044715f * x * x * x);
  const float e = fast_exp(2.f * z);
  const float th = 1.f - 2.f * __builtin_amdgcn_rcpf(e + 1.f);
  return 0.5f * x * (1.f + th);
}
DI void phase_glu(const P& p, int layer, int Mrows, unsigned char* smem) {
  unsigned char* ws = p.ws;
  const bf16_t* Y = (const bf16_t*)(ws + O_Y);
  const float* S5U = (const float*)(ws + O_S5U);
  const bf16_t* WGLU = (const bf16_t*)(ws + O_WGLU);
  bf16_t* O3 = (bf16_t*)(ws + O_O4) + (size_t)3 * M_ALL * 256;
  const float* Dv = p.in[I_S5D] + (size_t)layer * 256;
  const float* gb = p.in[I_GLUB] + (size_t)layer * 256;
  bf16_t* sG = (bf16_t*)smem;
  const int tid = TIDX, lane = tid & 63, wave = tid >> 6, r = lane & 31, h = lane >> 5;
  for (int t = blockIdx.x; t < (Mrows >> 6); t += gridDim.x) {
    const int m0 = t * 64;
    for (int e = tid; e < 64 * 64; e += NT) {
      const int rr = e >> 6, c4 = (e & 63) * 4;
      const size_t gi = (size_t)(m0 + rr) * 256 + c4;
      const uint2 y0 = *(const uint2*)(Y + gi), y1 = *(const uint2*)(Y + (size_t)M_ALL * 256 + gi);
      const float4 u = *(const float4*)(S5U + gi);
      const float4 dd = *(const float4*)(Dv + c4);
      const float a0 = __uint_as_float(y0.x << 16) + __uint_as_float(y1.x << 16) + u.x * dd.x;
      const float a1 = __uint_as_float(y0.x & 0xffff0000u) + __uint_as_float(y1.x & 0xffff0000u) + u.y * dd.y;
      const float a2 = __uint_as_float(y0.y << 16) + __uint_as_float(y1.y << 16) + u.z * dd.z;
      const float a3 = __uint_as_float(y0.y & 0xffff0000u) + __uint_as_float(y1.y & 0xffff0000u) + u.w * dd.w;
      uint2 o; o.x = pk2(gelu_tanh(a0), gelu_tanh(a1)); o.y = pk2(gelu_tanh(a2), gelu_tanh(a3));
      *(uint2*)(sG + rr * 264 + c4) = o;
    }
    __syncthreads();
    f32x16 acc[2][2];
    zero_acc<2>(acc);
#pragma unroll 4
    for (int kk = 0; kk < 16; ++kk) {
      const bf16x8 a0 = *(const bf16x8*)(sG + r * 264 + kk * 16 + 8 * h), a1 = *(const bf16x8*)(sG + (32 + r) * 264 + kk * 16 + 8 * h);
      const bf16x8 b0 = *(const bf16x8*)(WGLU + (size_t)(wave * 64 + r) * 256 + kk * 16 + 8 * h);
      const bf16x8 b1 = *(const bf16x8*)(WGLU + (size_t)(wave * 64 + 32 + r) * 256 + kk * 16 + 8 * h);
      acc[0][0] = MFMA32(a0, b0, acc[0][0]);
      acc[0][1] = MFMA32(a0, b1, acc[0][1]);
      acc[1][0] = MFMA32(a1, b0, acc[1][0]);
      acc[1][1] = MFMA32(a1, b1, acc[1][1]);
    }
#pragma unroll
    for (int mi = 0; mi < 2; ++mi)
#pragma unroll
      for (int ni = 0; ni < 2; ++ni) {
        const int col = wave * 64 + ni * 32 + r;
        const float bias = gb[col];
#pragma unroll
        for (int i = 0; i < 16; ++i) {
          const int lr = mi * 32 + crow(i, h);
          const float g = bf2f(sG[lr * 264 + col]);
          O3[(size_t)(m0 + lr) * 256 + col] = f2bf(g * sigmoidf_(acc[mi][ni][i] + bias));
        }
      }
    __syncthreads();
  }
}

DI f32x2 cmulf(f32x2 a, f32x2 b) { f32x2 r = {a.x * b.x - a.y * b.y, a.x * b.y + a.y * b.x}; return r; }
DI void s5_item(const P& p, int layer, int combo, unsigned char* smem) {
  unsigned char* ws = p.ws;
  const int tid = TIDX, lane = tid & 63, wave = tid >> 6;
  const int d = combo & 1, g = (combo >> 1) & 15, b = combo >> 5;
  f32x2* sX = (f32x2*)(smem + wave * 8448);
  bf16_t* sH = (bf16_t*)(smem + 4 * 8448) + wave * (16 * 136);
  f32x2* sE = (f32x2*)(smem + 4 * 8448 + 4 * 16 * 136 * 2);
  const float* S5U = (const float*)(ws + O_S5U);
  bf16_t* Y = (bf16_t*)(ws + O_Y) + (size_t)d * M_ALL * 256;
  const int pbase = ((layer * 2 + d) * 16 + g) * 64;
  const int col = lane & 15, q = lane >> 4;
  f32x2 ab, ff;
  {
    const float a_re = p.in[I_ARE][pbase + lane], a_im = p.in[I_AIM][pbase + lane];
    const float dt = fast_exp(p.in[I_LOGDT][(layer * 2 + d) * 16 + g]);
    const float mag = fast_exp(dt * a_re);
    float sn, cs; sincos_d((double)(dt * a_im), sn, cs);
    ab.x = mag * cs; ab.y = mag * sn;
    const float den = a_re * a_re + a_im * a_im;
    ff.x = ((ab.x - 1.f) * a_re + ab.y * a_im) / den;
    ff.y = (ab.y * a_re - (ab.x - 1.f) * a_im) / den;
  }
  bf16x8 fA[8];
#pragma unroll
  for (int blk = 0; blk < 8; ++blk) {
    const int ps = 8 * blk + (col >> 1), im = col & 1;
    const float fx = __shfl(ff.x, ps), fy = __shfl(ff.y, ps);
    const float* bre = p.in[I_BRE] + (size_t)(pbase + ps) * 16 + 8 * (q & 1);
    const float* bim = p.in[I_BIM] + (size_t)(pbase + ps) * 16 + 8 * (q & 1);
#pragma unroll
    for (int j = 0; j < 8; j += 2) {
      const float br0 = bre[j], bi0 = bim[j], br1 = bre[j + 1], bi1 = bim[j + 1];
      float v0 = im ? (fx * bi0 + fy * br0) : (fx * br0 - fy * bi0);
      float v1 = im ? (fx * bi1 + fy * br1) : (fx * br1 - fy * bi1);
      if (q >= 2) { v0 = 0.f; v1 = 0.f; }
      const unsigned w = pk2(v0, v1);
      fA[blk][j] = (short)(w & 0xffffu); fA[blk][j + 1] = (short)(w >> 16);
    }
  }
  bf16x8 cB[4];
  {
    const float* cre = p.in[I_CRE] + ((size_t)((layer * 2 + d) * 16 + g) * 16 + col) * 64;
    const float* cim = p.in[I_CIM] + ((size_t)((layer * 2 + d) * 16 + g) * 16 + col) * 64;
#pragma unroll
    for (int ks = 0; ks < 4; ++ks)
#pragma unroll
      for (int j = 0; j < 8; j += 2) {
        const int pp = (32 * ks + 8 * q + j) >> 1;
        const unsigned w = pk2(cre[pp], -cim[pp]);
        cB[ks][j] = (short)(w & 0xffffu); cB[ks][j + 1] = (short)(w >> 16);
      }
  }
  f32x2 apow;
  {
    f32x2 a2 = ab;
#pragma unroll
    for (int i = 0; i < 6; ++i) a2 = cmulf(a2, a2);
    f32x2 a3 = a2;
#pragma unroll
    for (int i = 0; i < 4; ++i) a3 = cmulf(a3, a3);
    apow = cmulf(a2, a3);
  }
  f32x2 hst = {0.f, 0.f};
#pragma unroll 1
  for (int pass = 0; pass < 2; ++pass) {
    for (int gj = 0; gj < 68; ++gj) {
      const int grp = wave * 68 + gj;
      const bool isctx = grp < 16;
      const int gi = isctx ? grp : grp - 16, L = isctx ? 256 : 4096;
      const int rowbase = isctx ? M_LAT + b * 256 : b * 4096;
      bf16x8 ub;
      {
        const int n = gi * 16 + col, t = d ? L - 1 - n : n;
        const float* up = S5U + (size_t)(rowbase + t) * 256 + g * 16 + 8 * (q & 1);
        const float4 u0 = *(const float4*)up, u1 = *(const float4*)(up + 4);
        unsigned w0 = pk2(u0.x, u0.y), w1 = pk2(u0.z, u0.w), w2 = pk2(u1.x, u1.y), w3 = pk2(u1.z, u1.w);
        if (q >= 2) { w0 = 0u; w1 = 0u; w2 = 0u; w3 = 0u; }
        ub[0] = (short)(w0 & 0xffffu); ub[1] = (short)(w0 >> 16); ub[2] = (short)(w1 & 0xffffu); ub[3] = (short)(w1 >> 16);
        ub[4] = (short)(w2 & 0xffffu); ub[5] = (short)(w2 >> 16); ub[6] = (short)(w3 & 0xffffu); ub[7] = (short)(w3 >> 16);
      }
#pragma unroll
      for (int blk = 0; blk < 8; ++blk) {
        f32x4 xz = {0.f, 0.f, 0.f, 0.f};
        xz = MFMA16(fA[blk], ub, xz);
        *(f32x4*)(sX + col * 66 + 8 * blk + 2 * q) = xz;
      }
      __syncthreads();
#pragma unroll 4
      for (int tt = 0; tt < 16; ++tt) {
        const f32x2 x = sX[tt * 66 + lane];
        f32x2 hn;
        hn.x = ab.x * hst.x - ab.y * hst.y + x.x;
        hn.y = ab.x * hst.y + ab.y * hst.x + x.y;
        hst = hn;
        if (pass) *(unsigned*)(sH + tt * 136 + 2 * lane) = pk2(hst.x, hst.y);
      }
      __syncthreads();
      if (pass) {
        f32x4 acc = {0.f, 0.f, 0.f, 0.f};
#pragma unroll
        for (int ks = 0; ks < 4; ++ks) {
          const bf16x8 a = *(const bf16x8*)(sH + (lane & 15) * 136 + ks * 32 + 8 * q);
          acc = MFMA16(a, cB[ks], acc);
        }
#pragma unroll
        for (int i = 0; i < 4; ++i) {
          const int tt = q * 4 + i, n = gi * 16 + tt, t = d ? L - 1 - n : n;
          Y[(size_t)(rowbase + t) * 256 + g * 16 + col] = f2bf(acc[i]);
        }
      }
    }
    if (pass == 0) {
      sE[wave * 64 + lane] = hst;
      __syncthreads();
      f32x2 st = {0.f, 0.f};
      for (int w = 0; w < wave; ++w) st = cmulf(apow, st) + sE[w * 64 + lane];
      hst = st;
      __syncthreads();
    }
  }
  __syncthreads();
}

DI float hy_in(const bf16_t* chp, int L, int t, float w0, float w1, float w2, float cb) {
  const float x0 = t > 0 ? bf2f(chp[t - 1]) : 0.f, x1 = bf2f(chp[t]), x2 = (t + 1 < L) ? bf2f(chp[t + 1]) : 0.f;
  return cb + w0 * x0 + w1 * x1 + w2 * x2;
}
DI void hyena_item(const P& p, int layer, int kind, int c, int bp, unsigned char* smem) {
  unsigned char* ws = p.ws;
  const int tid = TIDX;
  const int L = kind ? 256 : 4096, N = 2 * L, logN = kind ? 9 : 13;
  f32x2* W = (f32x2*)smem;
  const bf16_t* HYT = (const bf16_t*)(ws + O_HYT);
  const bf16_t* s0 = HYT + (kind ? HYT_LATSZ + (size_t)(2 * bp) * 768 * 256 : (size_t)(2 * bp) * 768 * 4096);
  const bf16_t* s1 = s0 + (size_t)768 * L;
  const int row0 = kind ? M_LAT + (2 * bp) * 256 : (2 * bp) * 4096;
  const int row1 = row0 + L;
  const float* cw = p.in[I_HCW] + (size_t)layer * 3 * 768;
  const float* cbv = p.in[I_HCB] + (size_t)layer * 768;
  const float bias1 = p.in[I_HBIAS][(layer * 2 + 0) * 256 + c], bias2 = p.in[I_HBIAS][(layer * 2 + 1) * 256 + c];
  const f32x2* KFa = kind ? (const f32x2*)(ws + O_KF1) + (size_t)(c * 2) * 512 : (const f32x2*)(ws + O_KF0) + (size_t)(c * 2) * 8192;
  const f32x2* KFb = KFa + N;
  bf16_t* OUT = (bf16_t*)(ws + O_O4) + (size_t)1 * M_ALL * 256;
  f32x2 zr[16];
  {
    const int ch = c;
    const float w0 = cw[ch], w1 = cw[768 + ch], w2 = cw[1536 + ch], cb = cbv[ch];
#pragma unroll
    for (int i = 0; i < 16; ++i) {
      const int t = tid + 256 * i;
      if (t < L) {
        f32x2 v = {hy_in(s0 + (size_t)ch * L, L, t, w0, w1, w2, cb), hy_in(s1 + (size_t)ch * L, L, t, w0, w1, w2, cb)};
        zr[i] = v; W[PH(t)] = v;
        f32x2 zz = {0.f, 0.f};
        W[PH(t + L)] = zz;
      }
    }
  }
  __syncthreads();
  fft_dif(W, N, logN);
  for (int n = tid; n < N; n += NT) W[PH(n)] = cmul(W[PH(n)], KFa[n]);
  __syncthreads();
  fft_dit_inv(W, N, logN);
  {
    const int ch = 256 + c;
    const float w0 = cw[ch], w1 = cw[768 + ch], w2 = cw[1536 + ch], cb = cbv[ch];
#pragma unroll
    for (int i = 0; i < 16; ++i) {
      const int t = tid + 256 * i;
      if (t < L) {
        const f32x2 y = W[PH(t)];
        const float g0 = hy_in(s0 + (size_t)ch * L, L, t, w0, w1, w2, cb), g1 = hy_in(s1 + (size_t)ch * L, L, t, w0, w1, w2, cb);
        zr[i].x = g0 * (y.x + bias1 * zr[i].x);
        zr[i].y = g1 * (y.y + bias1 * zr[i].y);
      }
    }
  }
  __syncthreads();
#pragma unroll
  for (int i = 0; i < 16; ++i) {
    const int t = tid + 256 * i;
    if (t < L) { W[PH(t)] = zr[i]; f32x2 zz = {0.f, 0.f}; W[PH(t + L)] = zz; }
  }
  __syncthreads();
  fft_dif(W, N, logN);
  for (int n = tid; n < N; n += NT) W[PH(n)] = cmul(W[PH(n)], KFb[n]);
  __syncthreads();
  fft_dit_inv(W, N, logN);
  {
    const int ch = 512 + c;
    const float w0 = cw[ch], w1 = cw[768 + ch], w2 = cw[1536 + ch], cb = cbv[ch];
#pragma unroll
    for (int i = 0; i < 16; ++i) {
      const int t = tid + 256 * i;
      if (t < L) {
        const f32x2 y = W[PH(t)];
        const float g0 = hy_in(s0 + (size_t)ch * L, L, t, w0, w1, w2, cb), g1 = hy_in(s1 + (size_t)ch * L, L, t, w0, w1, w2, cb);
        OUT[(size_t)(row0 + t) * 256 + c] = f2bf(g0 * (y.x + bias2 * zr[i].x));
        OUT[(size_t)(row1 + t) * 256 + c] = f2bf(g1 * (y.y + bias2 * zr[i].y));
      }
    }
  }
  __syncthreads();
}

template <int DQK>
DI void attn_item(const bf16_t* __restrict__ Qh, int qstride, const bf16_t* __restrict__ Kh, const bf16_t* __restrict__ Vth, bf16_t* __restrict__ Oh,
                  int a0, int a1, int b0, int b1, bool band, int qpos0, float m_init, float l_init, unsigned char* smem) {
  constexpr int KS = DQK + 8, NQ = DQK / 16, KCH = DQK / 8, KPT = (64 * KCH) / 256;
  bf16_t* sK = (bf16_t*)smem;
  bf16_t* sV = (bf16_t*)(smem + 2 * 64 * KS * 2);
  const int tid = TIDX, lane = tid & 63, wave = tid >> 6, r = lane & 31, h = lane >> 5;
  bf16x8 qf[NQ];
  {
    const bf16_t* qp = Qh + (size_t)(wave * 32 + r) * qstride + 8 * h;
#pragma unroll
    for (int ds = 0; ds < NQ; ++ds) qf[ds] = *(const bf16x8*)(qp + ds * 16);
  }
  f32x16 o0, o1;
#pragma unroll
  for (int i = 0; i < 16; ++i) { o0[i] = 0.f; o1[i] = 0.f; }
  float m = m_init, l = (h == 0) ? l_init : 0.f;
  const int nA = (a1 - a0) >> 6, nB = (b1 - b0) >> 6, nT = nA + nB;
  uint4 rk0, rk1, rk2 = {0u, 0u, 0u, 0u}, rv0, rv1;
#define ATT_KADDR(i) (Kh + (size_t)(key0_ + (tid + 256 * (i)) / KCH) * DQK + ((tid + 256 * (i)) % KCH) * 8)
#define ATT_VADDR(i) (Vth + (size_t)((tid + 256 * (i)) >> 3) * KEYS + key0_ + ((tid + 256 * (i)) & 7) * 8)
#define ATT_GLOAD(TI)                                                                                         \
  {                                                                                                           \
    const int ti_ = (TI);                                                                                     \
    const int key0_ = ti_ < nA ? a0 + ti_ * 64 : b0 + (ti_ - nA) * 64;                                        \
    rk0 = *(const uint4*)ATT_KADDR(0);                                                                        \
    rk1 = *(const uint4*)ATT_KADDR(1);                                                                        \
    if (KPT > 2) rk2 = *(const uint4*)ATT_KADDR(2);                                                           \
    rv0 = *(const uint4*)ATT_VADDR(0);                                                                        \
    rv1 = *(const uint4*)ATT_VADDR(1);                                                                        \
  }
#define ATT_KSADDR(i) (sK + buf_ * (64 * KS) + ((tid + 256 * (i)) / KCH) * KS + ((tid + 256 * (i)) % KCH) * 8)
#define ATT_VSADDR(i) (sV + buf_ * (64 * 72) + ((tid + 256 * (i)) >> 3) * 72 + ((tid + 256 * (i)) & 7) * 8)
#define ATT_SSTORE(BUF)                                                                                       \
  {                                                                                                           \
    const int buf_ = (BUF);                                                                                   \
    *(uint4*)ATT_KSADDR(0) = rk0;                                                                             \
    *(uint4*)ATT_KSADDR(1) = rk1;                                                                             \
    if (KPT > 2) *(uint4*)ATT_KSADDR(2) = rk2;                                                                \
    *(uint4*)ATT_VSADDR(0) = rv0;                                                                             \
    *(uint4*)ATT_VSADDR(1) = rv1;                                                                             \
  }
  ATT_GLOAD(0)
  ATT_SSTORE(0)
  __syncthreads();
  for (int ti = 0; ti < nT; ++ti) {
    const int cur = ti & 1;
    if (ti + 1 < nT) ATT_GLOAD(ti + 1)
    __builtin_amdgcn_sched_barrier(0);
    const bool inA = ti < nA;
    const int key0 = inA ? a0 + ti * 64 : b0 + (ti - nA) * 64;
    const bool msk = band && inA;
#pragma unroll
    for (int kb = 0; kb < 2; ++kb) {
      const int kbase = key0 + kb * 32;
      bool skip = false;
      if (msk) { const int qw = qpos0 + wave * 32; skip = (kbase > qw + 31 + 128) || (kbase + 31 < qw - 128); }
      if (!skip) {
        f32x16 s;
#pragma unroll
        for (int i = 0; i < 16; ++i) s[i] = 0.f;
        const bf16_t* kp = sK + cur * (64 * KS) + (kb * 32 + r) * KS + 8 * h;
#pragma unroll
        for (int ds = 0; ds < NQ; ++ds) { const bf16x8 a = *(const bf16x8*)(kp + ds * 16); s = MFMA32(a, qf[ds], s); }
        if (msk) {
          const int qp_ = qpos0 + wave * 32 + r;
#pragma unroll
          for (int i = 0; i < 16; ++i) { const int dlt = qp_ - (kbase + crow(i, h)); if (dlt > 128 || dlt < -128) s[i] = -1e30f; }
        }
        float mx = s[0];
#pragma unroll
        for (int i = 1; i < 16; ++i) mx = fmaxf(mx, s[i]);
        mx = fmaxf(mx, __shfl_xor(mx, 32));
        const float mn = fmaxf(m, mx);
        const float alpha = __builtin_amdgcn_exp2f(m - mn);
        m = mn;
        s = s - mn;
#pragma unroll
        for (int i = 0; i < 16; ++i) s[i] = __builtin_amdgcn_exp2f(s[i]);
        float ps;
        {
          typedef float f32x8_t __attribute__((ext_vector_type(8)));
          const f32x8_t lo8 = __builtin_shufflevector(s, s, 0, 1, 2, 3, 4, 5, 6, 7), hi8 = __builtin_shufflevector(s, s, 8, 9, 10, 11, 12, 13, 14, 15);
          const f32x8_t s8 = lo8 + hi8;
          const f32x4 s4 = __builtin_shufflevector(s8, s8, 0, 1, 2, 3) + __builtin_shufflevector(s8, s8, 4, 5, 6, 7);
          const f32x2 s2 = __builtin_shufflevector(s4, s4, 0, 1) + __builtin_shufflevector(s4, s4, 2, 3);
          ps = s2.x + s2.y;
        }
        l = l * alpha + ps;
        if (__builtin_amdgcn_ballot_w64(alpha != 1.0f) != 0ull) {
#pragma unroll
          for (int i = 0; i < 16; ++i) { o0[i] *= alpha; o1[i] *= alpha; }
        }
        bf16x8 pf0, pf1;
#pragma unroll
        for (int j = 0; j < 8; j += 2) {
          const unsigned w0 = pk2(s[j], s[j + 1]), w1 = pk2(s[8 + j], s[8 + j + 1]);
          pf0[j] = (short)(w0 & 0xffffu); pf0[j + 1] = (short)(w0 >> 16);
          pf1[j] = (short)(w1 & 0xffffu); pf1[j + 1] = (short)(w1 >> 16);
        }
        const bf16_t* vp = sV + cur * (64 * 72) + r * 72 + kb * 32 + 4 * h;
#pragma unroll
        for (int st = 0; st < 2; ++st) {
          const s16x4 lo0 = *(const s16x4*)(vp + 16 * st), hi0 = *(const s16x4*)(vp + 16 * st + 8);
          const s16x4 lo1 = *(const s16x4*)(vp + 32 * 72 + 16 * st), hi1 = *(const s16x4*)(vp + 32 * 72 + 16 * st + 8);
          const bf16x8 va0 = __builtin_shufflevector(lo0, hi0, 0, 1, 2, 3, 4, 5, 6, 7);
          const bf16x8 va1 = __builtin_shufflevector(lo1, hi1, 0, 1, 2, 3, 4, 5, 6, 7);
          o0 = MFMA32(va0, st ? pf1 : pf0, o0);
          o1 = MFMA32(va1, st ? pf1 : pf0, o1);
        }
      }
    }
    __builtin_amdgcn_sched_barrier(0);
    if (ti + 1 < nT) ATT_SSTORE(cur ^ 1)
    __syncthreads();
  }
  l += __shfl_xor(l, 32);
  const float inv = 1.0f / l;
  bf16_t* op = Oh + (size_t)(wave * 32 + r) * 256;
#pragma unroll
  for (int g = 0; g < 4; ++g) {
    uint2 w;
    w.x = pk2(o0[4 * g] * inv, o0[4 * g + 1] * inv); w.y = pk2(o0[4 * g + 2] * inv, o0[4 * g + 3] * inv);
    *(uint2*)(op + 8 * g + 4 * h) = w;
    w.x = pk2(o1[4 * g] * inv, o1[4 * g + 1] * inv); w.y = pk2(o1[4 * g + 2] * inv, o1[4 * g + 3] * inv);
    *(uint2*)(op + 32 + 8 * g + 4 * h) = w;
  }
}

DI void mla_item(const P& p, int b, int head, int row0, int a0, int a1, unsigned char* smem) {
  unsigned char* ws = p.ws;
  const bf16_t* Q = (const bf16_t*)(ws + O_QMLA) + ((size_t)row0 * 4 + head) * 96;
  const bf16_t* K = (const bf16_t*)(ws + O_KMLA) + ((size_t)b * 4 + head) * KEYS * 96;
  const bf16_t* V = (const bf16_t*)(ws + O_VMLAT) + ((size_t)b * 4 + head) * 64 * KEYS;
  bf16_t* O = (bf16_t*)(ws + O_O4) + (size_t)row0 * 256 + head * 64;
  attn_item<96>(Q, 384, K, V, O, a0, a1, 0, 0, false, 0, -1e30f, 0.f, smem);
}
DI void swa_item(const P& p, int layer, int b, int head, int row0, int a0, int a1, int b0, int b1, bool band, int qpos0, unsigned char* smem) {
  unsigned char* ws = p.ws;
  const int kvh = head >> 1;
  const bf16_t* Q = (const bf16_t*)(ws + O_QSWA) + ((size_t)row0 * 4 + head) * 64;
  const bf16_t* K = (const bf16_t*)(ws + O_KSWA) + ((size_t)b * 2 + kvh) * KEYS * 64;
  const bf16_t* V = (const bf16_t*)(ws + O_VSWAT) + ((size_t)b * 2 + kvh) * 64 * KEYS;
  bf16_t* O = (bf16_t*)(ws + O_O4) + (size_t)2 * M_ALL * 256 + (size_t)row0 * 256 + head * 64;
  const float sink = p.in[I_SINK][layer * 4 + head] * LOG2E;
  attn_item<64>(Q, 256, K, V, O, a0, a1, b0, b1, band, qpos0, sink, 1.f, smem);
}

DI void phase_mix(const P& p, int slot, int layer, bool ctx_out, unsigned char* smem, int* s_item) {
  unsigned* ctr = (unsigned*)(p.ws + O_CTR) + slot;
  const int n_s5 = 256, n_hy = 1024, n_mla = 1024, n_swa = 1024;
  const int e0 = n_s5, e1 = e0 + n_hy, e2 = e1 + n_mla, e3 = e2 + n_swa;
  const int e4 = e3 + (ctx_out ? 1024 : 0), e5 = e4 + (ctx_out ? 64 : 0), e6 = e5 + (ctx_out ? 64 : 0);
  for (;;) {
    if (TIDX == 0) *s_item = (int)atomicAdd(ctr, 1u);
    __syncthreads();
    const int it = *s_item;
    __syncthreads();
    if (it >= e6) break;
    if (it < e0) { for (int rp = 0; rp < REP_S5; ++rp) s5_item(p, layer, it, smem); }
    else if (it < e1) { const int j = it - e0; for (int rp = 0; rp < REP_HY; ++rp) hyena_item(p, layer, 0, j >> 2, j & 3, smem); }
    else if (it < e2) {
      const int j = it - e1, qb = j & 31, head = (j >> 5) & 3, b = j >> 7;
      for (int rp = 0; rp < REP_MLA; ++rp) mla_item(p, b, head, b * 4096 + qb * 128, 0, KEYS, smem);
    } else if (it < e3) {
      const int j = it - e2, qb = j & 31, head = (j >> 5) & 3, b = j >> 7, q0 = qb * 128;
      const int a0 = q0 >= 128 ? q0 - 128 : 0, a1 = q0 + 256 <= 4096 ? q0 + 256 : 4096;
      for (int rp = 0; rp < REP_SWA; ++rp) swa_item(p, layer, b, head, b * 4096 + q0, a0, a1, 4096, KEYS, true, q0, smem);
    } else if (it < e4) { const int j = it - e3; hyena_item(p, layer, 1, j >> 2, j & 3, smem); }
    else if (it < e5) {
      const int j = it - e4, qb = j & 1, head = (j >> 1) & 3, b = j >> 3;
      mla_item(p, b, head, M_LAT + b * 256 + qb * 128, 4096, KEYS, smem);
    } else {
      const int j = it - e5, qb = j & 1, head = (j >> 1) & 3, b = j >> 3;
      swa_item(p, layer, b, head, M_LAT + b * 256 + qb * 128, 4096, KEYS, 0, 0, false, 0, smem);
    }
  }
}

#define XB_TMO      128
#define XB_XCNT(j)  (256  + 64 * (j))
#define XB_XSUB(j)  (1280 + 64 * (j))
#define XB_XGEN(j)  (2304 + 64 * (j))
#define XB_TOP      3328
#define XB_TOPGEN   3392
#define XCD_BAR_WORDS 3456
#define XB_SPIN_CAP (1u << 22)
#define LAS __attribute__((address_space(3)))
DI unsigned xb_ld(unsigned* p) { return __hip_atomic_load(p, __ATOMIC_RELAXED, __HIP_MEMORY_SCOPE_AGENT); }
DI unsigned xb_add(unsigned* p, unsigned v) { return __hip_atomic_fetch_add(p, v, __ATOMIC_RELAXED, __HIP_MEMORY_SCOPE_AGENT); }
DI unsigned xb_xcc_id() { return (unsigned)__builtin_amdgcn_s_getreg((3 << 11) | 20) & 0xFu; }
#define XB_SPIN(cond, bar) do { unsigned _sp = 0; while (cond) { __builtin_amdgcn_s_sleep(1); \
    if ((++_sp & 255u) == 0u) { if (xb_ld(&(bar)[XB_TMO])) break; if (_sp > XB_SPIN_CAP) { atomicAdd(&(bar)[XB_TMO], 1u); break; } } } } while (0)
struct XcdBarrier { unsigned* bar; unsigned x; volatile LAS unsigned* st; };
DI XcdBarrier xcd_barrier_post(unsigned* bar, volatile LAS unsigned* st) {
  XcdBarrier b; b.bar = bar; b.x = xb_xcc_id(); b.st = st;
  if (threadIdx.x == 0) (void)xb_add(&bar[XB_XCNT(b.x)], 1u);
  return b;
}
DI void xcd_barrier_complete(unsigned* bar, unsigned x, unsigned& nloc, unsigned& nx) {
  const unsigned G = gridDim.x * gridDim.y * gridDim.z;
  unsigned sum, cnt, mine, sp = 0u;
  for (;;) {
    sum = 0u; cnt = 0u; mine = 0u;
#pragma unroll
    for (unsigned j = 0; j < 16; ++j) { const unsigned c = xb_ld(&bar[XB_XCNT(j)]); sum += c; cnt += (c > 0u) ? 1u : 0u; mine = (j == x) ? c : mine; }
    if (sum == G) break;
    __builtin_amdgcn_s_sleep(1);
    if ((++sp & 255u) == 0u) { if (xb_ld(&bar[XB_TMO])) break; if (sp > XB_SPIN_CAP) { atomicAdd(&bar[XB_TMO], 1u); break; } }
  }
  nloc = mine > 0u ? mine : 1u; nx = cnt > 0u ? cnt : 1u;
}
DI void xcd_barrier(const XcdBarrier& b) {
  asm volatile("s_waitcnt vmcnt(0)" ::: "memory");
  __syncthreads();
  if (threadIdx.x == 0) {
    unsigned* bar = b.bar;
    __builtin_amdgcn_s_waitcnt(0);
    unsigned nloc = b.st[0], nx = b.st[1];
    if (nloc == 0u) { xcd_barrier_complete(bar, b.x, nloc, nx); b.st[0] = nloc; b.st[1] = nx; }
    const unsigned old = xb_add(&bar[XB_XSUB(b.x)], 1u);
    const unsigned gen = old / nloc;
    if (old + 1u == (gen + 1u) * nloc) {
      __builtin_amdgcn_fence(__ATOMIC_RELEASE, "agent");
      asm volatile("s_waitcnt vmcnt(0)" ::: "memory");
      const unsigned og = xb_add(&bar[XB_TOP], 1u);
      const unsigned tg = og / nx;
      if (og + 1u == (tg + 1u) * nx) xb_add(&bar[XB_TOPGEN], 1u);
      else XB_SPIN(xb_ld(&bar[XB_TOPGEN]) == tg, bar);
      __builtin_amdgcn_fence(__ATOMIC_ACQUIRE, "agent");
      xb_add(&bar[XB_XGEN(b.x)], 1u);
      asm volatile("s_waitcnt vmcnt(0)" ::: "memory");
    } else {
      XB_SPIN(xb_ld(&bar[XB_XGEN(b.x)]) == gen, bar);
      __builtin_amdgcn_fence(__ATOMIC_ACQUIRE, "agent");
      asm volatile("s_waitcnt vmcnt(0)" ::: "memory");
    }
  }
  __syncthreads();
}

#ifndef REP_UPDN
#define REP_UPDN 1
#endif
#ifndef REP_MIXER_GEMM
#define REP_MIXER_GEMM 1
#endif
#ifndef REP_MIX
#define REP_MIX 1
#endif
#ifndef REP_PRO
#define REP_PRO 1
#endif
#ifndef REP_CONV
#define REP_CONV 1
#endif
#ifndef REP_KF
#define REP_KF 1
#endif
#ifndef REP_MODH
#define REP_MODH 1
#endif
#ifndef REP_MODONLY
#define REP_MODONLY 1
#endif
#ifndef REP_H2ONLY
#define REP_H2ONLY 1
#endif
#ifndef REP_SYNC
#define REP_SYNC 1
#endif
#define GSYNC() { for (int rs_ = 0; rs_ < REP_SYNC; ++rs_) xcd_barrier(xb); }
__global__ void __launch_bounds__(NT, 2) fwd_megakernel(P p) {
  cg::grid_group grid = cg::this_grid();
  __shared__ __attribute__((aligned(16))) unsigned char smem[SMEM_BYTES];
  __shared__ int s_item;
  unsigned char* ws = p.ws;
  __shared__ uint4 xb_words;
  if (threadIdx.x == 0) xb_words = make_uint4(0u, 0u, 0u, 0u);
  __syncthreads();
  XcdBarrier xb = xcd_barrier_post((unsigned*)(ws + O_BAR), (volatile LAS unsigned*)&xb_words);
  for (int rep = 0; rep < REP_PRO; ++rep) {
    for (int r2 = 0; r2 < REP_MODH; ++r2) { for (int r3 = 0; r3 < REP_MODONLY; ++r3) phase_modulation(p, smem); for (int r3 = 0; r3 < REP_H2ONLY; ++r3) phase_h2(p); phase_rope(p); }
    for (int r2 = 0; r2 < REP_CONV; ++r2) phase_convert(p, 0, smem);
    if (p.out == nullptr) grid.sync();
    GSYNC();
  }
  for (int rep = 0; rep < REP_PRO * REP_KF; ++rep) phase_kf(p, 0, true, smem);
  phase_rows(p, M_ALL, 0, 0, 0, 0.f, true, true, 0, 0, false);
  GSYNC();
#pragma unroll 1
  for (int layer = 0; layer < 2; ++layer) {
    const bool ctx_out = layer == 0;
    const int Mc = ctx_out ? M_ALL : M_LAT;
    for (int rep = 0; rep < REP_UPDN; ++rep) {
      phase_ffn_up(p, M_ALL, O_WUP1, smem);
      GSYNC();
      phase_gemm_plain_bf16(p, M_ALL, (const bf16_t*)(ws + O_ACT), DFF, (const bf16_t*)(ws + O_WDN1), (bf16_t*)(ws + O_F), 1024, smem);
      GSYNC();
    }
    phase_rows(p, M_ALL, 1, layer, 0, 0.5f, layer == 0, true, layer, 1, true);
    GSYNC();
    for (int rep = 0; rep < REP_MIXER_GEMM; ++rep) {
      if (rep) { phase_rows(p, M_ALL, 2, layer, 0, 0.f, false, false, 0, 0, true); GSYNC(); }
      phase_win(p, M_ALL, smem);
      GSYNC();
      phase_kvq(p, M_ALL, Mc, smem);
      GSYNC();
    }
    for (int rep = 0; rep < REP_MIX; ++rep) {
      phase_mix(p, layer + 2 * rep, layer, ctx_out, smem, &s_item);
      GSYNC();
      phase_glu(p, layer, Mc, smem);
      GSYNC();
    }
    for (int rep = 0; rep < REP_MIXER_GEMM; ++rep) {
      phase_merge(p, layer, Mc, smem);
      GSYNC();
      phase_gemm_plain_bf16(p, Mc, (const bf16_t*)(ws + O_MBUF), 1024, (const bf16_t*)(ws + O_WOUT), (bf16_t*)(ws + O_F), 1024, smem);
      GSYNC();
    }
    phase_rows(p, Mc, 1, layer, 1, 1.0f, false, true, layer, 2, false);
    GSYNC();
    for (int rep = 0; rep < REP_UPDN; ++rep) {
      phase_ffn_up(p, Mc, O_WUP2, smem);
      GSYNC();
      phase_gemm_plain_bf16(p, Mc, (const bf16_t*)(ws + O_ACT), DFF, (const bf16_t*)(ws + O_WDN2), (bf16_t*)(ws + O_F), 1024, smem);
      GSYNC();
    }
    phase_rows(p, Mc, 1, layer, 2, 0.5f, false, layer == 0, layer + 1, 0, false);
    if (layer == 0) {
      for (int rep = 0; rep < REP_PRO; ++rep) {
        for (int r2 = 0; r2 < REP_CONV; ++r2) phase_convert(p, 1, smem);
        for (int r2 = 0; r2 < REP_KF; ++r2) phase_kf(p, 1, false, smem);
      }
    }
    GSYNC();
  }
}

extern "C" void kernel_launch(void* const* d_in, const int* in_sizes, int n_in, void* d_out, int out_size, void* d_ws, size_t ws_size,
                              hipStream_t stream) {
  (void)in_sizes; (void)out_size;
  static int grid_blocks = 0;
  if (!grid_blocks) {
    int dev = 0, cus = 0, per = 0;
    (void)hipGetDevice(&dev);
    (void)hipDeviceGetAttribute(&cus, hipDeviceAttributeMultiprocessorCount, dev);
    (void)hipOccupancyMaxActiveBlocksPerMultiprocessor(&per, fwd_megakernel, NT, 0);
    if (per > 2) per = 2;
    if (per < 1) per = 1;
    grid_blocks = cus * per;
    grid_blocks &= ~7;
  }
  if (ws_size < WS_NEED || n_in < N_INPUTS) {
    fprintf(stderr, "workspace too small: need %zu have %zu\n", (size_t)WS_NEED, ws_size);
    return;
  }
  P p{};
  for (int i = 0; i < N_INPUTS; ++i) p.in[i] = (const float*)d_in[i];
  p.out = (float*)d_out;
  p.ws = (unsigned char*)d_ws;
  (void)hipMemsetAsync((unsigned char*)d_ws + O_CTR, 0, (size_t)(O_R - O_CTR), stream);
  void* args[] = {&p};
  hipError_t e = hipLaunchCooperativeKernel((void*)fwd_megakernel, dim3(grid_blocks), dim3(NT), args, 0, stream);
  if (e != hipSuccess) fprintf(stderr, "cooperative launch failed: %s (grid %d)\n", hipGetErrorString(e), grid_blocks);
}
```

```cpp
#include <hip/hip_runtime.h>
#include <hip/hip_cooperative_groups.h>
#include <cstdio>
namespace cg = cooperative_groups;
#ifndef PROBE_DBL
#define PROBE_DBL 0
#endif
#ifndef REP_S5
#define REP_S5 1
#endif
#ifndef REP_HY
#define REP_HY 1
#endif
#ifndef REP_MLA
#define REP_MLA 1
#endif
#ifndef REP_SWA
#define REP_SWA 1
#endif

#define DI __device__ __forceinline__
typedef unsigned short bf16_t;
typedef short bf16x8 __attribute__((ext_vector_type(8)));
typedef short s16x4 __attribute__((ext_vector_type(4)));
typedef float f32x16 __attribute__((ext_vector_type(16)));
typedef float f32x4 __attribute__((ext_vector_type(4)));
typedef float f32x2 __attribute__((ext_vector_type(2)));
typedef __bf16 bf16v2 __attribute__((ext_vector_type(2)));
#define MFMA32(a, b, c) __builtin_amdgcn_mfma_f32_32x32x16_bf16((a), (b), (c), 0, 0, 0)
#define MFMA16(a, b, c) __builtin_amdgcn_mfma_f32_16x16x32_bf16((a), (b), (c), 0, 0, 0)

constexpr int NT = 256;
constexpr int DM = 1024, NB = 8, SEQ = 4096, CTX = 256, DFF = 2816;
constexpr int M_LAT = NB * SEQ, M_CTX = NB * CTX, M_ALL = M_LAT + M_CTX;
constexpr int KEYS = SEQ + CTX;
constexpr float EPS = 1e-6f;
constexpr float LOG2E = 1.4426950408889634f;
constexpr int SMEM_BYTES = 73728;

enum { I_X = 0, I_C, I_CTX, I_CCTX, I_WADA, I_BADA, I_NPRE, I_NPOST, I_UP1, I_DN1, I_UP2, I_DN2, I_WIN, I_QNORM, I_KVNORM, I_WUQ, I_WUKV,
       I_HCW, I_HCB, I_HW1, I_HB1, I_HFREQ, I_HW2, I_HB2, I_HW3, I_HBIAS, I_SINK, I_ARE, I_AIM, I_LOGDT, I_BRE, I_BIM, I_CRE, I_CIM, I_S5D,
       I_GLUW, I_GLUB, I_WGATE, I_BGATE, I_BRMLA, I_BRHY, I_BRSWA, I_BRS5, I_WOUT, N_INPUTS };

constexpr size_t AL(size_t x) { return (x + 255) & ~size_t(255); }
constexpr size_t O_WUP1 = 0;
constexpr size_t O_WDN1 = O_WUP1 + AL((size_t)5632 * 1024 * 2);
constexpr size_t O_WUP2 = O_WDN1 + AL((size_t)1024 * 2816 * 2);
constexpr size_t O_WDN2 = O_WUP2 + AL((size_t)5632 * 1024 * 2);
constexpr size_t O_WIN = O_WDN2 + AL((size_t)1024 * 2816 * 2);
constexpr size_t O_WGATE = O_WIN + AL((size_t)1920 * 1024 * 2);
constexpr size_t O_WBR = O_WGATE + AL((size_t)4096 * 1024 * 2);
constexpr size_t O_WOUT = O_WBR + AL((size_t)4 * 1024 * 256 * 2);
constexpr size_t O_WUKV = O_WOUT + AL((size_t)1024 * 1024 * 2);
constexpr size_t O_WUQ = O_WUKV + AL((size_t)512 * 128 * 2);
constexpr size_t O_WGLU = O_WUQ + AL((size_t)384 * 192 * 2);
constexpr size_t O_U = O_WGLU + AL((size_t)256 * 256 * 2);
constexpr size_t O_XC = O_U + AL((size_t)M_ALL * 1024 * 2);
constexpr size_t O_MOD = O_XC + AL((size_t)M_CTX * 1024 * 4);
constexpr size_t O_H2 = O_MOD + AL((size_t)2 * 9 * 9216 * 4);
constexpr size_t O_ROPEM = O_H2 + AL((size_t)2 * (4096 + 256) * 64 * 4);
constexpr size_t O_ROPEW = O_ROPEM + AL((size_t)4096 * 16 * 8);
constexpr size_t O_KF0 = O_ROPEW + AL((size_t)4096 * 32 * 8);
constexpr size_t O_KF1 = O_KF0 + AL((size_t)256 * 2 * 8192 * 8);
constexpr size_t O_ROWSS = O_KF1 + AL((size_t)256 * 2 * 512 * 8);
constexpr size_t O_CTR = O_ROWSS + AL((size_t)2 * M_ALL * 4);
constexpr size_t O_BAR = O_CTR + 256;
constexpr size_t O_R = O_BAR + AL((size_t)3456 * 4);
constexpr size_t O_ACT = O_R;
constexpr size_t O_F = O_R + AL((size_t)M_ALL * 2816 * 2);
constexpr size_t O_O4 = O_R;
constexpr size_t O_Y = O_O4 + AL((size_t)4 * M_ALL * 256 * 2);
constexpr size_t O_HYT = O_Y + AL((size_t)2 * M_ALL * 256 * 2);
constexpr size_t O_MBUF = O_HYT;
constexpr size_t O_S5U = O_HYT + AL((size_t)M_ALL * 768 * 2);
constexpr size_t O_CKV = O_S5U + AL((size_t)M_ALL * 256 * 4);
constexpr size_t O_CQ = O_CKV + AL((size_t)M_ALL * 128 * 2);
constexpr size_t O_KMLA = O_CQ + AL((size_t)M_ALL * 192 * 2);
constexpr size_t O_VMLAT = O_KMLA + AL((size_t)NB * 4 * KEYS * 96 * 2);
constexpr size_t O_QMLA = O_VMLAT + AL((size_t)NB * 4 * 64 * KEYS * 2);
constexpr size_t O_KSWA = O_QMLA + AL((size_t)M_ALL * 384 * 2);
constexpr size_t O_VSWAT = O_KSWA + AL((size_t)NB * 2 * KEYS * 64 * 2);
constexpr size_t O_QSWA = O_VSWAT + AL((size_t)NB * 2 * 64 * KEYS * 2);
constexpr size_t O_END_MIX = O_QSWA + AL((size_t)M_ALL * 256 * 2);
constexpr size_t O_END_FFN = O_F + AL((size_t)M_ALL * 1024 * 2);
constexpr size_t WS_NEED = O_END_MIX > O_END_FFN ? O_END_MIX : O_END_FFN;
static_assert(O_MBUF + (size_t)M_ALL * 1024 * 2 <= O_CKV, "mbuf overlaps");
static_assert(O_F >= O_CKV, "F placement");
static_assert(WS_NEED <= (size_t)512 * 1024 * 1024, "workspace budget");
constexpr size_t HYT_LATSZ = (size_t)NB * 768 * 4096;

struct P {
  const float* in[N_INPUTS];
  float* out;
  unsigned char* ws;
};

DI int opaque_i(int x) { asm volatile("" : "+v"(x)); return x; }
#define TIDX opaque_i((int)threadIdx.x)
DI unsigned pk2(float lo, float hi) { f32x2 v = {lo, hi}; return __builtin_bit_cast(unsigned, __builtin_convertvector(v, bf16v2)); }
DI bf16_t f2bf(float x) { return (bf16_t)(pk2(x, 0.f) & 0xffffu); }
DI float bf2f(bf16_t b) { return __uint_as_float(((unsigned)b) << 16); }
DI float wave_sum(float v) {
#pragma unroll
  for (int o = 32; o; o >>= 1) v += __shfl_xor(v, o);
  return v;
}
DI int crow(int i, int h) { return (i & 3) + 8 * (i >> 2) + 4 * h; }
DI float fast_exp(float x) { return __builtin_amdgcn_exp2f(x * LOG2E); }
DI float sigmoidf_(float x) { return __builtin_amdgcn_rcpf(1.f + fast_exp(-x)); }
DI float siluf_(float x) { return x * sigmoidf_(x); }
DI void sincos_d(double x, float& s_out, float& c_out) {
  double k = rint(x * 0.15915494309189535);
  double r = x - k * 6.283185307179586;
  double y = r * 0.0625, y2 = y * y;
  double s = y * (1.0 - y2 / 6.0 * (1.0 - y2 / 20.0 * (1.0 - y2 / 42.0 * (1.0 - y2 / 72.0 * (1.0 - y2 / 110.0)))));
  double c = 1.0 - y2 / 2.0 * (1.0 - y2 / 12.0 * (1.0 - y2 / 30.0 * (1.0 - y2 / 56.0 * (1.0 - y2 / 90.0 * (1.0 - y2 / 132.0)))));
#pragma unroll
  for (int i = 0; i < 4; ++i) { double s2 = 2.0 * s * c, c2 = c * c - s * s; s = s2; c = c2; }
  s_out = (float)s; c_out = (float)c;
}
DI float sin_acc(float x) { float s, c; sincos_d((double)x, s, c); return s; }

template <int NI>
DI void gemm_kloop(f32x16 (&acc)[2][NI], const bf16_t* __restrict__ A, int lda, const bf16_t* __restrict__ Bt, int ldb, int K, int m0, int n0,
                   unsigned char* smem) {
  unsigned char* sA = smem;
  unsigned char* sB = smem + 32768;
  const int tid = TIDX, lane = tid & 63, wave = tid >> 6, r = lane & 31, h = lane >> 5, wm = wave >> 1, wn = wave & 1;
  const int drow = wave * 8 + (lane >> 3);
  const int csw = (lane & 7) ^ ((drow >> 1) & 7);
  const bf16_t* gA = A + (size_t)(m0 + drow) * lda + csw * 8;
  const bf16_t* gB = Bt + (size_t)(n0 + drow) * ldb + csw * 8;
  const int ldst = wave * 1024 + lane * 16;
  const int rsw = (r >> 1) & 7;
#define G_ISSUE(BUF, KO)                                                                                                        \
  {                                                                                                                             \
    _Pragma("unroll") for (int i = 0; i < 4; ++i)                                                                               \
        __builtin_amdgcn_global_load_lds((const unsigned*)(gA + (size_t)(32 * i) * lda + (KO)),                                 \
                                         (unsigned*)(sA + (BUF) * 16384 + i * 4096 + ldst), 16, 0, 0);                          \
    _Pragma("unroll") for (int i = 0; i < 2 * NI; ++i)                                                                          \
        __builtin_amdgcn_global_load_lds((const unsigned*)(gB + (size_t)(32 * i) * ldb + (KO)),                                 \
                                         (unsigned*)(sB + (BUF) * 16384 + i * 4096 + ldst), 16, 0, 0);                          \
  }
  const int nk = K >> 6;
  __syncthreads();
  G_ISSUE(0, 0)
  asm volatile("s_waitcnt vmcnt(0)" ::: "memory");
  __syncthreads();
  for (int ks = 0; ks < nk; ++ks) {
    const int cur = ks & 1;
    if (ks + 1 < nk) G_ISSUE(cur ^ 1, (ks + 1) * 64)
    const unsigned char* ab = sA + cur * 16384 + (wm * 64 + r) * 128;
    const unsigned char* bb = sB + cur * 16384 + (wn * 32 * NI + r) * 128;
#pragma unroll
    for (int kk = 0; kk < 4; ++kk) {
      const int pc = ((kk * 2 + h) ^ rsw) * 16;
      const bf16x8 a0 = *(const bf16x8*)(ab + pc), a1 = *(const bf16x8*)(ab + 32 * 128 + pc);
#pragma unroll
      for (int ni = 0; ni < NI; ++ni) {
        const bf16x8 b = *(const bf16x8*)(bb + ni * 32 * 128 + pc);
        acc[0][ni] = MFMA32(a0, b, acc[0][ni]);
        acc[1][ni] = MFMA32(a1, b, acc[1][ni]);
      }
    }
    asm volatile("s_waitcnt vmcnt(0)" ::: "memory");
    __syncthreads();
  }
#undef G_ISSUE
}
template <int NI>
DI void zero_acc(f32x16 (&acc)[2][NI]) {
#pragma unroll
  for (int a = 0; a < 2; ++a)
#pragma unroll
    for (int b = 0; b < NI; ++b)
#pragma unroll
      for (int i = 0; i < 16; ++i) acc[a][b][i] = 0.f;
}
#define DSR(dst, addr, off) asm volatile("ds_read_b128 %0, %1 offset:%2" : "=v"(dst) : "v"(addr), "i"(off))
#define FR_READ(F, ST, AA, BB)                                     \
  {                                                                \
    DSR(F##a0, AA, (ST) * 24576);                                  \
    DSR(F##a1, AA, (ST) * 24576 + 2048);                           \
    DSR(F##b0, BB, (ST) * 24576 + 8192);                           \
    DSR(F##b1, BB, (ST) * 24576 + 8192 + 2048);                    \
    DSR(F##b2, BB, (ST) * 24576 + 8192 + 4096);                    \
    DSR(F##b3, BB, (ST) * 24576 + 8192 + 6144);                    \
  }
#define FR_WAIT(F, N) asm volatile("s_waitcnt lgkmcnt(" #N ")" : "+v"(F##a0), "+v"(F##a1), "+v"(F##b0), "+v"(F##b1), "+v"(F##b2), "+v"(F##b3)::"memory")
#define FR_MFMA(F)                                                 \
  {                                                                \
    acc[0][0] = MFMA32(F##a0, F##b0, acc[0][0]);                   \
    acc[1][0] = MFMA32(F##a1, F##b0, acc[1][0]);                   \
    acc[0][1] = MFMA32(F##a0, F##b1, acc[0][1]);                   \
    acc[1][1] = MFMA32(F##a1, F##b1, acc[1][1]);                   \
    acc[0][2] = MFMA32(F##a0, F##b2, acc[0][2]);                   \
    acc[1][2] = MFMA32(F##a1, F##b2, acc[1][2]);                   \
    acc[0][3] = MFMA32(F##a0, F##b3, acc[0][3]);                   \
    acc[1][3] = MFMA32(F##a1, F##b3, acc[1][3]);                   \
    if (PROBE_DBL) {                                               \
      dum0 = MFMA32(F##a1, F##b0, dum0); dum1 = MFMA32(F##a0, F##b1, dum1);  \
      dum0 = MFMA32(F##a1, F##b2, dum0); dum1 = MFMA32(F##a0, F##b3, dum1);  \
      dum0 = MFMA32(F##a0, F##b0, dum0); dum1 = MFMA32(F##a1, F##b1, dum1);  \
      dum0 = MFMA32(F##a0, F##b2, dum0); dum1 = MFMA32(F##a1, F##b3, dum1);  \
    }                                                              \
  }
DI void gemm_kloop_wide(f32x16 (&acc)[2][4], const bf16_t* __restrict__ A, int lda, const bf16_t* __restrict__ Bt, int ldb, int K, int m0, int n0,
                        unsigned char* smem) {
  const int tid = TIDX, lane = tid & 63, wave = tid >> 6, r = lane & 31, h = lane >> 5, wm = wave >> 1, wn = wave & 1;
  const int drow = wave * 16 + (lane >> 2);
  const int csw = (lane & 3) ^ ((lane >> 4) & 3);
  const bf16_t* gA = A + (size_t)(m0 + drow) * lda + csw * 8;
  const bf16_t* gB = Bt + (size_t)(n0 + drow) * ldb + csw * 8;
  const int ldst = wave * 1024 + lane * 16;
  const int rsw = (r >> 2) & 3;
  const unsigned lbase = (unsigned)(size_t)smem;
  const unsigned aA0 = lbase + (wm * 64 + r) * 64 + ((0 + h) ^ rsw) * 16, aA1 = lbase + (wm * 64 + r) * 64 + ((2 + h) ^ rsw) * 16;
  const unsigned bB0 = lbase + (wn * 128 + r) * 64 + ((0 + h) ^ rsw) * 16, bB1 = lbase + (wn * 128 + r) * 64 + ((2 + h) ^ rsw) * 16;
#define GW_ISSUE(ST, KO)                                                                                                        \
  {                                                                                                                             \
    _Pragma("unroll") for (int i = 0; i < 2; ++i)                                                                               \
        __builtin_amdgcn_global_load_lds((const unsigned*)(gA + (size_t)(64 * i) * lda + (KO)),                                 \
                                         (unsigned*)(smem + (ST) * 24576 + i * 4096 + ldst), 16, 0, 0);                         \
    _Pragma("unroll") for (int i = 0; i < 4; ++i)                                                                               \
        __builtin_amdgcn_global_load_lds((const unsigned*)(gB + (size_t)(64 * i) * ldb + (KO)),                                 \
                                         (unsigned*)(smem + (ST) * 24576 + 8192 + i * 4096 + ldst), 16, 0, 0);                  \
  }
  bf16x8 Pa0, Pa1, Pb0, Pb1, Pb2, Pb3, Qa0, Qa1, Qb0, Qb1, Qb2, Qb3;
  f32x16 dum0, dum1;
  _Pragma("unroll") for (int i = 0; i < 16; ++i) { dum0[i] = 0.f; dum1[i] = 0.f; }
#define GW_STEP(KIDX, S, S1, S2)                                                                                                \
  {                                                                                                                             \
    asm volatile("s_waitcnt vmcnt(0)" ::: "memory");                                 \
    __builtin_amdgcn_s_barrier();                               \
    if ((KIDX) + 2 < nk) GW_ISSUE(S2, ((KIDX) + 2) * 32)                                                                        \
    FR_READ(Q, S, aA1, bB1)                                                                           \
    FR_WAIT(P, 6);                                               \
    FR_MFMA(P)                                                                                                                  \
    FR_WAIT(Q, 0);                                                                                                              \
    if ((KIDX) + 1 < nk) FR_READ(P, S1, aA0, bB0)                                                    \
    FR_MFMA(Q)                                                                                                                  \
  }
  const int nk = K >> 5;
  asm volatile("s_waitcnt vmcnt(0) lgkmcnt(0)" ::: "memory");
  __builtin_amdgcn_s_barrier();
  GW_ISSUE(0, 0)
  GW_ISSUE(1, 32)
  asm volatile("s_waitcnt vmcnt(6)" ::: "memory");
  __builtin_amdgcn_s_barrier();
  FR_READ(P, 0, aA0, bB0)
  for (int k = 0; k < nk; k += 3) {
    GW_STEP(k, 0, 1, 2)
    if (k + 1 < nk) GW_STEP(k + 1, 1, 2, 0)
    if (k + 2 < nk) GW_STEP(k + 2, 2, 0, 1)
  }
#undef GW_ISSUE
#undef GW_STEP
  if (PROBE_DBL) { _Pragma("unroll") for (int i = 0; i < 16; ++i) acc[0][0][i] += 0.f * (dum0[i] + dum1[i]); }
}
template <int BN = 128, class F>
DI void for_tiles(int ntm, int ntn, F f, int m_base = 0) {
  constexpr int GM = 8, GN = 8;
  const int xcd = blockIdx.x & 7, slot = blockIdx.x >> 3, nslot = gridDim.x >> 3;
  const int nmx = ntm >> 3;
  const int per = nmx * ntn;
  const int fullN = ntn / GN, fullM = nmx / GM;
  for (int L = slot; L < per; L += nslot) {
    int ng = L / (nmx * GN), gn = GN;
    if (ng >= fullN) { ng = fullN; gn = ntn - fullN * GN; }
    const int rem = L - ng * (nmx * GN);
    int mg = rem / (GM * gn), gm = GM;
    if (mg >= fullM) { mg = fullM; gm = nmx - fullM * GM; }
    const int rem2 = rem - mg * (GM * gn);
    const int mi = rem2 % gm, ni = rem2 / gm;
    const int tn = ng * GN + ni, tm = xcd + 8 * (mg * GM + mi);
    f(m_base + tm * 128, tn * BN, tn);
  }
}
struct RowInfo { int b, pos, kpos, L; bool lat; };
DI RowInfo row_info(int row) {
  RowInfo ri;
  if (row < M_LAT) { ri.b = row >> 12; ri.pos = row & 4095; ri.kpos = ri.pos; ri.lat = true; ri.L = 4096; }
  else { int q = row - M_LAT; ri.b = q >> 8; ri.pos = q & 255; ri.kpos = 4096 + ri.pos; ri.lat = false; ri.L = 256; }
  return ri;
}

DI int map_col(int mode, int n) {
  if (mode == 0) return n;
  if (mode == 1) { const int isb = n >= DFF; const int j = isb ? n - DFF : n; return (j >> 5) * 64 + (isb ? 32 : 0) + (j & 31); }
  if (n >= 1120) return n - 1120;
  if (n >= 864) return n - 864 + 1024;
  if (n >= 672) return n - 672 + 1664;
  if (n >= 416) return n - 416 + 768;
  if (n >= 288) return n - 288 + 1408;
  if (n >= 160) return n - 160 + 1280;
  if (n >= 128) return n - 128 + 1856;
  return n + 1536;
}
DI void conv_tile(const float* __restrict__ src, bf16_t* __restrict__ dst, const float* __restrict__ kscale, int K, int N, int mode, int t, float* tile  ) {
  const int ntn = (N + 63) >> 6;
  const int kt = t / ntn, nt = t % ntn, k0 = kt * 64, n0 = nt * 64, tid = TIDX;
  float vv[16];
#pragma unroll
  for (int i = 0; i < 16; ++i) {
    const int idx = tid + 256 * i, kk = idx >> 6, nn = idx & 63;
    vv[i] = (n0 + nn < N) ? __builtin_nontemporal_load(src + (size_t)(k0 + kk) * N + n0 + nn) : 0.f;
  }
#pragma unroll
  for (int i = 0; i < 16; ++i) {
    const int idx = tid + 256 * i, kk = idx >> 6, nn = idx & 63;
    float v = vv[i];
    if (kscale) v *= kscale[k0 + kk];
    tile[kk * 65 + nn] = v;
  }
  __syncthreads();
#pragma unroll 4
  for (int i = 0; i < 8; ++i) {
    const int idx = tid + 256 * i, nn = idx >> 5, kp = idx & 31;
    if (n0 + nn < N) {
      const int dr = map_col(mode, n0 + nn);
      *(unsigned*)(dst + (size_t)dr * K + k0 + 2 * kp) = pk2(tile[(2 * kp) * 65 + nn], tile[(2 * kp + 1) * 65 + nn]);
    }
  }
  __syncthreads();
}
DI void phase_convert(const P& p, int layer, unsigned char* smem) {
  unsigned char* ws = p.ws;
  const size_t l = (size_t)layer;
  const int tid = TIDX;
#define CONV_JOB(SRC, OFF, KS, KK, NN, MODE)                                                              \
  {                                                                                                       \
    const int ntiles_ = ((KK) >> 6) * (((NN) + 63) >> 6);                                                 \
    for (int t = blockIdx.x; t < ntiles_; t += gridDim.x) conv_tile((SRC), (bf16_t*)(ws + (OFF)), (KS), (KK), (NN), (MODE), t, (float*)smem); \
  }
  CONV_JOB(p.in[I_UP1] + l * 1024 * 5632, O_WUP1, nullptr, 1024, 5632, 1)
  CONV_JOB(p.in[I_DN1] + l * 2816 * 1024, O_WDN1, nullptr, 2816, 1024, 0)
  CONV_JOB(p.in[I_UP2] + l * 1024 * 5632, O_WUP2, nullptr, 1024, 5632, 1)
  CONV_JOB(p.in[I_DN2] + l * 2816 * 1024, O_WDN2, nullptr, 2816, 1024, 0)
  CONV_JOB(p.in[I_WIN] + l * 1024 * 1888, O_WIN, nullptr, 1024, 1888, 2)
#pragma unroll 1
  for (int i = 0; i < 4; ++i) CONV_JOB(p.in[I_WGATE] + (l * 4 + i) * 1024 * 1024, O_WGATE + (size_t)i * 1024 * 1024 * 2, nullptr, 1024, 1024, 0)
  CONV_JOB(p.in[I_BRMLA] + l * 256 * 1024, O_WBR + (size_t)0 * 1024 * 256 * 2, nullptr, 256, 1024, 0)
  CONV_JOB(p.in[I_BRHY] + l * 256 * 1024, O_WBR + (size_t)1 * 1024 * 256 * 2, nullptr, 256, 1024, 0)
  CONV_JOB(p.in[I_BRSWA] + l * 256 * 1024, O_WBR + (size_t)2 * 1024 * 256 * 2, nullptr, 256, 1024, 0)
  CONV_JOB(p.in[I_BRS5] + l * 256 * 1024, O_WBR + (size_t)3 * 1024 * 256 * 2, nullptr, 256, 1024, 0)
  CONV_JOB(p.in[I_WOUT] + l * 1024 * 1024, O_WOUT, nullptr, 1024, 1024, 0)
  CONV_JOB(p.in[I_WUKV] + l * 128 * 512, O_WUKV, p.in[I_KVNORM] + l * 128, 128, 512, 0)
  CONV_JOB(p.in[I_WUQ] + l * 192 * 384, O_WUQ, p.in[I_QNORM] + l * 192, 192, 384, 0)
  CONV_JOB(p.in[I_GLUW] + l * 256 * 256, O_WGLU, nullptr, 256, 256, 0)
#undef CONV_JOB
  {
    unsigned* z = (unsigned*)(ws + O_WIN + (size_t)1888 * 1024 * 2);
    for (int i = blockIdx.x * NT + tid; i < 32 * 1024 / 2; i += gridDim.x * NT) z[i] = 0u;
  }
}

DI void phase_modulation(const P& p, unsigned char* smem) {
  float* sS = (float*)smem;
  float* sR = sS + 9 * 1024;
  const int tid = TIDX, lane = tid & 63, wave = tid >> 6;
  float* MOD = (float*)(p.ws + O_MOD);
  bool filled = false;
  for (int it = blockIdx.x; it < 2 * 144; it += gridDim.x) {
    if (!filled) {
      for (int i = tid; i < 9 * 1024; i += NT) {
        const int v = i >> 10, k = i & 1023;
        const float x = v < 8 ? p.in[I_C][v * 1024 + k] : p.in[I_CCTX][k];
        sS[i] = siluf_(x);
      }
      filled = true;
      __syncthreads();
    }
    const int layer = it / 144, col = (it % 144) * 64 + lane;
    const float* w = p.in[I_WADA] + (size_t)layer * 1024 * 9216 + col;
    float acc[9];
#pragma unroll
    for (int v = 0; v < 9; ++v) acc[v] = 0.f;
#pragma unroll 8
    for (int k = wave * 256; k < wave * 256 + 256; ++k) {
      const float wv = __builtin_nontemporal_load(w + (size_t)k * 9216);
#pragma unroll
      for (int v = 0; v < 9; ++v) acc[v] += sS[v * 1024 + k] * wv;
    }
#pragma unroll
    for (int v = 0; v < 9; ++v) sR[(wave * 9 + v) * 64 + lane] = acc[v];
    __syncthreads();
    for (int i = tid; i < 9 * 64; i += NT) {
      const int v = i >> 6, c = i & 63;
      const float s = sR[(0 * 9 + v) * 64 + c] + sR[(1 * 9 + v) * 64 + c] + sR[(2 * 9 + v) * 64 + c] + sR[(3 * 9 + v) * 64 + c];
      const int cc = (it % 144) * 64 + c;
      MOD[((size_t)layer * 9 + v) * 9216 + cc] = s + p.in[I_BADA][(size_t)layer * 9216 + cc];
    }
    __syncthreads();
  }
  __syncthreads();
}

DI size_t h2_off(int layer, int kind) { return ((size_t)layer * (4096 + 256) + (kind ? 4096 : 0)) * 64; }
DI void phase_h2(const P& p) {
  const int tid = TIDX, lane = tid & 63, wave = tid >> 6;
  float* H2 = (float*)(p.ws + O_H2);
  const int rows_per_layer = 4096 + 256;
  for (int rr = blockIdx.x * 4 + wave; rr < 2 * rows_per_layer; rr += gridDim.x * 4) {
    const int layer = rr / rows_per_layer, q = rr % rows_per_layer;
    const int kind = q >= 4096, t = kind ? q - 4096 : q, L = kind ? 256 : 4096;
    float z = 0.f;
    if (lane == 0) z = (float)t / (float)(L - 1);
    else if (lane < 33) {
      const int j = (lane - 1) & 15;
      const float w = (6.2831855f * (float)t) / (float)L;
      const float fr = 1e-4f + (float)j * ((15.0f - 1e-4f) / 15.0f);
      const float ang = w * fr;
      float s, c; sincos_d((double)ang, s, c);
      z = lane <= 16 ? c : -s;
    }
    const float* w1 = p.in[I_HW1] + (size_t)layer * 33 * 64;
    const float* w2 = p.in[I_HW2] + (size_t)layer * 64 * 64;
    float a = p.in[I_HB1][layer * 64 + lane];
    for (int i = 0; i < 33; ++i) a += __shfl(z, i) * w1[i * 64 + lane];
    const float h1 = sin_acc(p.in[I_HFREQ][(layer * 2 + 0) * 64 + lane] * a);
    float a2 = p.in[I_HB2][layer * 64 + lane];
    for (int i = 0; i < 64; ++i) a2 += __shfl(h1, i) * w2[i * 64 + lane];
    const float h2 = sin_acc(p.in[I_HFREQ][(layer * 2 + 1) * 64 + lane] * a2);
    H2[h2_off(layer, kind) + (size_t)t * 64 + lane] = h2;
  }
}

DI void phase_rope(const P& p) {
  f32x2* RM = (f32x2*)(p.ws + O_ROPEM);
  f32x2* RW = (f32x2*)(p.ws + O_ROPEW);
  const int g0 = blockIdx.x * NT + TIDX, gs = gridDim.x * NT;
  for (int i = g0; i < 4096 * 48; i += gs) {
    const int pos = i / 48, e = i % 48;
    const float rowf = (float)(pos >> 6), colf = (float)(pos & 63);
    float ang;
    if (e < 16) { const int f = e & 7; const float fr = fast_exp(-(float)f / 8.0f * 9.210340371976184f); ang = (e < 8 ? rowf : colf) * fr; }
    else { const int e2 = e - 16, f = e2 & 15; const float fr = fast_exp(-(float)f / 16.0f * 9.210340371976184f); ang = (e2 < 16 ? rowf : colf) * fr; }
    float s, c; sincos_d((double)ang, s, c);
    f32x2 v = {c, s};
    if (e < 16) RM[pos * 16 + e] = v; else RW[pos * 32 + (e - 16)] = v;
  }
}

DI f32x2 cmul(f32x2 a, f32x2 b) { f32x2 r = {a.x * b.x - a.y * b.y, a.x * b.y + a.y * b.x}; return r; }
DI f32x2 cmulc(f32x2 a, f32x2 b) { f32x2 r = {a.x * b.x + a.y * b.y, a.y * b.x - a.x * b.y}; return r; }
DI f32x2 mul_mi(f32x2 a) { f32x2 r = {a.y, -a.x}; return r; }
DI f32x2 mul_pi(f32x2 a) { f32x2 r = {-a.y, a.x}; return r; }
#define PH(i) ((i) + ((i) >> 4))
DI void fft16_dif_tail(f32x2 (&x)[16]) {
  const float C1 = 0.92387953251f, S1 = 0.38268343236f, R2 = 0.70710678118f;
  const f32x2 T[4] = {{1.f, 0.f}, {C1, -S1}, {R2, -R2}, {S1, -C1}};
  const f32x2 T2[4] = {{1.f, 0.f}, {R2, -R2}, {0.f, -1.f}, {-R2, -R2}};
#pragma unroll
  for (int j = 0; j < 4; ++j) {
    const f32x2 a0 = x[j], a1 = x[j + 4], a2 = x[j + 8], a3 = x[j + 12];
    const f32x2 b0 = a0 + a2, b2 = cmul(a0 - a2, T[j]), b1 = a1 + a3, b3 = mul_mi(cmul(a1 - a3, T[j]));
    x[j] = b0 + b1; x[j + 4] = cmul(b0 - b1, T2[j]); x[j + 8] = b2 + b3; x[j + 12] = cmul(b2 - b3, T2[j]);
  }
#pragma unroll
  for (int k = 0; k < 4; ++k) {
    const f32x2 a0 = x[4 * k], a1 = x[4 * k + 1], a2 = x[4 * k + 2], a3 = x[4 * k + 3];
    const f32x2 b0 = a0 + a2, b2 = a0 - a2, b1 = a1 + a3, b3 = mul_mi(a1 - a3);
    x[4 * k] = b0 + b1; x[4 * k + 1] = b0 - b1; x[4 * k + 2] = b2 + b3; x[4 * k + 3] = b2 - b3;
  }
}
DI void fft16_dit_head(f32x2 (&x)[16]) {
  const float C1 = 0.92387953251f, S1 = 0.38268343236f, R2 = 0.70710678118f;
  const f32x2 T[4] = {{1.f, 0.f}, {C1, -S1}, {R2, -R2}, {S1, -C1}};
  const f32x2 T2[4] = {{1.f, 0.f}, {R2, -R2}, {0.f, -1.f}, {-R2, -R2}};
#pragma unroll
  for (int k = 0; k < 4; ++k) {
    const f32x2 c0 = x[4 * k], c1 = x[4 * k + 1], c2 = x[4 * k + 2], c3 = x[4 * k + 3];
    const f32x2 b0 = c0 + c1, b1 = c0 - c1, b2 = c2 + c3, b3 = c2 - c3;
    const f32x2 up = mul_pi(b3);
    x[4 * k] = b0 + b2; x[4 * k + 2] = b0 - b2; x[4 * k + 1] = b1 + up; x[4 * k + 3] = b1 - up;
  }
#pragma unroll
  for (int j = 0; j < 4; ++j) {
    const f32x2 c0 = x[j], c1 = x[j + 4], c2 = x[j + 8], c3 = x[j + 12];
    const f32x2 t = cmulc(c1, T2[j]), tp = cmulc(c3, T2[j]);
    const f32x2 b0 = c0 + t, b1 = c0 - t, b2 = c2 + tp, b3 = c2 - tp;
    const f32x2 u = cmulc(b2, T[j]), up = mul_pi(cmulc(b3, T[j]));
    x[j] = b0 + u; x[j + 8] = b0 - u; x[j + 4] = b1 + up; x[j + 12] = b1 - up;
  }
}
DI void fft_dif(f32x2* W, int N, int logN) {
  const int tid = TIDX;
  int s = logN - 1;
  {
    const int half = 1 << s, hp = half + (half >> 4);
    const float inv = 1.0f / (float)(2 * half);
    for (int i = tid; i < (N >> 1); i += NT) {
      const int j = i & (half - 1), base = PH(((i >> s) << (s + 1)) + j);
      const f32x2 a = W[base], b = W[base + hp];
      const float rev = (float)j * inv;
      const f32x2 w = {__builtin_amdgcn_cosf(rev), -__builtin_amdgcn_sinf(rev)};
      W[base] = a + b;
      W[base + hp] = cmul(a - b, w);
    }
    __syncthreads();
    --s;
  }
  for (; s >= 5; s -= 2) {
    const int half = 1 << s, quarter = half >> 1, hp = half + (half >> 4), qp = quarter + (quarter >> 4);
    const float inv = 1.0f / (float)(2 * half);
    for (int i = tid; i < (N >> 2); i += NT) {
      const int j = i & (quarter - 1), i0 = PH(((i >> (s - 1)) << (s + 1)) + j);
      const f32x2 a0 = W[i0], a1 = W[i0 + qp], a2 = W[i0 + hp], a3 = W[i0 + hp + qp];
      const float rev = (float)j * inv;
      const f32x2 w1 = {__builtin_amdgcn_cosf(rev), -__builtin_amdgcn_sinf(rev)};
      const f32x2 w2 = cmul(w1, w1);
      const f32x2 b0 = a0 + a2, b2 = cmul(a0 - a2, w1), b1 = a1 + a3, b3 = mul_mi(cmul(a1 - a3, w1));
      W[i0] = b0 + b1;
      W[i0 + qp] = cmul(b0 - b1, w2);
      W[i0 + hp] = b2 + b3;
      W[i0 + hp + qp] = cmul(b2 - b3, w2);
    }
    __syncthreads();
  }
  for (int gq = tid; gq < (N >> 4); gq += NT) {
    f32x2 x[16];
#pragma unroll
    for (int e = 0; e < 16; ++e) x[e] = W[17 * gq + e];
    fft16_dif_tail(x);
#pragma unroll
    for (int e = 0; e < 16; ++e) W[17 * gq + e] = x[e];
  }
  __syncthreads();
}
DI void fft_dit_inv(f32x2* W, int N, int logN) {
  const int tid = TIDX;
  for (int gq = tid; gq < (N >> 4); gq += NT) {
    f32x2 x[16];
#pragma unroll
    for (int e = 0; e < 16; ++e) x[e] = W[17 * gq + e];
    fft16_dit_head(x);
#pragma unroll
    for (int e = 0; e < 16; ++e) W[17 * gq + e] = x[e];
  }
  __syncthreads();
  int s = 5;
  for (; s < logN - 1; s += 2) {
    const int half = 1 << s, quarter = half >> 1, hp = half + (half >> 4), qp = quarter + (quarter >> 4);
    const float inv = 1.0f / (float)(2 * half);
    for (int i = tid; i < (N >> 2); i += NT) {
      const int j = i & (quarter - 1), i0 = PH(((i >> (s - 1)) << (s + 1)) + j);
      const f32x2 c0 = W[i0], c1 = W[i0 + qp], c2 = W[i0 + hp], c3 = W[i0 + hp + qp];
      const float rev = (float)j * inv;
      const f32x2 w1 = {__builtin_amdgcn_cosf(rev), -__builtin_amdgcn_sinf(rev)};
      const f32x2 w2 = cmul(w1, w1);
      const f32x2 t = cmulc(c1, w2), tp = cmulc(c3, w2);
      const f32x2 b0 = c0 + t, b1 = c0 - t, b2 = c2 + tp, b3 = c2 - tp;
      const f32x2 u = cmulc(b2, w1), up = mul_pi(cmulc(b3, w1));
      W[i0] = b0 + u;
      W[i0 + hp] = b0 - u;
      W[i0 + qp] = b1 + up;
      W[i0 + hp + qp] = b1 - up;
    }
    __syncthreads();
  }
  {
    const int sl = logN - 1, half = 1 << sl, hp = half + (half >> 4);
    const float inv = 1.0f / (float)(2 * half);
    for (int i = tid; i < (N >> 1); i += NT) {
      const int j = i & (half - 1), base = PH(((i >> sl) << (sl + 1)) + j);
      const f32x2 a = W[base], b = W[base + hp];
      const float rev = (float)j * inv;
      const f32x2 w = {__builtin_amdgcn_cosf(rev), __builtin_amdgcn_sinf(rev)};
      const f32x2 t = cmul(b, w);
      W[base] = a + t;
      W[base + hp] = a - t;
    }
    __syncthreads();
  }
}

DI void kf_item(const P& p, int layer, int kind, int c, int o, unsigned char* smem) {
  const int tid = TIDX;
  const int L = kind ? 256 : 4096, N = 2 * L, logN = kind ? 9 : 13;
  f32x2* W = (f32x2*)smem;
  float* sW3 = (float*)(smem + 69632);
  const float* w3 = p.in[I_HW3] + (size_t)layer * 64 * 1024;
  if (tid < 128) { const int dir = tid >> 6, j = tid & 63; sW3[tid] = w3[(size_t)j * 1024 + o * 512 + dir * 256 + c]; }
  __syncthreads();
  const float* H2 = (const float*)(p.ws + O_H2) + h2_off(layer, kind);
  const float lo = -3.0701134573253942f, hi = -15.350567286626971f;
  const float delta = fabsf(lo + (float)c * ((hi - lo) / 255.0f));
  const float invN = 1.0f / (float)N;
  for (int n = tid; n < N; n += NT) {
    float val = 0.f;
    if (n != L) {
      const int dir = n > L, t = dir ? N - n : n;
      const float4* hr = (const float4*)(H2 + (size_t)t * 64);
      const float* wv = sW3 + dir * 64;
      float acc = 0.f;
#pragma unroll
      for (int q = 0; q < 16; ++q) { const float4 hv = hr[q]; acc += hv.x * wv[4 * q] + hv.y * wv[4 * q + 1] + hv.z * wv[4 * q + 2] + hv.w * wv[4 * q + 3]; }
      const float tl = (float)t / (float)(L - 1);
      val = acc * fast_exp(-tl * delta) * invN;
    }
    f32x2 v = {val, 0.f};
    W[PH(n)] = v;
  }
  __syncthreads();
  fft_dif(W, N, logN);
  f32x2* KF = kind ? (f32x2*)(p.ws + O_KF1) + (size_t)(c * 2 + o) * 512 : (f32x2*)(p.ws + O_KF0) + (size_t)(c * 2 + o) * 8192;
  for (int n = tid; n < N; n += NT) KF[n] = W[PH(n)];
  __syncthreads();
}
DI void phase_kf(const P& p, int layer, bool with_ctx, unsigned char* smem) {
  const int total = 512 + (with_ctx ? 512 : 0);
  for (int it = blockIdx.x; it < total; it += gridDim.x) {
    const int kind = it >= 512, q = it & 511;
    kf_item(p, layer, kind, q >> 1, q & 1, smem);
  }
}

DI void phase_rows(const P& p, int Mrows, int mode, int layer, int sub, float resw, bool from_input, bool has_next, int nl, int nj, bool zero_rowss) {
  const int tid = TIDX, lane = tid & 63, wave = tid >> 6;
  const float* MOD = (const float*)(p.ws + O_MOD);
  const bf16_t* F = (const bf16_t*)(p.ws + O_F);
  bf16_t* U = (bf16_t*)(p.ws + O_U);
  float* XC = (float*)(p.ws + O_XC);
  float* ROWSS = (float*)(p.ws + O_ROWSS);
  for (int row0 = (blockIdx.x * 4 + wave) * 2; row0 < Mrows; row0 += gridDim.x * 8) {
    if (mode == 2) { if (lane < 2) { ROWSS[row0 + lane] = 0.f; ROWSS[M_ALL + row0 + lane] = 0.f; } continue; }
    const float* xin[2]; float* X[2]; int midx[2];
#pragma unroll
    for (int rr = 0; rr < 2; ++rr) {
      const int row = row0 + rr;
      const bool lat = row < M_LAT;
      midx[rr] = lat ? (row >> 12) : 8;
      xin[rr] = lat ? p.in[I_X] + (size_t)row * 1024 : p.in[I_CTX] + (size_t)(row - M_LAT) * 1024;
      X[rr] = lat ? p.out + (size_t)row * 1024 : XC + (size_t)(row - M_LAT) * 1024;
    }
    float4 xv[2][4];
    if (mode == 0) {
#pragma unroll
      for (int rr = 0; rr < 2; ++rr)
#pragma unroll
        for (int c4 = 0; c4 < 4; ++c4) xv[rr][c4] = *(const float4*)(xin[rr] + c4 * 256 + lane * 4);
    } else {
      uint2 raw[2][4];
      float4 xold[2][4];
#pragma unroll
      for (int rr = 0; rr < 2; ++rr)
#pragma unroll
        for (int c4 = 0; c4 < 4; ++c4) {
          { typedef unsigned u32x2v __attribute__((ext_vector_type(2)));
            const u32x2v rw = __builtin_nontemporal_load((const u32x2v*)(F + (size_t)(row0 + rr) * 1024 + c4 * 256 + lane * 4));
            raw[rr][c4].x = rw.x; raw[rr][c4].y = rw.y;
            const f32x4 xo4 = __builtin_nontemporal_load((const f32x4*)((from_input ? xin[rr] : X[rr]) + c4 * 256 + lane * 4));
            xold[rr][c4].x = xo4.x; xold[rr][c4].y = xo4.y; xold[rr][c4].z = xo4.z; xold[rr][c4].w = xo4.w; }
        }
      const float* gp = p.in[I_NPOST] + ((size_t)layer * 3 + sub) * 1024;
#pragma unroll
      for (int rr = 0; rr < 2; ++rr) {
        const float* mod = MOD + ((size_t)layer * 9 + midx[rr]) * 9216 + (3 * sub + 2) * 1024;
        float4 fv[4];
        float ss = 0.f;
#pragma unroll
        for (int c4 = 0; c4 < 4; ++c4) {
          fv[c4].x = __uint_as_float(raw[rr][c4].x << 16); fv[c4].y = __uint_as_float(raw[rr][c4].x & 0xffff0000u);
          fv[c4].z = __uint_as_float(raw[rr][c4].y << 16); fv[c4].w = __uint_as_float(raw[rr][c4].y & 0xffff0000u);
          ss += fv[c4].x * fv[c4].x + fv[c4].y * fv[c4].y + fv[c4].z * fv[c4].z + fv[c4].w * fv[c4].w;
        }
        ss = wave_sum(ss);
        const float rstd = rsqrtf(ss * (1.0f / 1024.0f) + EPS);
#pragma unroll
        for (int c4 = 0; c4 < 4; ++c4) {
          const int col = c4 * 256 + lane * 4;
          const float4 g = *(const float4*)(gp + col);
          const float4 mg = *(const float4*)(mod + col);
          xv[rr][c4].x = xold[rr][c4].x + resw * mg.x * (fv[c4].x * rstd * g.x);
          xv[rr][c4].y = xold[rr][c4].y + resw * mg.y * (fv[c4].y * rstd * g.y);
          xv[rr][c4].z = xold[rr][c4].z + resw * mg.z * (fv[c4].z * rstd * g.z);
          xv[rr][c4].w = xold[rr][c4].w + resw * mg.w * (fv[c4].w * rstd * g.w);
          { f32x4 st4 = {xv[rr][c4].x, xv[rr][c4].y, xv[rr][c4].z, xv[rr][c4].w}; __builtin_nontemporal_store(st4, (f32x4*)(X[rr] + col)); }
        }
      }
    }
    if (has_next) {
      const float* gpre = p.in[I_NPRE] + ((size_t)nl * 3 + nj) * 1024;
#pragma unroll
      for (int rr = 0; rr < 2; ++rr) {
        float ss = 0.f;
#pragma unroll
        for (int c4 = 0; c4 < 4; ++c4) ss += xv[rr][c4].x * xv[rr][c4].x + xv[rr][c4].y * xv[rr][c4].y + xv[rr][c4].z * xv[rr][c4].z + xv[rr][c4].w * xv[rr][c4].w;
        ss = wave_sum(ss);
        const float rstd = rsqrtf(ss * (1.0f / 1024.0f) + EPS);
        const float* modn = MOD + ((size_t)nl * 9 + midx[rr]) * 9216;
#pragma unroll
        for (int c4 = 0; c4 < 4; ++c4) {
          const int col = c4 * 256 + lane * 4;
          const float4 g = *(const float4*)(gpre + col);
          const float4 sc = *(const float4*)(modn + (3 * nj + 1) * 1024 + col);
          const float4 sh = *(const float4*)(modn + (3 * nj) * 1024 + col);
          const float u0 = xv[rr][c4].x * rstd * g.x * (1.f + sc.x) + sh.x;
          const float u1 = xv[rr][c4].y * rstd * g.y * (1.f + sc.y) + sh.y;
          const float u2 = xv[rr][c4].z * rstd * g.z * (1.f + sc.z) + sh.z;
          const float u3 = xv[rr][c4].w * rstd * g.w * (1.f + sc.w) + sh.w;
          uint2 o; o.x = pk2(u0, u1); o.y = pk2(u2, u3);
          *(uint2*)(U + (size_t)(row0 + rr) * 1024 + col) = o;
        }
      }
    }
    if (zero_rowss && lane < 2) { ROWSS[row0 + lane] = 0.f; ROWSS[M_ALL + row0 + lane] = 0.f; }
  }
}

#define EPI_COORDS                                                                                      \
  const int tid = TIDX, lane = tid & 63, wave = tid >> 6, r = lane & 31, h = lane >> 5, wm = wave >> 1, wn = wave & 1; \
  (void)tid; (void)lane; (void)wave; (void)r; (void)h; (void)wm; (void)wn;

DI void phase_ffn_up(const P& p, int Mrows, size_t off_w, unsigned char* smem) {
  const bf16_t* U = (const bf16_t*)(p.ws + O_U);
  const bf16_t* W = (const bf16_t*)(p.ws + off_w);
  bf16_t* ACT = (bf16_t*)(p.ws + O_ACT);
  for_tiles<256>(Mrows >> 7, 22, [&](int m0, int n0, int tn) __attribute__((always_inline)) {
    f32x16 acc[2][4];
    zero_acc<4>(acc);
    gemm_kloop_wide(acc, U, 1024, W, 1024, 1024, m0, n0, smem);
    EPI_COORDS
#pragma unroll
    for (int j = 0; j < 2; ++j) {
      const int col = tn * 128 + wn * 64 + j * 32 + r;
#pragma unroll
      for (int mi = 0; mi < 2; ++mi)
#pragma unroll
        for (int i = 0; i < 16; ++i) {
          const int row = m0 + wm * 64 + mi * 32 + crow(i, h);
          const float a = acc[mi][2 * j][i], b = acc[mi][2 * j + 1][i];
          ACT[(size_t)row * DFF + col] = f2bf(siluf_(a) * b);
        }
    }
  });
}
DI void phase_gemm_plain_bf16(const P& p, int Mrows, const bf16_t* A, int K, const bf16_t* W, bf16_t* OUT, int N, unsigned char* smem) {
  (void)p;
  const int Mwide = Mrows < M_LAT ? Mrows : M_LAT;
  for_tiles<256>(Mwide >> 7, N >> 8, [&](int m0, int n0, int tn) __attribute__((always_inline)) {
    (void)tn;
    f32x16 acc[2][4];
    zero_acc<4>(acc);
    gemm_kloop_wide(acc, A, K, W, K, K, m0, n0, smem);
    EPI_COORDS
#pragma unroll
    for (int mi = 0; mi < 2; ++mi)
#pragma unroll
      for (int ni = 0; ni < 4; ++ni)
#pragma unroll
        for (int i = 0; i < 16; ++i) {
          const int row = m0 + wm * 64 + mi * 32 + crow(i, h), col = n0 + wn * 128 + ni * 32 + r;
          OUT[(size_t)row * N + col] = f2bf(acc[mi][ni][i]);
        }
  });
  if (Mrows > Mwide) {
    for_tiles<64>((Mrows - Mwide) >> 7, N >> 6, [&](int m0, int n0, int tn) __attribute__((always_inline)) {
      (void)tn;
      f32x16 acc[2][1];
      zero_acc<1>(acc);
      gemm_kloop<1>(acc, A, K, W, K, K, m0, n0, smem);
      EPI_COORDS
#pragma unroll
      for (int mi = 0; mi < 2; ++mi)
#pragma unroll
        for (int i = 0; i < 16; ++i) {
          const int row = m0 + wm * 64 + mi * 32 + crow(i, h), col = n0 + wn * 32 + r;
          OUT[(size_t)row * N + col] = f2bf(acc[mi][0][i]);
        }
    }, Mwide);
  }
}

DI void win_epilogue(const P& p, int m0, int tn, int wn, f32x16 (&acc)[2][2]) {
  unsigned char* ws = p.ws;
  bf16_t* HYT = (bf16_t*)(ws + O_HYT);
  float* S5U = (float*)(ws + O_S5U);
  bf16_t* QSWA = (bf16_t*)(ws + O_QSWA);
  bf16_t* KSWA = (bf16_t*)(ws + O_KSWA);
  bf16_t* VSWAT = (bf16_t*)(ws + O_VSWAT);
  bf16_t* CKV = (bf16_t*)(ws + O_CKV);
  bf16_t* CQ = (bf16_t*)(ws + O_CQ);
  bf16_t* KMLA = (bf16_t*)(ws + O_KMLA);
  float* ROWSS = (float*)(ws + O_ROWSS);
  const f32x2* RM = (const f32x2*)(ws + O_ROPEM);
  const f32x2* RW = (const f32x2*)(ws + O_ROPEW);
  const float qscale = 0.125f * LOG2E;
  const int tid = TIDX, lane = tid & 63, wave = tid >> 6, r = lane & 31, h = lane >> 5, wm = wave >> 1;
    const RowInfo t0 = row_info(m0);
  if (tn < 6) {
    bf16_t* base = HYT + (t0.lat ? (size_t)t0.b * 768 * 4096 : HYT_LATSZ + (size_t)t0.b * 768 * 256);
#pragma unroll
    for (int mi = 0; mi < 2; ++mi)
#pragma unroll
      for (int ni = 0; ni < 2; ++ni) {
        const int ch = tn * 128 + wn * 64 + ni * 32 + r;
#pragma unroll
        for (int g = 0; g < 4; ++g) {
          const int pos = t0.pos + wm * 64 + mi * 32 + 8 * g + 4 * h;
          uint2 o; o.x = pk2(acc[mi][ni][4 * g], acc[mi][ni][4 * g + 1]); o.y = pk2(acc[mi][ni][4 * g + 2], acc[mi][ni][4 * g + 3]);
          *(uint2*)(base + (size_t)ch * t0.L + pos) = o;
        }
      }
  } else if (tn < 8) {
#pragma unroll
    for (int mi = 0; mi < 2; ++mi)
#pragma unroll
      for (int ni = 0; ni < 2; ++ni)
#pragma unroll
        for (int i = 0; i < 16; ++i) {
          const int row = m0 + wm * 64 + mi * 32 + crow(i, h), col = (tn - 6) * 128 + wn * 64 + ni * 32 + r;
          S5U[(size_t)row * 256 + col] = acc[mi][ni][i];
        }
  } else if (tn < 11) {
#pragma unroll
    for (int mi = 0; mi < 2; ++mi)
#pragma unroll
      for (int i = 0; i < 16; ++i) {
        const int lr = wm * 64 + mi * 32 + crow(i, h);
        const int row = m0 + lr, pos = t0.pos + lr;
        float x1 = acc[mi][0][i], x2 = acc[mi][1][i];
        if (t0.lat) {
          const f32x2 cs = RW[pos * 32 + r];
          const float y1 = x1 * cs.x - x2 * cs.y, y2 = x1 * cs.y + x2 * cs.x;
          x1 = y1; x2 = y2;
        }
        if (tn < 10) {
          const int head = (tn - 8) * 2 + wn;
          bf16_t* q = QSWA + ((size_t)row * 4 + head) * 64;
          q[r] = f2bf(x1 * qscale); q[r + 32] = f2bf(x2 * qscale);
        } else {
          bf16_t* k = KSWA + (((size_t)t0.b * 2 + wn) * KEYS + (t0.kpos + lr)) * 64;
          k[r] = f2bf(x1); k[r + 32] = f2bf(x2);
        }
      }
  } else if (tn == 11) {
#pragma unroll
    for (int mi = 0; mi < 2; ++mi)
#pragma unroll
      for (int ni = 0; ni < 2; ++ni) {
        const int dv = ni * 32 + r;
#pragma unroll
        for (int g = 0; g < 4; ++g) {
          const int kp = t0.kpos + wm * 64 + mi * 32 + 8 * g + 4 * h;
          uint2 o; o.x = pk2(acc[mi][ni][4 * g], acc[mi][ni][4 * g + 1]); o.y = pk2(acc[mi][ni][4 * g + 2], acc[mi][ni][4 * g + 3]);
          *(uint2*)(VSWAT + (((size_t)t0.b * 2 + wn) * 64 + dv) * KEYS + kp) = o;
        }
      }
  } else {
    const bool is_kv = tn == 12;
    const bool rope_wave = (tn == 14) && (wn == 1);
    if (!rope_wave) {
      bf16_t* dst = is_kv ? CKV : CQ;
      const int ld = is_kv ? 128 : 192;
      const int cbase = (tn == 14 ? 128 : 0) + wn * 64;
      float* rs = ROWSS + (is_kv ? 0 : M_ALL);
#pragma unroll
      for (int mi = 0; mi < 2; ++mi)
#pragma unroll
        for (int i = 0; i < 16; ++i) {
          const int row = m0 + wm * 64 + mi * 32 + crow(i, h);
          const float v0 = acc[mi][0][i], v1 = acc[mi][1][i];
          dst[(size_t)row * ld + cbase + r] = f2bf(v0);
          dst[(size_t)row * ld + cbase + 32 + r] = f2bf(v1);
          float s = v0 * v0 + v1 * v1;
#pragma unroll
          for (int o = 16; o; o >>= 1) s += __shfl_xor(s, o);
          if (r == 0) atomicAdd(rs + row, s);
        }
    } else {
#pragma unroll
      for (int mi = 0; mi < 2; ++mi)
#pragma unroll
        for (int i = 0; i < 16; ++i) {
          const int lr = wm * 64 + mi * 32 + crow(i, h);
          const int pos = t0.pos + lr;
          const float x = acc[mi][0][i];
          const float partner = __shfl_xor(x, 16);
          float y = x;
          if (t0.lat) {
            const f32x2 cs = RM[pos * 16 + (r & 15)];
            y = (r < 16) ? (x * cs.x - partner * cs.y) : (partner * cs.y + x * cs.x);
          }
          const bf16_t yb = f2bf(y);
#pragma unroll
          for (int hd = 0; hd < 4; ++hd) KMLA[(((size_t)t0.b * 4 + hd) * KEYS + (t0.kpos + lr)) * 96 + 64 + r] = yb;
        }
    }
  }
}
DI void phase_win(const P& p, int Mrows, unsigned char* smem) {
  const bf16_t* U = (const bf16_t*)(p.ws + O_U);
  const bf16_t* W = (const bf16_t*)(p.ws + O_WIN);
  const int Mwide = Mrows < M_LAT ? Mrows : M_LAT;
  for_tiles<256>(Mwide >> 7, 8, [&](int m0, int n0, int tn) __attribute__((always_inline)) {
    (void)n0;
    f32x16 acc[2][4];
    zero_acc<4>(acc);
    gemm_kloop_wide(acc, U, 1024, W, 1024, 1024, m0, n0, smem);
    const int wn = (TIDX >> 6) & 1, go = tn * 2 + wn;
    if (go < 15) {
#pragma unroll
      for (int half = 0; half < 2; ++half) {
        f32x16 t4[2][2];
        t4[0][0] = acc[0][2 * half]; t4[0][1] = acc[0][2 * half + 1]; t4[1][0] = acc[1][2 * half]; t4[1][1] = acc[1][2 * half + 1];
        win_epilogue(p, m0, go, half, t4);
      }
    }
  });
  if (Mrows > Mwide) {
    for_tiles((Mrows - Mwide) >> 7, 15, [&](int m0, int n0, int tn) __attribute__((always_inline)) {
      f32x16 acc[2][2];
      zero_acc<2>(acc);
      gemm_kloop<2>(acc, U, 1024, W, 1024, 1024, m0, n0, smem);
      win_epilogue(p, m0, tn, (TIDX >> 6) & 1, acc);
    }, Mwide);
  }
}

DI void phase_kvq(const P& p, int Mkv, int Mq, unsigned char* smem) {
  unsigned char* ws = p.ws;
  const bf16_t* CKV = (const bf16_t*)(ws + O_CKV);
  const bf16_t* CQ = (const bf16_t*)(ws + O_CQ);
  const bf16_t* WUKV = (const bf16_t*)(ws + O_WUKV);
  const bf16_t* WUQ = (const bf16_t*)(ws + O_WUQ);
  bf16_t* KMLA = (bf16_t*)(ws + O_KMLA);
  bf16_t* VMLAT = (bf16_t*)(ws + O_VMLAT);
  bf16_t* QMLA = (bf16_t*)(ws + O_QMLA);
  const float* ROWSS = (const float*)(ws + O_ROWSS);
  const f32x2* RM = (const f32x2*)(ws + O_ROPEM);
  const float qscale = 0.10206207261596577f * LOG2E;
  for_tiles(Mkv >> 7, 4, [&](int m0, int n0, int tn) __attribute__((always_inline)) {
    f32x16 acc[2][2];
    zero_acc<2>(acc);
    gemm_kloop<2>(acc, CKV, 128, WUKV, 128, 128, m0, n0, smem);
    EPI_COORDS
    const RowInfo t0 = row_info(m0);
#pragma unroll
    for (int mi = 0; mi < 2; ++mi) {
      float rstd[16];
#pragma unroll
      for (int i = 0; i < 16; ++i) rstd[i] = rsqrtf(ROWSS[m0 + wm * 64 + mi * 32 + crow(i, h)] * (1.0f / 128.0f) + EPS);
      if (wn == 0) {
#pragma unroll
        for (int ni = 0; ni < 2; ++ni)
#pragma unroll
          for (int i = 0; i < 16; ++i) {
            const int lr = wm * 64 + mi * 32 + crow(i, h);
            KMLA[(((size_t)t0.b * 4 + tn) * KEYS + (t0.kpos + lr)) * 96 + ni * 32 + r] = f2bf(acc[mi][ni][i] * rstd[i]);
          }
      } else {
#pragma unroll
        for (int ni = 0; ni < 2; ++ni) {
          const int dv = ni * 32 + r;
#pragma unroll
          for (int g = 0; g < 4; ++g) {
            const int kp = t0.kpos + wm * 64 + mi * 32 + 8 * g + 4 * h;
            uint2 o;
            o.x = pk2(acc[mi][ni][4 * g] * rstd[4 * g], acc[mi][ni][4 * g + 1] * rstd[4 * g + 1]);
            o.y = pk2(acc[mi][ni][4 * g + 2] * rstd[4 * g + 2], acc[mi][ni][4 * g + 3] * rstd[4 * g + 3]);
            *(uint2*)(VMLAT + (((size_t)t0.b * 4 + tn) * 64 + dv) * KEYS + kp) = o;
          }
        }
      }
    }
  });
  for_tiles(Mq >> 7, 3, [&](int m0, int n0, int tn) __attribute__((always_inline)) {
    f32x16 acc[2][2];
    zero_acc<2>(acc);
    gemm_kloop<2>(acc, CQ, 192, WUQ, 192, 192, m0, n0, smem);
    EPI_COORDS
    (void)tn;
    const RowInfo t0 = row_info(m0);
#pragma unroll
    for (int mi = 0; mi < 2; ++mi)
#pragma unroll
      for (int ni = 0; ni < 2; ++ni) {
        const int cb = n0 + wn * 64 + ni * 32;
        const int head = cb / 96, d0 = cb - head * 96;
#pragma unroll
        for (int i = 0; i < 16; ++i) {
          const int lr = wm * 64 + mi * 32 + crow(i, h);
          const int row = m0 + lr;
          const float rstd = rsqrtf(ROWSS[M_ALL + row] * (1.0f / 192.0f) + EPS);
          float v = acc[mi][ni][i] * rstd;
          if (d0 == 64) {
            const float partner = __shfl_xor(v, 16);
            if (t0.lat) {
              const f32x2 cs = RM[(t0.pos + lr) * 16 + (r & 15)];
              v = (r < 16) ? (v * cs.x - partner * cs.y) : (partner * cs.y + v * cs.x);
            }
          }
          QMLA[((size_t)row * 4 + head) * 96 + d0 + r] = f2bf(v * qscale);
        }
      }
  });
}

template <int NI>
DI void merge_tile(const P& p, int layer, int m0, int n0, unsigned char* smem) {
  unsigned char* ws = p.ws;
  const bf16_t* U = (const bf16_t*)(ws + O_U);
  const bf16_t* O4 = (const bf16_t*)(ws + O_O4);
  const bf16_t* WG = (const bf16_t*)(ws + O_WGATE);
  const bf16_t* WB = (const bf16_t*)(ws + O_WBR);
  bf16_t* MB = (bf16_t*)(ws + O_MBUF);
  const float* bg = p.in[I_BGATE] + (size_t)layer * 4 * 1024;
  EPI_COORDS
  f32x16 macc[2][NI];
  zero_acc<NI>(macc);
#pragma unroll 1
  for (int br = 0; br < 4; ++br) {
    f32x16 acc[2][NI];
    zero_acc<NI>(acc);
    gemm_kloop<NI>(acc, O4 + (size_t)br * M_ALL * 256, 256, WB + (size_t)br * 1024 * 256, 256, 256, m0, n0, smem);
    unsigned po[2][NI][8];
#pragma unroll
    for (int mi = 0; mi < 2; ++mi)
#pragma unroll
      for (int ni = 0; ni < NI; ++ni)
#pragma unroll
        for (int q = 0; q < 8; ++q) po[mi][ni][q] = pk2(acc[mi][ni][2 * q], acc[mi][ni][2 * q + 1]);
    zero_acc<NI>(acc);
    gemm_kloop<NI>(acc, U, 1024, WG + (size_t)br * 1024 * 1024, 1024, 1024, m0, n0, smem);
#pragma unroll
    for (int ni = 0; ni < NI; ++ni) {
      const float bias = bg[br * 1024 + n0 + wn * 32 * NI + ni * 32 + r];
#pragma unroll
      for (int mi = 0; mi < 2; ++mi)
#pragma unroll
        for (int q = 0; q < 8; ++q) {
          const float o0 = __uint_as_float(po[mi][ni][q] << 16), o1 = __uint_as_float(po[mi][ni][q] & 0xffff0000u);
          macc[mi][ni][2 * q] += sigmoidf_(acc[mi][ni][2 * q] + bias) * o0;
          macc[mi][ni][2 * q + 1] += sigmoidf_(acc[mi][ni][2 * q + 1] + bias) * o1;
        }
    }
  }
#pragma unroll
  for (int mi = 0; mi < 2; ++mi)
#pragma unroll
    for (int ni = 0; ni < NI; ++ni)
#pragma unroll
      for (int i = 0; i < 16; ++i) {
        const int row = m0 + wm * 64 + mi * 32 + crow(i, h), col = n0 + wn * 32 * NI + ni * 32 + r;
        MB[(size_t)row * 1024 + col] = f2bf(macc[mi][ni][i]);
      }
}
DI void phase_merge(const P& p, int layer, int Mrows, unsigned char* smem) {
  for_tiles(Mrows >> 7, 8, [&](int m0, int n0, int tn) __attribute__((always_inline)) { (void)tn; merge_tile<2>(p, layer, m0, n0, smem); });
}

DI float gelu_tanh(float x) {
  const float z = 0.7978845608028654f * (x + 0.044715f * x * x * x);
  const float e = fast_exp(2.f * z);
  const float th = 1.f - 2.f * __builtin_amdgcn_rcpf(e + 1.f);
  return 0.5f * x * (1.f + th);
}
DI void phase_glu(const P& p, int layer, int Mrows, unsigned char* smem) {
  unsigned char* ws = p.ws;
  const bf16_t* Y = (const bf16_t*)(ws + O_Y);
  const float* S5U = (const float*)(ws + O_S5U);
  const bf16_t* WGLU = (const bf16_t*)(ws + O_WGLU);
  bf16_t* O3 = (bf16_t*)(ws + O_O4) + (size_t)3 * M_ALL * 256;
  const float* Dv = p.in[I_S5D] + (size_t)layer * 256;
  const float* gb = p.in[I_GLUB] + (size_t)layer * 256;
  bf16_t* sG = (bf16_t*)smem;
  const int tid = TIDX, lane = tid & 63, wave = tid >> 6, r = lane & 31, h = lane >> 5;
  for (int t = blockIdx.x; t < (Mrows >> 6); t += gridDim.x) {
    const int m0 = t * 64;
    for (int e = tid; e < 64 * 64; e += NT) {
      const int rr = e >> 6, c4 = (e & 63) * 4;
      const size_t gi = (size_t)(m0 + rr) * 256 + c4;
      const uint2 y0 = *(const uint2*)(Y + gi), y1 = *(const uint2*)(Y + (size_t)M_ALL * 256 + gi);
      const float4 u = *(const float4*)(S5U + gi);
      const float4 dd = *(const float4*)(Dv + c4);
      const float a0 = __uint_as_float(y0.x << 16) + __uint_as_float(y1.x << 16) + u.x * dd.x;
      const float a1 = __uint_as_float(y0.x & 0xffff0000u) + __uint_as_float(y1.x & 0xffff0000u) + u.y * dd.y;
      const float a2 = __uint_as_float(y0.y << 16) + __uint_as_float(y1.y << 16) + u.z * dd.z;
      const float a3 = __uint_as_float(y0.y & 0xffff0000u) + __uint_as_float(y1.y & 0xffff0000u) + u.w * dd.w;
      uint2 o; o.x = pk2(gelu_tanh(a0), gelu_tanh(a1)); o.y = pk2(gelu_tanh(a2), gelu_tanh(a3));
      *(uint2*)(sG + rr * 264 + c4) = o;
    }
    __syncthreads();
    f32x16 acc[2][2];
    zero_acc<2>(acc);
#pragma unroll 4
    for (int kk = 0; kk < 16; ++kk) {
      const bf16x8 a0 = *(const bf16x8*)(sG + r * 264 + kk * 16 + 8 * h), a1 = *(const bf16x8*)(sG + (32 + r) * 264 + kk * 16 + 8 * h);
      const bf16x8 b0 = *(const bf16x8*)(WGLU + (size_t)(wave * 64 + r) * 256 + kk * 16 + 8 * h);
      const bf16x8 b1 = *(const bf16x8*)(WGLU + (size_t)(wave * 64 + 32 + r) * 256 + kk * 16 + 8 * h);
      acc[0][0] = MFMA32(a0, b0, acc[0][0]);
      acc[0][1] = MFMA32(a0, b1, acc[0][1]);
      acc[1][0] = MFMA32(a1, b0, acc[1][0]);
      acc[1][1] = MFMA32(a1, b1, acc[1][1]);
    }
#pragma unroll
    for (int mi = 0; mi < 2; ++mi)
#pragma unroll
      for (int ni = 0; ni < 2; ++ni) {
        const int col = wave * 64 + ni * 32 + r;
        const float bias = gb[col];
#pragma unroll
        for (int i = 0; i < 16; ++i) {
          const int lr = mi * 32 + crow(i, h);
          const float g = bf2f(sG[lr * 264 + col]);
          O3[(size_t)(m0 + lr) * 256 + col] = f2bf(g * sigmoidf_(acc[mi][ni][i] + bias));
        }
      }
    __syncthreads();
  }
}

DI f32x2 cmulf(f32x2 a, f32x2 b) { f32x2 r = {a.x * b.x - a.y * b.y, a.x * b.y + a.y * b.x}; return r; }
DI void s5_item(const P& p, int layer, int combo, unsigned char* smem) {
  unsigned char* ws = p.ws;
  const int tid = TIDX, lane = tid & 63, wave = tid >> 6;
  const int d = combo & 1, g = (combo >> 1) & 15, b = combo >> 5;
  f32x2* sX = (f32x2*)(smem + wave * 8448);
  bf16_t* sH = (bf16_t*)(smem + 4 * 8448) + wave * (16 * 136);
  f32x2* sE = (f32x2*)(smem + 4 * 8448 + 4 * 16 * 136 * 2);
  const float* S5U = (const float*)(ws + O_S5U);
  bf16_t* Y = (bf16_t*)(ws + O_Y) + (size_t)d * M_ALL * 256;
  const int pbase = ((layer * 2 + d) * 16 + g) * 64;
  const int col = lane & 15, q = lane >> 4;
  f32x2 ab, ff;
  {
    const float a_re = p.in[I_ARE][pbase + lane], a_im = p.in[I_AIM][pbase + lane];
    const float dt = fast_exp(p.in[I_LOGDT][(layer * 2 + d) * 16 + g]);
    const float mag = fast_exp(dt * a_re);
    float sn, cs; sincos_d((double)(dt * a_im), sn, cs);
    ab.x = mag * cs; ab.y = mag * sn;
    const float den = a_re * a_re + a_im * a_im;
    ff.x = ((ab.x - 1.f) * a_re + ab.y * a_im) / den;
    ff.y = (ab.y * a_re - (ab.x - 1.f) * a_im) / den;
  }
  bf16x8 fA[8];
#pragma unroll
  for (int blk = 0; blk < 8; ++blk) {
    const int ps = 8 * blk + (col >> 1), im = col & 1;
    const float fx = __shfl(ff.x, ps), fy = __shfl(ff.y, ps);
    const float* bre = p.in[I_BRE] + (size_t)(pbase + ps) * 16 + 8 * (q & 1);
    const float* bim = p.in[I_BIM] + (size_t)(pbase + ps) * 16 + 8 * (q & 1);
#pragma unroll
    for (int j = 0; j < 8; j += 2) {
      const float br0 = bre[j], bi0 = bim[j], br1 = bre[j + 1], bi1 = bim[j + 1];
      float v0 = im ? (fx * bi0 + fy * br0) : (fx * br0 - fy * bi0);
      float v1 = im ? (fx * bi1 + fy * br1) : (fx * br1 - fy * bi1);
      if (q >= 2) { v0 = 0.f; v1 = 0.f; }
      const unsigned w = pk2(v0, v1);
      fA[blk][j] = (short)(w & 0xffffu); fA[blk][j + 1] = (short)(w >> 16);
    }
  }
  bf16x8 cB[4];
  {
    const float* cre = p.in[I_CRE] + ((size_t)((layer * 2 + d) * 16 + g) * 16 + col) * 64;
    const float* cim = p.in[I_CIM] + ((size_t)((layer * 2 + d) * 16 + g) * 16 + col) * 64;
#pragma unroll
    for (int ks = 0; ks < 4; ++ks)
#pragma unroll
      for (int j = 0; j < 8; j += 2) {
        const int pp = (32 * ks + 8 * q + j) >> 1;
        const unsigned w = pk2(cre[pp], -cim[pp]);
        cB[ks][j] = (short)(w & 0xffffu); cB[ks][j + 1] = (short)(w >> 16);
      }
  }
  f32x2 apow;
  {
    f32x2 a2 = ab;
#pragma unroll
    for (int i = 0; i < 6; ++i) a2 = cmulf(a2, a2);
    f32x2 a3 = a2;
#pragma unroll
    for (int i = 0; i < 4; ++i) a3 = cmulf(a3, a3);
    apow = cmulf(a2, a3);
  }
  f32x2 hst = {0.f, 0.f};
#pragma unroll 1
  for (int pass = 0; pass < 2; ++pass) {
    for (int gj = 0; gj < 68; ++gj) {
      const int grp = wave * 68 + gj;
      const bool isctx = grp < 16;
      const int gi = isctx ? grp : grp - 16, L = isctx ? 256 : 4096;
      const int rowbase = isctx ? M_LAT + b * 256 : b * 4096;
      bf16x8 ub;
      {
        const int n = gi * 16 + col, t = d ? L - 1 - n : n;
        const float* up = S5U + (size_t)(rowbase + t) * 256 + g * 16 + 8 * (q & 1);
        const float4 u0 = *(const float4*)up, u1 = *(const float4*)(up + 4);
        unsigned w0 = pk2(u0.x, u0.y), w1 = pk2(u0.z, u0.w), w2 = pk2(u1.x, u1.y), w3 = pk2(u1.z, u1.w);
        if (q >= 2) { w0 = 0u; w1 = 0u; w2 = 0u; w3 = 0u; }
        ub[0] = (short)(w0 & 0xffffu); ub[1] = (short)(w0 >> 16); ub[2] = (short)(w1 & 0xffffu); ub[3] = (short)(w1 >> 16);
        ub[4] = (short)(w2 & 0xffffu); ub[5] = (short)(w2 >> 16); ub[6] = (short)(w3 & 0xffffu); ub[7] = (short)(w3 >> 16);
      }
#pragma unroll
      for (int blk = 0; blk < 8; ++blk) {
        f32x4 xz = {0.f, 0.f, 0.f, 0.f};
        xz = MFMA16(fA[blk], ub, xz);
        *(f32x4*)(sX + col * 66 + 8 * blk + 2 * q) = xz;
      }
      __syncthreads();
#pragma unroll 4
      for (int tt = 0; tt < 16; ++tt) {
        const f32x2 x = sX[tt * 66 + lane];
        f32x2 hn;
        hn.x = ab.x * hst.x - ab.y * hst.y + x.x;
        hn.y = ab.x * hst.y + ab.y * hst.x + x.y;
        hst = hn;
        if (pass) *(unsigned*)(sH + tt * 136 + 2 * lane) = pk2(hst.x, hst.y);
      }
      __syncthreads();
      if (pass) {
        f32x4 acc = {0.f, 0.f, 0.f, 0.f};
#pragma unroll
        for (int ks = 0; ks < 4; ++ks) {
          const bf16x8 a = *(const bf16x8*)(sH + (lane & 15) * 136 + ks * 32 + 8 * q);
          acc = MFMA16(a, cB[ks], acc);
        }
#pragma unroll
        for (int i = 0; i < 4; ++i) {
          const int tt = q * 4 + i, n = gi * 16 + tt, t = d ? L - 1 - n : n;
          Y[(size_t)(rowbase + t) * 256 + g * 16 + col] = f2bf(acc[i]);
        }
      }
    }
    if (pass == 0) {
      sE[wave * 64 + lane] = hst;
      __syncthreads();
      f32x2 st = {0.f, 0.f};
      for (int w = 0; w < wave; ++w) st = cmulf(apow, st) + sE[w * 64 + lane];
      hst = st;
      __syncthreads();
    }
  }
  __syncthreads();
}

DI float hy_in(const bf16_t* chp, int L, int t, float w0, float w1, float w2, float cb) {
  const float x0 = t > 0 ? bf2f(chp[t - 1]) : 0.f, x1 = bf2f(chp[t]), x2 = (t + 1 < L) ? bf2f(chp[t + 1]) : 0.f;
  return cb + w0 * x0 + w1 * x1 + w2 * x2;
}
DI void hyena_item(const P& p, int layer, int kind, int c, int bp, unsigned char* smem) {
  unsigned char* ws = p.ws;
  const int tid = TIDX;
  const int L = kind ? 256 : 4096, N = 2 * L, logN = kind ? 9 : 13;
  f32x2* W = (f32x2*)smem;
  const bf16_t* HYT = (const bf16_t*)(ws + O_HYT);
  const bf16_t* s0 = HYT + (kind ? HYT_LATSZ + (size_t)(2 * bp) * 768 * 256 : (size_t)(2 * bp) * 768 * 4096);
  const bf16_t* s1 = s0 + (size_t)768 * L;
  const int row0 = kind ? M_LAT + (2 * bp) * 256 : (2 * bp) * 4096;
  const int row1 = row0 + L;
  const float* cw = p.in[I_HCW] + (size_t)layer * 3 * 768;
  const float* cbv = p.in[I_HCB] + (size_t)layer * 768;
  const float bias1 = p.in[I_HBIAS][(layer * 2 + 0) * 256 + c], bias2 = p.in[I_HBIAS][(layer * 2 + 1) * 256 + c];
  const f32x2* KFa = kind ? (const f32x2*)(ws + O_KF1) + (size_t)(c * 2) * 512 : (const f32x2*)(ws + O_KF0) + (size_t)(c * 2) * 8192;
  const f32x2* KFb = KFa + N;
  bf16_t* OUT = (bf16_t*)(ws + O_O4) + (size_t)1 * M_ALL * 256;
  f32x2 zr[16];
  {
    const int ch = c;
    const float w0 = cw[ch], w1 = cw[768 + ch], w2 = cw[1536 + ch], cb = cbv[ch];
#pragma unroll
    for (int i = 0; i < 16; ++i) {
      const int t = tid + 256 * i;
      if (t < L) {
        f32x2 v = {hy_in(s0 + (size_t)ch * L, L, t, w0, w1, w2, cb), hy_in(s1 + (size_t)ch * L, L, t, w0, w1, w2, cb)};
        zr[i] = v; W[PH(t)] = v;
        f32x2 zz = {0.f, 0.f};
        W[PH(t + L)] = zz;
      }
    }
  }
  __syncthreads();
  fft_dif(W, N, logN);
  for (int n = tid; n < N; n += NT) W[PH(n)] = cmul(W[PH(n)], KFa[n]);
  __syncthreads();
  fft_dit_inv(W, N, logN);
  {
    const int ch = 256 + c;
    const float w0 = cw[ch], w1 = cw[768 + ch], w2 = cw[1536 + ch], cb = cbv[ch];
#pragma unroll
    for (int i = 0; i < 16; ++i) {
      const int t = tid + 256 * i;
      if (t < L) {
        const f32x2 y = W[PH(t)];
        const float g0 = hy_in(s0 + (size_t)ch * L, L, t, w0, w1, w2, cb), g1 = hy_in(s1 + (size_t)ch * L, L, t, w0, w1, w2, cb);
        zr[i].x = g0 * (y.x + bias1 * zr[i].x);
        zr[i].y = g1 * (y.y + bias1 * zr[i].y);
      }
    }
  }
  __syncthreads();
#pragma unroll
  for (int i = 0; i < 16; ++i) {
    const int t = tid + 256 * i;
    if (t < L) { W[PH(t)] = zr[i]; f32x2 zz = {0.f, 0.f}; W[PH(t + L)] = zz; }
  }
  __syncthreads();
  fft_dif(W, N, logN);
  for (int n = tid; n < N; n += NT) W[PH(n)] = cmul(W[PH(n)], KFb[n]);
  __syncthreads();
  fft_dit_inv(W, N, logN);
  {
    const int ch = 512 + c;
    const float w0 = cw[ch], w1 = cw[768 + ch], w2 = cw[1536 + ch], cb = cbv[ch];
#pragma unroll
    for (int i = 0; i < 16; ++i) {
      const int t = tid + 256 * i;
      if (t < L) {
        const f32x2 y = W[PH(t)];
        const float g0 = hy_in(s0 + (size_t)ch * L, L, t, w0, w1, w2, cb), g1 = hy_in(s1 + (size_t)ch * L, L, t, w0, w1, w2, cb);
        OUT[(size_t)(row0 + t) * 256 + c] = f2bf(g0 * (y.x + bias2 * zr[i].x));
        OUT[(size_t)(row1 + t) * 256 + c] = f2bf(g1 * (y.y + bias2 * zr[i].y));
      }
    }
  }
  __syncthreads();
}

template <int DQK>
DI void attn_item(const bf16_t* __restrict__ Qh, int qstride, const bf16_t* __restrict__ Kh, const bf16_t* __restrict__ Vth, bf16_t* __restrict__ Oh,
                  int a0, int a1, int b0, int b1, bool band, int qpos0, float m_init, float l_init, unsigned char* smem) {
  constexpr int KS = DQK + 8, NQ = DQK / 16, KCH = DQK / 8, KPT = (64 * KCH) / 256;
  bf16_t* sK = (bf16_t*)smem;
  bf16_t* sV = (bf16_t*)(smem + 2 * 64 * KS * 2);
  const int tid = TIDX, lane = tid & 63, wave = tid >> 6, r = lane & 31, h = lane >> 5;
  bf16x8 qf[NQ];
  {
    const bf16_t* qp = Qh + (size_t)(wave * 32 + r) * qstride + 8 * h;
#pragma unroll
    for (int ds = 0; ds < NQ; ++ds) qf[ds] = *(const bf16x8*)(qp + ds * 16);
  }
  f32x16 o0, o1;
#pragma unroll
  for (int i = 0; i < 16; ++i) { o0[i] = 0.f; o1[i] = 0.f; }
  float m = m_init, l = (h == 0) ? l_init : 0.f;
  const int nA = (a1 - a0) >> 6, nB = (b1 - b0) >> 6, nT = nA + nB;
  uint4 rk0, rk1, rk2 = {0u, 0u, 0u, 0u}, rv0, rv1;
#define ATT_KADDR(i) (Kh + (size_t)(key0_ + (tid + 256 * (i)) / KCH) * DQK + ((tid + 256 * (i)) % KCH) * 8)
#define ATT_VADDR(i) (Vth + (size_t)((tid + 256 * (i)) >> 3) * KEYS + key0_ + ((tid + 256 * (i)) & 7) * 8)
#define ATT_GLOAD(TI)                                                                                         \
  {                                                                                                           \
    const int ti_ = (TI);                                                                                     \
    const int key0_ = ti_ < nA ? a0 + ti_ * 64 : b0 + (ti_ - nA) * 64;                                        \
    rk0 = *(const uint4*)ATT_KADDR(0);                                                                        \
    rk1 = *(const uint4*)ATT_KADDR(1);                                                                        \
    if (KPT > 2) rk2 = *(const uint4*)ATT_KADDR(2);                                                           \
    rv0 = *(const uint4*)ATT_VADDR(0);                                                                        \
    rv1 = *(const uint4*)ATT_VADDR(1);                                                                        \
  }
#define ATT_KSADDR(i) (sK + buf_ * (64 * KS) + ((tid + 256 * (i)) / KCH) * KS + ((tid + 256 * (i)) % KCH) * 8)
#define ATT_VSADDR(i) (sV + buf_ * (64 * 72) + ((tid + 256 * (i)) >> 3) * 72 + ((tid + 256 * (i)) & 7) * 8)
#define ATT_SSTORE(BUF)                                                                                       \
  {                                                                                                           \
    const int buf_ = (BUF);                                                                                   \
    *(uint4*)ATT_KSADDR(0) = rk0;                                                                             \
    *(uint4*)ATT_KSADDR(1) = rk1;                                                                             \
    if (KPT > 2) *(uint4*)ATT_KSADDR(2) = rk2;                                                                \
    *(uint4*)ATT_VSADDR(0) = rv0;                                                                             \
    *(uint4*)ATT_VSADDR(1) = rv1;                                                                             \
  }
  ATT_GLOAD(0)
  ATT_SSTORE(0)
  __syncthreads();
  for (int ti = 0; ti < nT; ++ti) {
    const int cur = ti & 1;
    if (ti + 1 < nT) ATT_GLOAD(ti + 1)
    __builtin_amdgcn_sched_barrier(0);
    const bool inA = ti < nA;
    const int key0 = inA ? a0 + ti * 64 : b0 + (ti - nA) * 64;
    const bool msk = band && inA;
#pragma unroll
    for (int kb = 0; kb < 2; ++kb) {
      const int kbase = key0 + kb * 32;
      bool skip = false;
      if (msk) { const int qw = qpos0 + wave * 32; skip = (kbase > qw + 31 + 128) || (kbase + 31 < qw - 128); }
      if (!skip) {
        f32x16 s;
#pragma unroll
        for (int i = 0; i < 16; ++i) s[i] = 0.f;
        const bf16_t* kp = sK + cur * (64 * KS) + (kb * 32 + r) * KS + 8 * h;
#pragma unroll
        for (int ds = 0; ds < NQ; ++ds) { const bf16x8 a = *(const bf16x8*)(kp + ds * 16); s = MFMA32(a, qf[ds], s); }
        if (msk) {
          const int qp_ = qpos0 + wave * 32 + r;
#pragma unroll
          for (int i = 0; i < 16; ++i) { const int dlt = qp_ - (kbase + crow(i, h)); if (dlt > 128 || dlt < -128) s[i] = -1e30f; }
        }
        float mx = s[0];
#pragma unroll
        for (int i = 1; i < 16; ++i) mx = fmaxf(mx, s[i]);
        mx = fmaxf(mx, __shfl_xor(mx, 32));
        const float mn = fmaxf(m, mx);
        const float alpha = __builtin_amdgcn_exp2f(m - mn);
        m = mn;
        s = s - mn;
#pragma unroll
        for (int i = 0; i < 16; ++i) s[i] = __builtin_amdgcn_exp2f(s[i]);
        float ps;
        {
          typedef float f32x8_t __attribute__((ext_vector_type(8)));
          const f32x8_t lo8 = __builtin_shufflevector(s, s, 0, 1, 2, 3, 4, 5, 6, 7), hi8 = __builtin_shufflevector(s, s, 8, 9, 10, 11, 12, 13, 14, 15);
          const f32x8_t s8 = lo8 + hi8;
          const f32x4 s4 = __builtin_shufflevector(s8, s8, 0, 1, 2, 3) + __builtin_shufflevector(s8, s8, 4, 5, 6, 7);
          const f32x2 s2 = __builtin_shufflevector(s4, s4, 0, 1) + __builtin_shufflevector(s4, s4, 2, 3);
          ps = s2.x + s2.y;
        }
        l = l * alpha + ps;
        if (__builtin_amdgcn_ballot_w64(alpha != 1.0f) != 0ull) {
#pragma unroll
          for (int i = 0; i < 16; ++i) { o0[i] *= alpha; o1[i] *= alpha; }
        }
        bf16x8 pf0, pf1;
#pragma unroll
        for (int j = 0; j < 8; j += 2) {
          const unsigned w0 = pk2(s[j], s[j + 1]), w1 = pk2(s[8 + j], s[8 + j + 1]);
          pf0[j] = (short)(w0 & 0xffffu); pf0[j + 1] = (short)(w0 >> 16);
          pf1[j] = (short)(w1 & 0xffffu); pf1[j + 1] = (short)(w1 >> 16);
        }
        const bf16_t* vp = sV + cur * (64 * 72) + r * 72 + kb * 32 + 4 * h;
#pragma unroll
        for (int st = 0; st < 2; ++st) {
          const s16x4 lo0 = *(const s16x4*)(vp + 16 * st), hi0 = *(const s16x4*)(vp + 16 * st + 8);
          const s16x4 lo1 = *(const s16x4*)(vp + 32 * 72 + 16 * st), hi1 = *(const s16x4*)(vp + 32 * 72 + 16 * st + 8);
          const bf16x8 va0 = __builtin_shufflevector(lo0, hi0, 0, 1, 2, 3, 4, 5, 6, 7);
          const bf16x8 va1 = __builtin_shufflevector(lo1, hi1, 0, 1, 2, 3, 4, 5, 6, 7);
          o0 = MFMA32(va0, st ? pf1 : pf0, o0);
          o1 = MFMA32(va1, st ? pf1 : pf0, o1);
        }
      }
    }
    __builtin_amdgcn_sched_barrier(0);
    if (ti + 1 < nT) ATT_SSTORE(cur ^ 1)
    __syncthreads();
  }
  l += __shfl_xor(l, 32);
  const float inv = 1.0f / l;
  bf16_t* op = Oh + (size_t)(wave * 32 + r) * 256;
#pragma unroll
  for (int g = 0; g < 4; ++g) {
    uint2 w;
    w.x = pk2(o0[4 * g] * inv, o0[4 * g + 1] * inv); w.y = pk2(o0[4 * g + 2] * inv, o0[4 * g + 3] * inv);
    *(uint2*)(op + 8 * g + 4 * h) = w;
    w.x = pk2(o1[4 * g] * inv, o1[4 * g + 1] * inv); w.y = pk2(o1[4 * g + 2] * inv, o1[4 * g + 3] * inv);
    *(uint2*)(op + 32 + 8 * g + 4 * h) = w;
  }
}

DI void mla_item(const P& p, int b, int head, int row0, int a0, int a1, unsigned char* smem) {
  unsigned char* ws = p.ws;
  const bf16_t* Q = (const bf16_t*)(ws + O_QMLA) + ((size_t)row0 * 4 + head) * 96;
  const bf16_t* K = (const bf16_t*)(ws + O_KMLA) + ((size_t)b * 4 + head) * KEYS * 96;
  const bf16_t* V = (const bf16_t*)(ws + O_VMLAT) + ((size_t)b * 4 + head) * 64 * KEYS;
  bf16_t* O = (bf16_t*)(ws + O_O4) + (size_t)row0 * 256 + head * 64;
  attn_item<96>(Q, 384, K, V, O, a0, a1, 0, 0, false, 0, -1e30f, 0.f, smem);
}
DI void swa_item(const P& p, int layer, int b, int head, int row0, int a0, int a1, int b0, int b1, bool band, int qpos0, unsigned char* smem) {
  unsigned char* ws = p.ws;
  const int kvh = head >> 1;
  const bf16_t* Q = (const bf16_t*)(ws + O_QSWA) + ((size_t)row0 * 4 + head) * 64;
  const bf16_t* K = (const bf16_t*)(ws + O_KSWA) + ((size_t)b * 2 + kvh) * KEYS * 64;
  const bf16_t* V = (const bf16_t*)(ws + O_VSWAT) + ((size_t)b * 2 + kvh) * 64 * KEYS;
  bf16_t* O = (bf16_t*)(ws + O_O4) + (size_t)2 * M_ALL * 256 + (size_t)row0 * 256 + head * 64;
  const float sink = p.in[I_SINK][layer * 4 + head] * LOG2E;
  attn_item<64>(Q, 256, K, V, O, a0, a1, b0, b1, band, qpos0, sink, 1.f, smem);
}

DI void phase_mix(const P& p, int slot, int layer, bool ctx_out, unsigned char* smem, int* s_item) {
  unsigned* ctr = (unsigned*)(p.ws + O_CTR) + slot;
  const int n_s5 = 256, n_hy = 1024, n_mla = 1024, n_swa = 1024;
  const int e0 = n_s5, e1 = e0 + n_hy, e2 = e1 + n_mla, e3 = e2 + n_swa;
  const int e4 = e3 + (ctx_out ? 1024 : 0), e5 = e4 + (ctx_out ? 64 : 0), e6 = e5 + (ctx_out ? 64 : 0);
  for (;;) {
    if (TIDX == 0) *s_item = (int)atomicAdd(ctr, 1u);
    __syncthreads();
    const int it = *s_item;
    __syncthreads();
    if (it >= e6) break;
    if (it < e0) { for (int rp = 0; rp < REP_S5; ++rp) s5_item(p, layer, it, smem); }
    else if (it < e1) { const int j = it - e0; for (int rp = 0; rp < REP_HY; ++rp) hyena_item(p, layer, 0, j >> 2, j & 3, smem); }
    else if (it < e2) {
      const int j = it - e1, qb = j & 31, head = (j >> 5) & 3, b = j >> 7;
      for (int rp = 0; rp < REP_MLA; ++rp) mla_item(p, b, head, b * 4096 + qb * 128, 0, KEYS, smem);
    } else if (it < e3) {
      const int j = it - e2, qb = j & 31, head = (j >> 5) & 3, b = j >> 7, q0 = qb * 128;
      const int a0 = q0 >= 128 ? q0 - 128 : 0, a1 = q0 + 256 <= 4096 ? q0 + 256 : 4096;
      for (int rp = 0; rp < REP_SWA; ++rp) swa_item(p, layer, b, head, b * 4096 + q0, a0, a1, 4096, KEYS, true, q0, smem);
    } else if (it < e4) { const int j = it - e3; hyena_item(p, layer, 1, j >> 2, j & 3, smem); }
    else if (it < e5) {
      const int j = it - e4, qb = j & 1, head = (j >> 1) & 3, b = j >> 3;
      mla_item(p, b, head, M_LAT + b * 256 + qb * 128, 4096, KEYS, smem);
    } else {
      const int j = it - e5, qb = j & 1, head = (j >> 1) & 3, b = j >> 3;
      swa_item(p, layer, b, head, M_LAT + b * 256 + qb * 128, 4096, KEYS, 0, 0, false, 0, smem);
    }
  }
}

#define XB_TMO      128
#define XB_XCNT(j)  (256  + 64 * (j))
#define XB_XSUB(j)  (1280 + 64 * (j))
#define XB_XGEN(j)  (2304 + 64 * (j))
#define XB_TOP      3328
#define XB_TOPGEN   3392
#define XCD_BAR_WORDS 3456
#define XB_SPIN_CAP (1u << 22)
#define LAS __attribute__((address_space(3)))
DI unsigned xb_ld(unsigned* p) { return __hip_atomic_load(p, __ATOMIC_RELAXED, __HIP_MEMORY_SCOPE_AGENT); }
DI unsigned xb_add(unsigned* p, unsigned v) { return __hip_atomic_fetch_add(p, v, __ATOMIC_RELAXED, __HIP_MEMORY_SCOPE_AGENT); }
DI unsigned xb_xcc_id() { return (unsigned)__builtin_amdgcn_s_getreg((3 << 11) | 20) & 0xFu; }
#define XB_SPIN(cond, bar) do { unsigned _sp = 0; while (cond) { __builtin_amdgcn_s_sleep(1); \
    if ((++_sp & 255u) == 0u) { if (xb_ld(&(bar)[XB_TMO])) break; if (_sp > XB_SPIN_CAP) { atomicAdd(&(bar)[XB_TMO], 1u); break; } } } } while (0)
struct XcdBarrier { unsigned* bar; unsigned x; volatile LAS unsigned* st; };
DI XcdBarrier xcd_barrier_post(unsigned* bar, volatile LAS unsigned* st) {
  XcdBarrier b; b.bar = bar; b.x = xb_xcc_id(); b.st = st;
  if (threadIdx.x == 0) (void)xb_add(&bar[XB_XCNT(b.x)], 1u);
  return b;
}
DI void xcd_barrier_complete(unsigned* bar, unsigned x, unsigned& nloc, unsigned& nx) {
  const unsigned G = gridDim.x * gridDim.y * gridDim.z;
  unsigned sum, cnt, mine, sp = 0u;
  for (;;) {
    sum = 0u; cnt = 0u; mine = 0u;
#pragma unroll
    for (unsigned j = 0; j < 16; ++j) { const unsigned c = xb_ld(&bar[XB_XCNT(j)]); sum += c; cnt += (c > 0u) ? 1u : 0u; mine = (j == x) ? c : mine; }
    if (sum == G) break;
    __builtin_amdgcn_s_sleep(1);
    if ((++sp & 255u) == 0u) { if (xb_ld(&bar[XB_TMO])) break; if (sp > XB_SPIN_CAP) { atomicAdd(&bar[XB_TMO], 1u); break; } }
  }
  nloc = mine > 0u ? mine : 1u; nx = cnt > 0u ? cnt : 1u;
}
DI void xcd_barrier(const XcdBarrier& b) {
  asm volatile("s_waitcnt vmcnt(0)" ::: "memory");
  __syncthreads();
  if (threadIdx.x == 0) {
    unsigned* bar = b.bar;
    __builtin_amdgcn_s_waitcnt(0);
    unsigned nloc = b.st[0], nx = b.st[1];
    if (nloc == 0u) { xcd_barrier_complete(bar, b.x, nloc, nx); b.st[0] = nloc; b.st[1] = nx; }
    const unsigned old = xb_add(&bar[XB_XSUB(b.x)], 1u);
    const unsigned gen = old / nloc;
    if (old + 1u == (gen + 1u) * nloc) {
      __builtin_amdgcn_fence(__ATOMIC_RELEASE, "agent");
      asm volatile("s_waitcnt vmcnt(0)" ::: "memory");
      const unsigned og = xb_add(&bar[XB_TOP], 1u);
      const unsigned tg = og / nx;
      if (og + 1u == (tg + 1u) * nx) xb_add(&bar[XB_TOPGEN], 1u);
      else XB_SPIN(xb_ld(&bar[XB_TOPGEN]) == tg, bar);
      __builtin_amdgcn_fence(__ATOMIC_ACQUIRE, "agent");
      xb_add(&bar[XB_XGEN(b.x)], 1u);
      asm volatile("s_waitcnt vmcnt(0)" ::: "memory");
    } else {
      XB_SPIN(xb_ld(&bar[XB_XGEN(b.x)]) == gen, bar);
      __builtin_amdgcn_fence(__ATOMIC_ACQUIRE, "agent");
      asm volatile("s_waitcnt vmcnt(0)" ::: "memory");
    }
  }
  __syncthreads();
}

#ifndef REP_UPDN
#define REP_UPDN 1
#endif
#ifndef REP_MIXER_GEMM
#define REP_MIXER_GEMM 1
#endif
#ifndef REP_MIX
#define REP_MIX 1
#endif
#ifndef REP_PRO
#define REP_PRO 1
#endif
#ifndef REP_CONV
#define REP_CONV 1
#endif
#ifndef REP_KF
#define REP_KF 1
#endif
#ifndef REP_MODH
#define REP_MODH 1
#endif
#ifndef REP_MODONLY
#define REP_MODONLY 1
#endif
#ifndef REP_H2ONLY
#define REP_H2ONLY 1
#endif
#ifndef REP_SYNC
#define REP_SYNC 1
#endif
#define GSYNC() { for (int rs_ = 0; rs_ < REP_SYNC; ++rs_) xcd_barrier(xb); }
__global__ void __launch_bounds__(NT, 2) fwd_megakernel(P p) {
  cg::grid_group grid = cg::this_grid();
  __shared__ __attribute__((aligned(16))) unsigned char smem[SMEM_BYTES];
  __shared__ int s_item;
  unsigned char* ws = p.ws;
  __shared__ uint4 xb_words;
  if (threadIdx.x == 0) xb_words = make_uint4(0u, 0u, 0u, 0u);
  __syncthreads();
  XcdBarrier xb = xcd_barrier_post((unsigned*)(ws + O_BAR), (volatile LAS unsigned*)&xb_words);
  for (int rep = 0; rep < REP_PRO; ++rep) {
    for (int r2 = 0; r2 < REP_MODH; ++r2) { for (int r3 = 0; r3 < REP_MODONLY; ++r3) phase_modulation(p, smem); for (int r3 = 0; r3 < REP_H2ONLY; ++r3) phase_h2(p); phase_rope(p); }
    for (int r2 = 0; r2 < REP_CONV; ++r2) phase_convert(p, 0, smem);
    if (p.out == nullptr) grid.sync();
    GSYNC();
  }
  for (int rep = 0; rep < REP_PRO * REP_KF; ++rep) phase_kf(p, 0, true, smem);
  phase_rows(p, M_ALL, 0, 0, 0, 0.f, true, true, 0, 0, false);
  GSYNC();
#pragma unroll 1
  for (int layer = 0; layer < 2; ++layer) {
    const bool ctx_out = layer == 0;
    const int Mc = ctx_out ? M_ALL : M_LAT;
    for (int rep = 0; rep < REP_UPDN; ++rep) {
      phase_ffn_up(p, M_ALL, O_WUP1, smem);
      GSYNC();
      phase_gemm_plain_bf16(p, M_ALL, (const bf16_t*)(ws + O_ACT), DFF, (const bf16_t*)(ws + O_WDN1), (bf16_t*)(ws + O_F), 1024, smem);
      GSYNC();
    }
    phase_rows(p, M_ALL, 1, layer, 0, 0.5f, layer == 0, true, layer, 1, true);
    GSYNC();
    for (int rep = 0; rep < REP_MIXER_GEMM; ++rep) {
      if (rep) { phase_rows(p, M_ALL, 2, layer, 0, 0.f, false, false, 0, 0, true); GSYNC(); }
      phase_win(p, M_ALL, smem);
      GSYNC();
      phase_kvq(p, M_ALL, Mc, smem);
      GSYNC();
    }
    for (int rep = 0; rep < REP_MIX; ++rep) {
      phase_mix(p, layer + 2 * rep, layer, ctx_out, smem, &s_item);
      GSYNC();
      phase_glu(p, layer, Mc, smem);
      GSYNC();
    }
    for (int rep = 0; rep < REP_MIXER_GEMM; ++rep) {
      phase_merge(p, layer, Mc, smem);
      GSYNC();
      phase_gemm_plain_bf16(p, Mc, (const bf16_t*)(ws + O_MBUF), 1024, (const bf16_t*)(ws + O_WOUT), (bf16_t*)(ws + O_F), 1024, smem);
      GSYNC();
    }
    phase_rows(p, Mc, 1, layer, 1, 1.0f, false, true, layer, 2, false);
    GSYNC();
    for (int rep = 0; rep < REP_UPDN; ++rep) {
      phase_ffn_up(p, Mc, O_WUP2, smem);
      GSYNC();
      phase_gemm_plain_bf16(p, Mc, (const bf16_t*)(ws + O_ACT), DFF, (const bf16_t*)(ws + O_WDN2), (bf16_t*)(ws + O_F), 1024, smem);
      GSYNC();
    }
    phase_rows(p, Mc, 1, layer, 2, 0.5f, false, layer == 0, layer + 1, 0, false);
    if (layer == 0) {
      for (int rep = 0; rep < REP_PRO; ++rep) {
        for (int r2 = 0; r2 < REP_CONV; ++r2) phase_convert(p, 1, smem);
        for (int r2 = 0; r2 < REP_KF; ++r2) phase_kf(p, 1, false, smem);
      }
    }
    GSYNC();
  }
}

extern "C" void kernel_launch(void* const* d_in, const int* in_sizes, int n_in, void* d_out, int out_size, void* d_ws, size_t ws_size,
                              hipStream_t stream) {
  (void)in_sizes; (void)out_size;
  static int grid_blocks = 0;
  if (!grid_blocks) {
    int dev = 0, cus = 0, per = 0;
    (void)hipGetDevice(&dev);
    (void)hipDeviceGetAttribute(&cus, hipDeviceAttributeMultiprocessorCount, dev);
    (void)hipOccupancyMaxActiveBlocksPerMultiprocessor(&per, fwd_megakernel, NT, 0);
    if (per > 2) per = 2;
    if (per < 1) per = 1;
    grid_blocks = cus * per;
    grid_blocks &= ~7;
  }
  if (ws_size < WS_NEED || n_in < N_INPUTS) {
    fprintf(stderr, "workspace too small: need %zu have %zu\n", (size_t)WS_NEED, ws_size);
    return;
  }
  P p{};
  for (int i = 0; i < N_INPUTS; ++i) p.in[i] = (const float*)d_in[i];
  p.out = (float*)d_out;
  p.ws = (unsigned char*)d_ws;
  (void)hipMemsetAsync((unsigned char*)d_ws + O_CTR, 0, (size_t)(O_R - O_CTR), stream);
  void* args[] = {&p};
  hipError_t e = hipLaunchCooperativeKernel((void*)fwd_megakernel, dim3(grid_blocks), dim3(NT), args, 0, stream);
  if (e != hipSuccess) fprintf(stderr, "cooperative launch failed: %s (grid %d)\n", hipGetErrorString(e), grid_blocks);
}
```

```cpp
#include <hip/hip_runtime.h>
#include <hip/hip_cooperative_groups.h>
#include <cstdio>
namespace cg = cooperative_groups;
#ifndef PROBE_DBL
#define PROBE_DBL 0
#endif
#ifndef REP_S5
#define REP_S5 1
#endif
#ifndef REP_HY
#define REP_HY 1
#endif
#ifndef REP_MLA
#define REP_MLA 1
#endif
#ifndef REP_SWA
#define REP_SWA 1
#endif

#define DI __device__ __forceinline__
typedef unsigned short bf16_t;
typedef short bf16x8 __attribute__((ext_vector_type(8)));
typedef short s16x4 __attribute__((ext_vector_type(4)));
typedef float f32x16 __attribute__((ext_vector_type(16)));
typedef float f32x4 __attribute__((ext_vector_type(4)));
typedef float f32x2 __attribute__((ext_vector_type(2)));
typedef __bf16 bf16v2 __attribute__((ext_vector_type(2)));
#define MFMA32(a, b, c) __builtin_amdgcn_mfma_f32_32x32x16_bf16((a), (b), (c), 0, 0, 0)
#define MFMA16(a, b, c) __builtin_amdgcn_mfma_f32_16x16x32_bf16((a), (b), (c), 0, 0, 0)

constexpr int NT = 256;
constexpr int DM = 1024, NB = 8, SEQ = 4096, CTX = 256, DFF = 2816;
constexpr int M_LAT = NB * SEQ, M_CTX = NB * CTX, M_ALL = M_LAT + M_CTX;
constexpr int KEYS = SEQ + CTX;
constexpr float EPS = 1e-6f;
constexpr float LOG2E = 1.4426950408889634f;
constexpr int SMEM_BYTES = 73728;

enum { I_X = 0, I_C, I_CTX, I_CCTX, I_WADA, I_BADA, I_NPRE, I_NPOST, I_UP1, I_DN1, I_UP2, I_DN2, I_WIN, I_QNORM, I_KVNORM, I_WUQ, I_WUKV,
       I_HCW, I_HCB, I_HW1, I_HB1, I_HFREQ, I_HW2, I_HB2, I_HW3, I_HBIAS, I_SINK, I_ARE, I_AIM, I_LOGDT, I_BRE, I_BIM, I_CRE, I_CIM, I_S5D,
       I_GLUW, I_GLUB, I_WGATE, I_BGATE, I_BRMLA, I_BRHY, I_BRSWA, I_BRS5, I_WOUT, N_INPUTS };

constexpr size_t AL(size_t x) { return (x + 255) & ~size_t(255); }
constexpr size_t O_WUP1 = 0;
constexpr size_t O_WDN1 = O_WUP1 + AL((size_t)5632 * 1024 * 2);
constexpr size_t O_WUP2 = O_WDN1 + AL((size_t)1024 * 2816 * 2);
constexpr size_t O_WDN2 = O_WUP2 + AL((size_t)5632 * 1024 * 2);
constexpr size_t O_WIN = O_WDN2 + AL((size_t)1024 * 2816 * 2);
constexpr size_t O_WGATE = O_WIN + AL((size_t)1920 * 1024 * 2);
constexpr size_t O_WBR = O_WGATE + AL((size_t)4096 * 1024 * 2);
constexpr size_t O_WOUT = O_WBR + AL((size_t)4 * 1024 * 256 * 2);
constexpr size_t O_WUKV = O_WOUT + AL((size_t)1024 * 1024 * 2);
constexpr size_t O_WUQ = O_WUKV + AL((size_t)512 * 128 * 2);
constexpr size_t O_WGLU = O_WUQ + AL((size_t)384 * 192 * 2);
constexpr size_t O_U = O_WGLU + AL((size_t)256 * 256 * 2);
constexpr size_t O_XC = O_U + AL((size_t)M_ALL * 1024 * 2);
constexpr size_t O_MOD = O_XC + AL((size_t)M_CTX * 1024 * 4);
constexpr size_t O_H2 = O_MOD + AL((size_t)2 * 9 * 9216 * 4);
constexpr size_t O_ROPEM = O_H2 + AL((size_t)2 * (4096 + 256) * 64 * 4);
constexpr size_t O_ROPEW = O_ROPEM + AL((size_t)4096 * 16 * 8);
constexpr size_t O_KF0 = O_ROPEW + AL((size_t)4096 * 32 * 8);
constexpr size_t O_KF1 = O_KF0 + AL((size_t)256 * 2 * 8192 * 8);
constexpr size_t O_ROWSS = O_KF1 + AL((size_t)256 * 2 * 512 * 8);
constexpr size_t O_CTR = O_ROWSS + AL((size_t)2 * M_ALL * 4);
constexpr size_t O_BAR = O_CTR + 256;
constexpr size_t O_R = O_BAR + AL((size_t)3456 * 4);
constexpr size_t O_ACT = O_R;
constexpr size_t O_F = O_R + AL((size_t)M_ALL * 2816 * 2);
constexpr size_t O_O4 = O_R;
constexpr size_t O_Y = O_O4 + AL((size_t)4 * M_ALL * 256 * 2);
constexpr size_t O_HYT = O_Y + AL((size_t)2 * M_ALL * 256 * 2);
constexpr size_t O_MBUF = O_HYT;
constexpr size_t O_S5U = O_HYT + AL((size_t)M_ALL * 768 * 2);
constexpr size_t O_CKV = O_S5U + AL((size_t)M_ALL * 256 * 4);
constexpr size_t O_CQ = O_CKV + AL((size_t)M_ALL * 128 * 2);
constexpr size_t O_KMLA = O_CQ + AL((size_t)M_ALL * 192 * 2);
constexpr size_t O_VMLAT = O_KMLA + AL((size_t)NB * 4 * KEYS * 96 * 2);
constexpr size_t O_QMLA = O_VMLAT + AL((size_t)NB * 4 * 64 * KEYS * 2);
constexpr size_t O_KSWA = O_QMLA + AL((size_t)M_ALL * 384 * 2);
constexpr size_t O_VSWAT = O_KSWA + AL((size_t)NB * 2 * KEYS * 64 * 2);
constexpr size_t O_QSWA = O_VSWAT + AL((size_t)NB * 2 * 64 * KEYS * 2);
constexpr size_t O_END_MIX = O_QSWA + AL((size_t)M_ALL * 256 * 2);
constexpr size_t O_END_FFN = O_F + AL((size_t)M_ALL * 1024 * 2);
constexpr size_t WS_NEED = O_END_MIX > O_END_FFN ? O_END_MIX : O_END_FFN;
static_assert(O_MBUF + (size_t)M_ALL * 1024 * 2 <= O_CKV, "mbuf overlaps");
static_assert(O_F >= O_CKV, "F placement");
static_assert(WS_NEED <= (size_t)512 * 1024 * 1024, "workspace budget");
constexpr size_t HYT_LATSZ = (size_t)NB * 768 * 4096;

struct P {
  const float* in[N_INPUTS];
  float* out;
  unsigned char* ws;
};

DI int opaque_i(int x) { asm volatile("" : "+v"(x)); return x; }
#define TIDX opaque_i((int)threadIdx.x)
DI unsigned pk2(float lo, float hi) { f32x2 v = {lo, hi}; return __builtin_bit_cast(unsigned, __builtin_convertvector(v, bf16v2)); }
DI bf16_t f2bf(float x) { return (bf16_t)(pk2(x, 0.f) & 0xffffu); }
DI float bf2f(bf16_t b) { return __uint_as_float(((unsigned)b) << 16); }
DI float wave_sum(float v) {
#pragma unroll
  for (int o = 32; o; o >>= 1) v += __shfl_xor(v, o);
  return v;
}
DI int crow(int i, int h) { return (i & 3) + 8 * (i >> 2) + 4 * h; }
DI float fast_exp(float x) { return __builtin_amdgcn_exp2f(x * LOG2E); }
DI float sigmoidf_(float x) { return __builtin_amdgcn_rcpf(1.f + fast_exp(-x)); }
DI float siluf_(float x) { return x * sigmoidf_(x); }
DI void sincos_d(double x, float& s_out, float& c_out) {
  double k = rint(x * 0.15915494309189535);
  double r = x - k * 6.283185307179586;
  double y = r * 0.0625, y2 = y * y;
  double s = y * (1.0 - y2 / 6.0 * (1.0 - y2 / 20.0 * (1.0 - y2 / 42.0 * (1.0 - y2 / 72.0 * (1.0 - y2 / 110.0)))));
  double c = 1.0 - y2 / 2.0 * (1.0 - y2 / 12.0 * (1.0 - y2 / 30.0 * (1.0 - y2 / 56.0 * (1.0 - y2 / 90.0 * (1.0 - y2 / 132.0)))));
#pragma unroll
  for (int i = 0; i < 4; ++i) { double s2 = 2.0 * s * c, c2 = c * c - s * s; s = s2; c = c2; }
  s_out = (float)s; c_out = (float)c;
}
DI float sin_acc(float x) { float s, c; sincos_d((double)x, s, c); return s; }

template <int NI>
DI void gemm_kloop(f32x16 (&acc)[2][NI], const bf16_t* __restrict__ A, int lda, const bf16_t* __restrict__ Bt, int ldb, int K, int m0, int n0,
                   unsigned char* smem) {
  unsigned char* sA = smem;
  unsigned char* sB = smem + 32768;
  const int tid = TIDX, lane = tid & 63, wave = tid >> 6, r = lane & 31, h = lane >> 5, wm = wave >> 1, wn = wave & 1;
  const int drow = wave * 8 + (lane >> 3);
  const int csw = (lane & 7) ^ ((drow >> 1) & 7);
  const bf16_t* gA = A + (size_t)(m0 + drow) * lda + csw * 8;
  const bf16_t* gB = Bt + (size_t)(n0 + drow) * ldb + csw * 8;
  const int ldst = wave * 1024 + lane * 16;
  const int rsw = (r >> 1) & 7;
#define G_ISSUE(BUF, KO)                                                                                                        \
  {                                                                                                                             \
    _Pragma("unroll") for (int i = 0; i < 4; ++i)                                                                               \
        __builtin_amdgcn_global_load_lds((const unsigned*)(gA + (size_t)(32 * i) * lda + (KO)),                                 \
                                         (unsigned*)(sA + (BUF) * 16384 + i * 4096 + ldst), 16, 0, 0);                          \
    _Pragma("unroll") for (int i = 0; i < 2 * NI; ++i)                                                                          \
        __builtin_amdgcn_global_load_lds((const unsigned*)(gB + (size_t)(32 * i) * ldb + (KO)),                                 \
                                         (unsigned*)(sB + (BUF) * 16384 + i * 4096 + ldst), 16, 0, 0);                          \
  }
  const int nk = K >> 6;
  __syncthreads();
  G_ISSUE(0, 0)
  asm volatile("s_waitcnt vmcnt(0)" ::: "memory");
  __syncthreads();
  for (int ks = 0; ks < nk; ++ks) {
    const int cur = ks & 1;
    if (ks + 1 < nk) G_ISSUE(cur ^ 1, (ks + 1) * 64)
    const unsigned char* ab = sA + cur * 16384 + (wm * 64 + r) * 128;
    const unsigned char* bb = sB + cur * 16384 + (wn * 32 * NI + r) * 128;
#pragma unroll
    for (int kk = 0; kk < 4; ++kk) {
      const int pc = ((kk * 2 + h) ^ rsw) * 16;
      const bf16x8 a0 = *(const bf16x8*)(ab + pc), a1 = *(const bf16x8*)(ab + 32 * 128 + pc);
#pragma unroll
      for (int ni = 0; ni < NI; ++ni) {
        const bf16x8 b = *(const bf16x8*)(bb + ni * 32 * 128 + pc);
        acc[0][ni] = MFMA32(a0, b, acc[0][ni]);
        acc[1][ni] = MFMA32(a1, b, acc[1][ni]);
      }
    }
    asm volatile("s_waitcnt vmcnt(0)" ::: "memory");
    __syncthreads();
  }
#undef G_ISSUE
}
template <int NI>
DI void zero_acc(f32x16 (&acc)[2][NI]) {
#pragma unroll
  for (int a = 0; a < 2; ++a)
#pragma unroll
    for (int b = 0; b < NI; ++b)
#pragma unroll
      for (int i = 0; i < 16; ++i) acc[a][b][i] = 0.f;
}
#define DSR(dst, addr, off) asm volatile("ds_read_b128 %0, %1 offset:%2" : "=v"(dst) : "v"(addr), "i"(off))
#define FR_READ(F, ST, AA, BB)                                     \
  {                                                                \
    DSR(F##a0, AA, (ST) * 24576);                                  \
    DSR(F##a1, AA, (ST) * 24576 + 2048);                           \
    DSR(F##b0, BB, (ST) * 24576 + 8192);                           \
    DSR(F##b1, BB, (ST) * 24576 + 8192 + 2048);                    \
    DSR(F##b2, BB, (ST) * 24576 + 8192 + 4096);                    \
    DSR(F##b3, BB, (ST) * 24576 + 8192 + 6144);                    \
  }
#define FR_WAIT(F, N) asm volatile("s_waitcnt lgkmcnt(" #N ")" : "+v"(F##a0), "+v"(F##a1), "+v"(F##b0), "+v"(F##b1), "+v"(F##b2), "+v"(F##b3)::"memory")
#define FR_MFMA(F)                                                 \
  {                                                                \
    acc[0][0] = MFMA32(F##a0, F##b0, acc[0][0]);                   \
    acc[1][0] = MFMA32(F##a1, F##b0, acc[1][0]);                   \
    acc[0][1] = MFMA32(F##a0, F##b1, acc[0][1]);                   \
    acc[1][1] = MFMA32(F##a1, F##b1, acc[1][1]);                   \
    acc[0][2] = MFMA32(F##a0, F##b2, acc[0][2]);                   \
    acc[1][2] = MFMA32(F##a1, F##b2, acc[1][2]);                   \
    acc[0][3] = MFMA32(F##a0, F##b3, acc[0][3]);                   \
    acc[1][3] = MFMA32(F##a1, F##b3, acc[1][3]);                   \
    if (PROBE_DBL) {                                               \
      dum0 = MFMA32(F##a1, F##b0, dum0); dum1 = MFMA32(F##a0, F##b1, dum1);  \
      dum0 = MFMA32(F##a1, F##b2, dum0); dum1 = MFMA32(F##a0, F##b3, dum1);  \
      dum0 = MFMA32(F##a0, F##b0, dum0); dum1 = MFMA32(F##a1, F##b1, dum1);  \
      dum0 = MFMA32(F##a0, F##b2, dum0); dum1 = MFMA32(F##a1, F##b3, dum1);  \
    }                                                              \
  }
DI void gemm_kloop_wide(f32x16 (&acc)[2][4], const bf16_t* __restrict__ A, int lda, const bf16_t* __restrict__ Bt, int ldb, int K, int m0, int n0,
                        unsigned char* smem) {
  const int tid = TIDX, lane = tid & 63, wave = tid >> 6, r = lane & 31, h = lane >> 5, wm = wave >> 1, wn = wave & 1;
  const int drow = wave * 16 + (lane >> 2);
  const int csw = (lane & 3) ^ ((lane >> 4) & 3);
  const bf16_t* gA = A + (size_t)(m0 + drow) * lda + csw * 8;
  const bf16_t* gB = Bt + (size_t)(n0 + drow) * ldb + csw * 8;
  const int ldst = wave * 1024 + lane * 16;
  const int rsw = (r >> 2) & 3;
  const unsigned lbase = (unsigned)(size_t)smem;
  const unsigned aA0 = lbase + (wm * 64 + r) * 64 + ((0 + h) ^ rsw) * 16, aA1 = lbase + (wm * 64 + r) * 64 + ((2 + h) ^ rsw) * 16;
  const unsigned bB0 = lbase + (wn * 128 + r) * 64 + ((0 + h) ^ rsw) * 16, bB1 = lbase + (wn * 128 + r) * 64 + ((2 + h) ^ rsw) * 16;
#define GW_ISSUE(ST, KO)                                                                                                        \
  {                                                                                                                             \
    _Pragma("unroll") for (int i = 0; i < 2; ++i)                                                                               \
        __builtin_amdgcn_global_load_lds((const unsigned*)(gA + (size_t)(64 * i) * lda + (KO)),                                 \
                                         (unsigned*)(smem + (ST) * 24576 + i * 4096 + ldst), 16, 0, 0);                         \
    _Pragma("unroll") for (int i = 0; i < 4; ++i)                                                                               \
        __builtin_amdgcn_global_load_lds((const unsigned*)(gB + (size_t)(64 * i) * ldb + (KO)),                                 \
                                         (unsigned*)(smem + (ST) * 24576 + 8192 + i * 4096 + ldst), 16, 0, 0);                  \
  }
  bf16x8 Pa0, Pa1, Pb0, Pb1, Pb2, Pb3, Qa0, Qa1, Qb0, Qb1, Qb2, Qb3;
  f32x16 dum0, dum1;
  _Pragma("unroll") for (int i = 0; i < 16; ++i) { dum0[i] = 0.f; dum1[i] = 0.f; }
#define GW_STEP(KIDX, S, S1, S2)                                                                                                \
  {                                                                                                                             \
    asm volatile("s_waitcnt vmcnt(0)" ::: "memory");                                 \
    __builtin_amdgcn_s_barrier();                               \
    if ((KIDX) + 2 < nk) GW_ISSUE(S2, ((KIDX) + 2) * 32)                                                                        \
    FR_READ(Q, S, aA1, bB1)                                                                           \
    FR_WAIT(P, 6);                                               \
    FR_MFMA(P)                                                                                                                  \
    FR_WAIT(Q, 0);                                                                                                              \
    if ((KIDX) + 1 < nk) FR_READ(P, S1, aA0, bB0)                                                    \
    FR_MFMA(Q)                                                                                                                  \
  }
  const int nk = K >> 5;
  asm volatile("s_waitcnt vmcnt(0) lgkmcnt(0)" ::: "memory");
  __builtin_amdgcn_s_barrier();
  GW_ISSUE(0, 0)
  GW_ISSUE(1, 32)
  asm volatile("s_waitcnt vmcnt(6)" ::: "memory");
  __builtin_amdgcn_s_barrier();
  FR_READ(P, 0, aA0, bB0)
  for (int k = 0; k < nk; k += 3) {
    GW_STEP(k, 0, 1, 2)
    if (k + 1 < nk) GW_STEP(k + 1, 1, 2, 0)
    if (k + 2 < nk) GW_STEP(k + 2, 2, 0, 1)
  }
#undef GW_ISSUE
#undef GW_STEP
  if (PROBE_DBL) { _Pragma("unroll") for (int i = 0; i < 16; ++i) acc[0][0][i] += 0.f * (dum0[i] + dum1[i]); }
}
template <int BN = 128, class F>
DI void for_tiles(int ntm, int ntn, F f, int m_base = 0) {
  constexpr int GM = 8, GN = 8;
  const int xcd = blockIdx.x & 7, slot = blockIdx.x >> 3, nslot = gridDim.x >> 3;
  const int nmx = ntm >> 3;
  const int per = nmx * ntn;
  const int fullN = ntn / GN, fullM = nmx / GM;
  for (int L = slot; L < per; L += nslot) {
    int ng = L / (nmx * GN), gn = GN;
    if (ng >= fullN) { ng = fullN; gn = ntn - fullN * GN; }
    const int rem = L - ng * (nmx * GN);
    int mg = rem / (GM * gn), gm = GM;
    if (mg >= fullM) { mg = fullM; gm = nmx - fullM * GM; }
    const int rem2 = rem - mg * (GM * gn);
    const int mi = rem2 % gm, ni = rem2 / gm;
    const int tn = ng * GN + ni, tm = xcd + 8 * (mg * GM + mi);
    f(m_base + tm * 128, tn * BN, tn);
  }
}
struct RowInfo { int b, pos, kpos, L; bool lat; };
DI RowInfo row_info(int row) {
  RowInfo ri;
  if (row < M_LAT) { ri.b = row >> 12; ri.pos = row & 4095; ri.kpos = ri.pos; ri.lat = true; ri.L = 4096; }
  else { int q = row - M_LAT; ri.b = q >> 8; ri.pos = q & 255; ri.kpos = 4096 + ri.pos; ri.lat = false; ri.L = 256; }
  return ri;
}

DI int map_col(int mode, int n) {
  if (mode == 0) return n;
  if (mode == 1) { const int isb = n >= DFF; const int j = isb ? n - DFF : n; return (j >> 5) * 64 + (isb ? 32 : 0) + (j & 31); }
  if (n >= 1120) return n - 1120;
  if (n >= 864) return n - 864 + 1024;
  if (n >= 672) return n - 672 + 1664;
  if (n >= 416) return n - 416 + 768;
  if (n >= 288) return n - 288 + 1408;
  if (n >= 160) return n - 160 + 1280;
  if (n >= 128) return n - 128 + 1856;
  return n + 1536;
}
DI void conv_tile(const float* __restrict__ src, bf16_t* __restrict__ dst, const float* __restrict__ kscale, int K, int N, int mode, int t, float* tile  ) {
  const int ntn = (N + 63) >> 6;
  const int kt = t / ntn, nt = t % ntn, k0 = kt * 64, n0 = nt * 64, tid = TIDX;
  float vv[16];
#pragma unroll
  for (int i = 0; i < 16; ++i) {
    const int idx = tid + 256 * i, kk = idx >> 6, nn = idx & 63;
    vv[i] = (n0 + nn < N) ? __builtin_nontemporal_load(src + (size_t)(k0 + kk) * N + n0 + nn) : 0.f;
  }
#pragma unroll
  for (int i = 0; i < 16; ++i) {
    const int idx = tid + 256 * i, kk = idx >> 6, nn = idx & 63;
    float v = vv[i];
    if (kscale) v *= kscale[k0 + kk];
    tile[kk * 65 + nn] = v;
  }
  __syncthreads();
#pragma unroll 4
  for (int i = 0; i < 8; ++i) {
    const int idx = tid + 256 * i, nn = idx >> 5, kp = idx & 31;
    if (n0 + nn < N) {
      const int dr = map_col(mode, n0 + nn);
      *(unsigned*)(dst + (size_t)dr * K + k0 + 2 * kp) = pk2(tile[(2 * kp) * 65 + nn], tile[(2 * kp + 1) * 65 + nn]);
    }
  }
  __syncthreads();
}
DI void phase_convert(const P& p, int layer, unsigned char* smem) {
  unsigned char* ws = p.ws;
  const size_t l = (size_t)layer;
  const int tid = TIDX;
#define CONV_JOB(SRC, OFF, KS, KK, NN, MODE)                                                              \
  {                                                                                                       \
    const int ntiles_ = ((KK) >> 6) * (((NN) + 63) >> 6);                                                 \
    for (int t = blockIdx.x; t < ntiles_; t += gridDim.x) conv_tile((SRC), (bf16_t*)(ws + (OFF)), (KS), (KK), (NN), (MODE), t, (float*)smem); \
  }
  CONV_JOB(p.in[I_UP1] + l * 1024 * 5632, O_WUP1, nullptr, 1024, 5632, 1)
  CONV_JOB(p.in[I_DN1] + l * 2816 * 1024, O_WDN1, nullptr, 2816, 1024, 0)
  CONV_JOB(p.in[I_UP2] + l * 1024 * 5632, O_WUP2, nullptr, 1024, 5632, 1)
  CONV_JOB(p.in[I_DN2] + l * 2816 * 1024, O_WDN2, nullptr, 2816, 1024, 0)
  CONV_JOB(p.in[I_WIN] + l * 1024 * 1888, O_WIN, nullptr, 1024, 1888, 2)
#pragma unroll 1
  for (int i = 0; i < 4; ++i) CONV_JOB(p.in[I_WGATE] + (l * 4 + i) * 1024 * 1024, O_WGATE + (size_t)i * 1024 * 1024 * 2, nullptr, 1024, 1024, 0)
  CONV_JOB(p.in[I_BRMLA] + l * 256 * 1024, O_WBR + (size_t)0 * 1024 * 256 * 2, nullptr, 256, 1024, 0)
  CONV_JOB(p.in[I_BRHY] + l * 256 * 1024, O_WBR + (size_t)1 * 1024 * 256 * 2, nullptr, 256, 1024, 0)
  CONV_JOB(p.in[I_BRSWA] + l * 256 * 1024, O_WBR + (size_t)2 * 1024 * 256 * 2, nullptr, 256, 1024, 0)
  CONV_JOB(p.in[I_BRS5] + l * 256 * 1024, O_WBR + (size_t)3 * 1024 * 256 * 2, nullptr, 256, 1024, 0)
  CONV_JOB(p.in[I_WOUT] + l * 1024 * 1024, O_WOUT, nullptr, 1024, 1024, 0)
  CONV_JOB(p.in[I_WUKV] + l * 128 * 512, O_WUKV, p.in[I_KVNORM] + l * 128, 128, 512, 0)
  CONV_JOB(p.in[I_WUQ] + l * 192 * 384, O_WUQ, p.in[I_QNORM] + l * 192, 192, 384, 0)
  CONV_JOB(p.in[I_GLUW] + l * 256 * 256, O_WGLU, nullptr, 256, 256, 0)
#undef CONV_JOB
  {
    unsigned* z = (unsigned*)(ws + O_WIN + (size_t)1888 * 1024 * 2);
    for (int i = blockIdx.x * NT + tid; i < 32 * 1024 / 2; i += gridDim.x * NT) z[i] = 0u;
  }
}

DI void phase_modulation(const P& p, unsigned char* smem) {
  float* sS = (float*)smem;
  float* sR = sS + 9 * 1024;
  const int tid = TIDX, lane = tid & 63, wave = tid >> 6;
  float* MOD = (float*)(p.ws + O_MOD);
  bool filled = false;
  for (int it = blockIdx.x; it < 2 * 144; it += gridDim.x) {
    if (!filled) {
      for (int i = tid; i < 9 * 1024; i += NT) {
        const int v = i >> 10, k = i & 1023;
        const float x = v < 8 ? p.in[I_C][v * 1024 + k] : p.in[I_CCTX][k];
        sS[i] = siluf_(x);
      }
      filled = true;
      __syncthreads();
    }
    const int layer = it / 144, col = (it % 144) * 64 + lane;
    const float* w = p.in[I_WADA] + (size_t)layer * 1024 * 9216 + col;
    float acc[9];
#pragma unroll
    for (int v = 0; v < 9; ++v) acc[v] = 0.f;
#pragma unroll 8
    for (int k = wave * 256; k < wave * 256 + 256; ++k) {
      const float wv = __builtin_nontemporal_load(w + (size_t)k * 9216);
#pragma unroll
      for (int v = 0; v < 9; ++v) acc[v] += sS[v * 1024 + k] * wv;
    }
#pragma unroll
    for (int v = 0; v < 9; ++v) sR[(wave * 9 + v) * 64 + lane] = acc[v];
    __syncthreads();
    for (int i = tid; i < 9 * 64; i += NT) {
      const int v = i >> 6, c = i & 63;
      const float s = sR[(0 * 9 + v) * 64 + c] + sR[(1 * 9 + v) * 64 + c] + sR[(2 * 9 + v) * 64 + c] + sR[(3 * 9 + v) * 64 + c];
      const int cc = (it % 144) * 64 + c;
      MOD[((size_t)layer * 9 + v) * 9216 + cc] = s + p.in[I_BADA][(size_t)layer * 9216 + cc];
    }
    __syncthreads();
  }
  __syncthreads();
}

DI size_t h2_off(int layer, int kind) { return ((size_t)layer * (4096 + 256) + (kind ? 4096 : 0)) * 64; }
DI void phase_h2(const P& p) {
  const int tid = TIDX, lane = tid & 63, wave = tid >> 6;
  float* H2 = (float*)(p.ws + O_H2);
  const int rows_per_layer = 4096 + 256;
  for (int rr = blockIdx.x * 4 + wave; rr < 2 * rows_per_layer; rr += gridDim.x * 4) {
    const int layer = rr / rows_per_layer, q = rr % rows_per_layer;
    const int kind = q >= 4096, t = kind ? q - 4096 : q, L = kind ? 256 : 4096;
    float z = 0.f;
    if (lane == 0) z = (float)t / (float)(L - 1);
    else if (lane < 33) {
      const int j = (lane - 1) & 15;
      const float w = (6.2831855f * (float)t) / (float)L;
      const float fr = 1e-4f + (float)j * ((15.0f - 1e-4f) / 15.0f);
      const float ang = w * fr;
      float s, c; sincos_d((double)ang, s, c);
      z = lane <= 16 ? c : -s;
    }
    const float* w1 = p.in[I_HW1] + (size_t)layer * 33 * 64;
    const float* w2 = p.in[I_HW2] + (size_t)layer * 64 * 64;
    float a = p.in[I_HB1][layer * 64 + lane];
    for (int i = 0; i < 33; ++i) a += __shfl(z, i) * w1[i * 64 + lane];
    const float h1 = sin_acc(p.in[I_HFREQ][(layer * 2 + 0) * 64 + lane] * a);
    float a2 = p.in[I_HB2][layer * 64 + lane];
    for (int i = 0; i < 64; ++i) a2 += __shfl(h1, i) * w2[i * 64 + lane];
    const float h2 = sin_acc(p.in[I_HFREQ][(layer * 2 + 1) * 64 + lane] * a2);
    H2[h2_off(layer, kind) + (size_t)t * 64 + lane] = h2;
  }
}

DI void phase_rope(const P& p) {
  f32x2* RM = (f32x2*)(p.ws + O_ROPEM);
  f32x2* RW = (f32x2*)(p.ws + O_ROPEW);
  const int g0 = blockIdx.x * NT + TIDX, gs = gridDim.x * NT;
  for (int i = g0; i < 4096 * 48; i += gs) {
    const int pos = i / 48, e = i % 48;
    const float rowf = (float)(pos >> 6), colf = (float)(pos & 63);
    float ang;
    if (e < 16) { const int f = e & 7; const float fr = fast_exp(-(float)f / 8.0f * 9.210340371976184f); ang = (e < 8 ? rowf : colf) * fr; }
    else { const int e2 = e - 16, f = e2 & 15; const float fr = fast_exp(-(float)f / 16.0f * 9.210340371976184f); ang = (e2 < 16 ? rowf : colf) * fr; }
    float s, c; sincos_d((double)ang, s, c);
    f32x2 v = {c, s};
    if (e < 16) RM[pos * 16 + e] = v; else RW[pos * 32 + (e - 16)] = v;
  }
}

DI f32x2 cmul(f32x2 a, f32x2 b) { f32x2 r = {a.x * b.x - a.y * b.y, a.x * b.y + a.y * b.x}; return r; }
DI f32x2 cmulc(f32x2 a, f32x2 b) { f32x2 r = {a.x * b.x + a.y * b.y, a.y * b.x - a.x * b.y}; return r; }
DI f32x2 mul_mi(f32x2 a) { f32x2 r = {a.y, -a.x}; return r; }
DI f32x2 mul_pi(f32x2 a) { f32x2 r = {-a.y, a.x}; return r; }
#define PH(i) ((i) + ((i) >> 4))
DI void fft16_dif_tail(f32x2 (&x)[16]) {
  const float C1 = 0.92387953251f, S1 = 0.38268343236f, R2 = 0.70710678118f;
  const f32x2 T[4] = {{1.f, 0.f}, {C1, -S1}, {R2, -R2}, {S1, -C1}};
  const f32x2 T2[4] = {{1.f, 0.f}, {R2, -R2}, {0.f, -1.f}, {-R2, -R2}};
#pragma unroll
  for (int j = 0; j < 4; ++j) {
    const f32x2 a0 = x[j], a1 = x[j + 4], a2 = x[j + 8], a3 = x[j + 12];
    const f32x2 b0 = a0 + a2, b2 = cmul(a0 - a2, T[j]), b1 = a1 + a3, b3 = mul_mi(cmul(a1 - a3, T[j]));
    x[j] = b0 + b1; x[j + 4] = cmul(b0 - b1, T2[j]); x[j + 8] = b2 + b3; x[j + 12] = cmul(b2 - b3, T2[j]);
  }
#pragma unroll
  for (int k = 0; k < 4; ++k) {
    const f32x2 a0 = x[4 * k], a1 = x[4 * k + 1], a2 = x[4 * k + 2], a3 = x[4 * k + 3];
    const f32x2 b0 = a0 + a2, b2 = a0 - a2, b1 = a1 + a3, b3 = mul_mi(a1 - a3);
    x[4 * k] = b0 + b1; x[4 * k + 1] = b0 - b1; x[4 * k + 2] = b2 + b3; x[4 * k + 3] = b2 - b3;
  }
}
DI void fft16_dit_head(f32x2 (&x)[16]) {
  const float C1 = 0.92387953251f, S1 = 0.38268343236f, R2 = 0.70710678118f;
  const f32x2 T[4] = {{1.f, 0.f}, {C1, -S1}, {R2, -R2}, {S1, -C1}};
  const f32x2 T2[4] = {{1.f, 0.f}, {R2, -R2}, {0.f, -1.f}, {-R2, -R2}};
#pragma unroll
  for (int k = 0; k < 4; ++k) {
    const f32x2 c0 = x[4 * k], c1 = x[4 * k + 1], c2 = x[4 * k + 2], c3 = x[4 * k + 3];
    const f32x2 b0 = c0 + c1, b1 = c0 - c1, b2 = c2 + c3, b3 = c2 - c3;
    const f32x2 up = mul_pi(b3);
    x[4 * k] = b0 + b2; x[4 * k + 2] = b0 - b2; x[4 * k + 1] = b1 + up; x[4 * k + 3] = b1 - up;
  }
#pragma unroll
  for (int j = 0; j < 4; ++j) {
    const f32x2 c0 = x[j], c1 = x[j + 4], c2 = x[j + 8], c3 = x[j + 12];
    const f32x2 t = cmulc(c1, T2[j]), tp = cmulc(c3, T2[j]);
    const f32x2 b0 = c0 + t, b1 = c0 - t, b2 = c2 + tp, b3 = c2 - tp;
    const f32x2 u = cmulc(b2, T[j]), up = mul_pi(cmulc(b3, T[j]));
    x[j] = b0 + u; x[j + 8] = b0 - u; x[j + 4] = b1 + up; x[j + 12] = b1 - up;
  }
}
DI void fft_dif(f32x2* W, int N, int logN) {
  const int tid = TIDX;
  int s = logN - 1;
  {
    const int half = 1 << s, hp = half + (half >> 4);
    const float inv = 1.0f / (float)(2 * half);
    for (int i = tid; i < (N >> 1); i += NT) {
      const int j = i & (half - 1), base = PH(((i >> s) << (s + 1)) + j);
      const f32x2 a = W[base], b = W[base + hp];
      const float rev = (float)j * inv;
      const f32x2 w = {__builtin_amdgcn_cosf(rev), -__builtin_amdgcn_sinf(rev)};
      W[base] = a + b;
      W[base + hp] = cmul(a - b, w);
    }
    __syncthreads();
    --s;
  }
  for (; s >= 5; s -= 2) {
    const int half = 1 << s, quarter = half >> 1, hp = half + (half >> 4), qp = quarter + (quarter >> 4);
    const float inv = 1.0f / (float)(2 * half);
    for (int i = tid; i < (N >> 2); i += NT) {
      const int j = i & (quarter - 1), i0 = PH(((i >> (s - 1)) << (s + 1)) + j);
      const f32x2 a0 = W[i0], a1 = W[i0 + qp], a2 = W[i0 + hp], a3 = W[i0 + hp + qp];
      const float rev = (float)j * inv;
      const f32x2 w1 = {__builtin_amdgcn_cosf(rev), -__builtin_amdgcn_sinf(rev)};
      const f32x2 w2 = cmul(w1, w1);
      const f32x2 b0 = a0 + a2, b2 = cmul(a0 - a2, w1), b1 = a1 + a3, b3 = mul_mi(cmul(a1 - a3, w1));
      W[i0] = b0 + b1;
      W[i0 + qp] = cmul(b0 - b1, w2);
      W[i0 + hp] = b2 + b3;
      W[i0 + hp + qp] = cmul(b2 - b3, w2);
    }
    __syncthreads();
  }
  for (int gq = tid; gq < (N >> 4); gq += NT) {
    f32x2 x[16];
#pragma unroll
    for (int e = 0; e < 16; ++e) x[e] = W[17 * gq + e];
    fft16_dif_tail(x);
#pragma unroll
    for (int e = 0; e < 16; ++e) W[17 * gq + e] = x[e];
  }
  __syncthreads();
}
DI void fft_dit_inv(f32x2* W, int N, int logN) {
  const int tid = TIDX;
  for (int gq = tid; gq < (N >> 4); gq += NT) {
    f32x2 x[16];
#pragma unroll
    for (int e = 0; e < 16; ++e) x[e] = W[17 * gq + e];
    fft16_dit_head(x);
#pragma unroll
    for (int e = 0; e < 16; ++e) W[17 * gq + e] = x[e];
  }
  __syncthreads();
  int s = 5;
  for (; s < logN - 1; s += 2) {
    const int half = 1 << s, quarter = half >> 1, hp = half + (half >> 4), qp = quarter + (quarter >> 4);
    const float inv = 1.0f / (float)(2 * half);
    for (int i = tid; i < (N >> 2); i += NT) {
      const int j = i & (quarter - 1), i0 = PH(((i >> (s - 1)) << (s + 1)) + j);
      const f32x2 c0 = W[i0], c1 = W[i0 + qp], c2 = W[i0 + hp], c3 = W[i0 + hp + qp];
      const float rev = (float)j * inv;
      const f32x2 w1 = {__builtin_amdgcn_cosf(rev), -__builtin_amdgcn_sinf(rev)};
      const f32x2 w2 = cmul(w1, w1);
      const f32x2 t = cmulc(c1, w2), tp = cmulc(c3, w2);
      const f32x2 b0 = c0 + t, b1 = c0 - t, b2 = c2 + tp, b3 = c2 - tp;
      const f32x2 u = cmulc(b2, w1), up = mul_pi(cmulc(b3, w1));
      W[i0] = b0 + u;
      W[i0 + hp] = b0 - u;
      W[i0 + qp] = b1 + up;
      W[i0 + hp + qp] = b1 - up;
    }
    __syncthreads();
  }
  {
    const int sl = logN - 1, half = 1 << sl, hp = half + (half >> 4);
    const float inv = 1.0f / (float)(2 * half);
    for (int i = tid; i < (N >> 1); i += NT) {
      const int j = i & (half - 1), base = PH(((i >> sl) << (sl + 1)) + j);
      const f32x2 a = W[base], b = W[base + hp];
      const float rev = (float)j * inv;
      const f32x2 w = {__builtin_amdgcn_cosf(rev), __builtin_amdgcn_sinf(rev)};
      const f32x2 t = cmul(b, w);
      W[base] = a + t;
      W[base + hp] = a - t;
    }
    __syncthreads();
  }
}

DI void kf_item(const P& p, int layer, int kind, int c, int o, unsigned char* smem) {
  const int tid = TIDX;
  const int L = kind ? 256 : 4096, N = 2 * L, logN = kind ? 9 : 13;
  f32x2* W = (f32x2*)smem;
  float* sW3 = (float*)(smem + 69632);
  const float* w3 = p.in[I_HW3] + (size_t)layer * 64 * 1024;
  if (tid < 128) { const int dir = tid >> 6, j = tid & 63; sW3[tid] = w3[(size_t)j * 1024 + o * 512 + dir * 256 + c]; }
  __syncthreads();
  const float* H2 = (const float*)(p.ws + O_H2) + h2_off(layer, kind);
  const float lo = -3.0701134573253942f, hi = -15.350567286626971f;
  const float delta = fabsf(lo + (float)c * ((hi - lo) / 255.0f));
  const float invN = 1.0f / (float)N;
  for (int n = tid; n < N; n += NT) {
    float val = 0.f;
    if (n != L) {
      const int dir = n > L, t = dir ? N - n : n;
      const float4* hr = (const float4*)(H2 + (size_t)t * 64);
      const float* wv = sW3 + dir * 64;
      float acc = 0.f;
#pragma unroll
      for (int q = 0; q < 16; ++q) { const float4 hv = hr[q]; acc += hv.x * wv[4 * q] + hv.y * wv[4 * q + 1] + hv.z * wv[4 * q + 2] + hv.w * wv[4 * q + 3]; }
      const float tl = (float)t / (float)(L - 1);
      val = acc * fast_exp(-tl * delta) * invN;
    }
    f32x2 v = {val, 0.f};
    W[PH(n)] = v;
  }
  __syncthreads();
  fft_dif(W, N, logN);
  f32x2* KF = kind ? (f32x2*)(p.ws + O_KF1) + (size_t)(c * 2 + o) * 512 : (f32x2*)(p.ws + O_KF0) + (size_t)(c * 2 + o) * 8192;
  for (int n = tid; n < N; n += NT) KF[n] = W[PH(n)];
  __syncthreads();
}
DI void phase_kf(const P& p, int layer, bool with_ctx, unsigned char* smem) {
  const int total = 512 + (with_ctx ? 512 : 0);
  for (int it = blockIdx.x; it < total; it += gridDim.x) {
    const int kind = it >= 512, q = it & 511;
    kf_item(p, layer, kind, q >> 1, q & 1, smem);
  }
}

DI void phase_rows(const P& p, int Mrows, int mode, int layer, int sub, float resw, bool from_input, bool has_next, int nl, int nj, bool zero_rowss) {
  const int tid = TIDX, lane = tid & 63, wave = tid >> 6;
  const float* MOD = (const float*)(p.ws + O_MOD);
  const bf16_t* F = (const bf16_t*)(p.ws + O_F);
  bf16_t* U = (bf16_t*)(p.ws + O_U);
  float* XC = (float*)(p.ws + O_XC);
  float* ROWSS = (float*)(p.ws + O_ROWSS);
  for (int row0 = (blockIdx.x * 4 + wave) * 2; row0 < Mrows; row0 += gridDim.x * 8) {
    if (mode == 2) { if (lane < 2) { ROWSS[row0 + lane] = 0.f; ROWSS[M_ALL + row0 + lane] = 0.f; } continue; }
    const float* xin[2]; float* X[2]; int midx[2];
#pragma unroll
    for (int rr = 0; rr < 2; ++rr) {
      const int row = row0 + rr;
      const bool lat = row < M_LAT;
      midx[rr] = lat ? (row >> 12) : 8;
      xin[rr] = lat ? p.in[I_X] + (size_t)row * 1024 : p.in[I_CTX] + (size_t)(row - M_LAT) * 1024;
      X[rr] = lat ? p.out + (size_t)row * 1024 : XC + (size_t)(row - M_LAT) * 1024;
    }
    float4 xv[2][4];
    if (mode == 0) {
#pragma unroll
      for (int rr = 0; rr < 2; ++rr)
#pragma unroll
        for (int c4 = 0; c4 < 4; ++c4) xv[rr][c4] = *(const float4*)(xin[rr] + c4 * 256 + lane * 4);
    } else {
      uint2 raw[2][4];
      float4 xold[2][4];
#pragma unroll
      for (int rr = 0; rr < 2; ++rr)
#pragma unroll
        for (int c4 = 0; c4 < 4; ++c4) {
          { typedef unsigned u32x2v __attribute__((ext_vector_type(2)));
            const u32x2v rw = __builtin_nontemporal_load((const u32x2v*)(F + (size_t)(row0 + rr) * 1024 + c4 * 256 + lane * 4));
            raw[rr][c4].x = rw.x; raw[rr][c4].y = rw.y;
            const f32x4 xo4 = __builtin_nontemporal_load((const f32x4*)((from_input ? xin[rr] : X[rr]) + c4 * 256 + lane * 4));
            xold[rr][c4].x = xo4.x; xold[rr][c4].y = xo4.y; xold[rr][c4].z = xo4.z; xold[rr][c4].w = xo4.w; }
        }
      const float* gp = p.in[I_NPOST] + ((size_t)layer * 3 + sub) * 1024;
#pragma unroll
      for (int rr = 0; rr < 2; ++rr) {
        const float* mod = MOD + ((size_t)layer * 9 + midx[rr]) * 9216 + (3 * sub + 2) * 1024;
        float4 fv[4];
        float ss = 0.f;
#pragma unroll
        for (int c4 = 0; c4 < 4; ++c4) {
          fv[c4].x = __uint_as_float(raw[rr][c4].x << 16); fv[c4].y = __uint_as_float(raw[rr][c4].x & 0xffff0000u);
          fv[c4].z = __uint_as_float(raw[rr][c4].y << 16); fv[c4].w = __uint_as_float(raw[rr][c4].y & 0xffff0000u);
          ss += fv[c4].x * fv[c4].x + fv[c4].y * fv[c4].y + fv[c4].z * fv[c4].z + fv[c4].w * fv[c4].w;
        }
        ss = wave_sum(ss);
        const float rstd = rsqrtf(ss * (1.0f / 1024.0f) + EPS);
#pragma unroll
        for (int c4 = 0; c4 < 4; ++c4) {
          const int col = c4 * 256 + lane * 4;
          const float4 g = *(const float4*)(gp + col);
          const float4 mg = *(const float4*)(mod + col);
          xv[rr][c4].x = xold[rr][c4].x + resw * mg.x * (fv[c4].x * rstd * g.x);
          xv[rr][c4].y = xold[rr][c4].y + resw * mg.y * (fv[c4].y * rstd * g.y);
          xv[rr][c4].z = xold[rr][c4].z + resw * mg.z * (fv[c4].z * rstd * g.z);
          xv[rr][c4].w = xold[rr][c4].w + resw * mg.w * (fv[c4].w * rstd * g.w);
          { f32x4 st4 = {xv[rr][c4].x, xv[rr][c4].y, xv[rr][c4].z, xv[rr][c4].w}; __builtin_nontemporal_store(st4, (f32x4*)(X[rr] + col)); }
        }
      }
    }
    if (has_next) {
      const float* gpre = p.in[I_NPRE] + ((size_t)nl * 3 + nj) * 1024;
#pragma unroll
      for (int rr = 0; rr < 2; ++rr) {
        float ss = 0.f;
#pragma unroll
        for (int c4 = 0; c4 < 4; ++c4) ss += xv[rr][c4].x * xv[rr][c4].x + xv[rr][c4].y * xv[rr][c4].y + xv[rr][c4].z * xv[rr][c4].z + xv[rr][c4].w * xv[rr][c4].w;
        ss = wave_sum(ss);
        const float rstd = rsqrtf(ss * (1.0f / 1024.0f) + EPS);
        const float* modn = MOD + ((size_t)nl * 9 + midx[rr]) * 9216;
#pragma unroll
        for (int c4 = 0; c4 < 4; ++c4) {
          const int col = c4 * 256 + lane * 4;
          const float4 g = *(const float4*)(gpre + col);
          const float4 sc = *(const float4*)(modn + (3 * nj + 1) * 1024 + col);
          const float4 sh = *(const float4*)(modn + (3 * nj) * 1024 + col);
          const float u0 = xv[rr][c4].x * rstd * g.x * (1.f + sc.x) + sh.x;
          const float u1 = xv[rr][c4].y * rstd * g.y * (1.f + sc.y) + sh.y;
          const float u2 = xv[rr][c4].z * rstd * g.z * (1.f + sc.z) + sh.z;
          const float u3 = xv[rr][c4].w * rstd * g.w * (1.f + sc.w) + sh.w;
          uint2 o; o.x = pk2(u0, u1); o.y = pk2(u2, u3);
          *(uint2*)(U + (size_t)(row0 + rr) * 1024 + col) = o;
        }
      }
    }
    if (zero_rowss && lane < 2) { ROWSS[row0 + lane] = 0.f; ROWSS[M_ALL + row0 + lane] = 0.f; }
  }
}

#define EPI_COORDS                                                                                      \
  const int tid = TIDX, lane = tid & 63, wave = tid >> 6, r = lane & 31, h = lane >> 5, wm = wave >> 1, wn = wave & 1; \
  (void)tid; (void)lane; (void)wave; (void)r; (void)h; (void)wm; (void)wn;

DI void phase_ffn_up(const P& p, int Mrows, size_t off_w, unsigned char* smem) {
  const bf16_t* U = (const bf16_t*)(p.ws + O_U);
  const bf16_t* W = (const bf16_t*)(p.ws + off_w);
  bf16_t* ACT = (bf16_t*)(p.ws + O_ACT);
  for_tiles<256>(Mrows >> 7, 22, [&](int m0, int n0, int tn) __attribute__((always_inline)) {
    f32x16 acc[2][4];
    zero_acc<4>(acc);
    gemm_kloop_wide(acc, U, 1024, W, 1024, 1024, m0, n0, smem);
    EPI_COORDS
#pragma unroll
    for (int j = 0; j < 2; ++j) {
      const int col = tn * 128 + wn * 64 + j * 32 + r;
#pragma unroll
      for (int mi = 0; mi < 2; ++mi)
#pragma unroll
        for (int i = 0; i < 16; ++i) {
          const int row = m0 + wm * 64 + mi * 32 + crow(i, h);
          const float a = acc[mi][2 * j][i], b = acc[mi][2 * j + 1][i];
          ACT[(size_t)row * DFF + col] = f2bf(siluf_(a) * b);
        }
    }
  });
}
DI void phase_gemm_plain_bf16(const P& p, int Mrows, const bf16_t* A, int K, const bf16_t* W, bf16_t* OUT, int N, unsigned char* smem) {
  (void)p;
  const int Mwide = Mrows < M_LAT ? Mrows : M_LAT;
  for_tiles<256>(Mwide >> 7, N >> 8, [&](int m0, int n0, int tn) __attribute__((always_inline)) {
    (void)tn;
    f32x16 acc[2][4];
    zero_acc<4>(acc);
    gemm_kloop_wide(acc, A, K, W, K, K, m0, n0, smem);
    EPI_COORDS
#pragma unroll
    for (int mi = 0; mi < 2; ++mi)
#pragma unroll
      for (int ni = 0; ni < 4; ++ni)
#pragma unroll
        for (int i = 0; i < 16; ++i) {
          const int row = m0 + wm * 64 + mi * 32 + crow(i, h), col = n0 + wn * 128 + ni * 32 + r;
          OUT[(size_t)row * N + col] = f2bf(acc[mi][ni][i]);
        }
  });
  if (Mrows > Mwide) {
    for_tiles<64>((Mrows - Mwide) >> 7, N >> 6, [&](int m0, int n0, int tn) __attribute__((always_inline)) {
      (void)tn;
      f32x16 acc[2][1];
      zero_acc<1>(acc);
      gemm_kloop<1>(acc, A, K, W, K, K, m0, n0, smem);
      EPI_COORDS
#pragma unroll
      for (int mi = 0; mi < 2; ++mi)
#pragma unroll
        for (int i = 0; i < 16; ++i) {
          const int row = m0 + wm * 64 + mi * 32 + crow(i, h), col = n0 + wn * 32 + r;
          OUT[(size_t)row * N + col] = f2bf(acc[mi][0][i]);
        }
    }, Mwide);
  }
}

DI void win_epilogue(const P& p, int m0, int tn, int wn, f32x16 (&acc)[2][2]) {
  unsigned char* ws = p.ws;
  bf16_t* HYT = (bf16_t*)(ws + O_HYT);
  float* S5U = (float*)(ws + O_S5U);
  bf16_t* QSWA = (bf16_t*)(ws + O_QSWA);
  bf16_t* KSWA = (bf16_t*)(ws + O_KSWA);
  bf16_t* VSWAT = (bf16_t*)(ws + O_VSWAT);
  bf16_t* CKV = (bf16_t*)(ws + O_CKV);
  bf16_t* CQ = (bf16_t*)(ws + O_CQ);
  bf16_t* KMLA = (bf16_t*)(ws + O_KMLA);
  float* ROWSS = (float*)(ws + O_ROWSS);
  const f32x2* RM = (const f32x2*)(ws + O_ROPEM);
  const f32x2* RW = (const f32x2*)(ws + O_ROPEW);
  const float qscale = 0.125f * LOG2E;
  const int tid = TIDX, lane = tid & 63, wave = tid >> 6, r = lane & 31, h = lane >> 5, wm = wave >> 1;
    const RowInfo t0 = row_info(m0);
  if (tn < 6) {
    bf16_t* base = HYT + (t0.lat ? (size_t)t0.b * 768 * 4096 : HYT_LATSZ + (size_t)t0.b * 768 * 256);
#pragma unroll
    for (int mi = 0; mi < 2; ++mi)
#pragma unroll
      for (int ni = 0; ni < 2; ++ni) {
        const int ch = tn * 128 + wn * 64 + ni * 32 + r;
#pragma unroll
        for (int g = 0; g < 4; ++g) {
          const int pos = t0.pos + wm * 64 + mi * 32 + 8 * g + 4 * h;
          uint2 o; o.x = pk2(acc[mi][ni][4 * g], acc[mi][ni][4 * g + 1]); o.y = pk2(acc[mi][ni][4 * g + 2], acc[mi][ni][4 * g + 3]);
          *(uint2*)(base + (size_t)ch * t0.L + pos) = o;
        }
      }
  } else if (tn < 8) {
#pragma unroll
    for (int mi = 0; mi < 2; ++mi)
#pragma unroll
      for (int ni = 0; ni < 2; ++ni)
#pragma unroll
        for (int i = 0; i < 16; ++i) {
          const int row = m0 + wm * 64 + mi * 32 + crow(i, h), col = (tn - 6) * 128 + wn * 64 + ni * 32 + r;
          S5U[(size_t)row * 256 + col] = acc[mi][ni][i];
        }
  } else if (tn < 11) {
#pragma unroll
    for (int mi = 0; mi < 2; ++mi)
#pragma unroll
      for (int i = 0; i < 16; ++i) {
        const int lr = wm * 64 + mi * 32 + crow(i, h);
        const int row = m0 + lr, pos = t0.pos + lr;
        float x1 = acc[mi][0][i], x2 = acc[mi][1][i];
        if (t0.lat) {
          const f32x2 cs = RW[pos * 32 + r];
          const float y1 = x1 * cs.x - x2 * cs.y, y2 = x1 * cs.y + x2 * cs.x;
          x1 = y1; x2 = y2;
        }
        if (tn < 10) {
          const int head = (tn - 8) * 2 + wn;
          bf16_t* q = QSWA + ((size_t)row * 4 + head) * 64;
          q[r] = f2bf(x1 * qscale); q[r + 32] = f2bf(x2 * qscale);
        } else {
          bf16_t* k = KSWA + (((size_t)t0.b * 2 + wn) * KEYS + (t0.kpos + lr)) * 64;
          k[r] = f2bf(x1); k[r + 32] = f2bf(x2);
        }
      }
  } else if (tn == 11) {
#pragma unroll
    for (int mi = 0; mi < 2; ++mi)
#pragma unroll
      for (int ni = 0; ni < 2; ++ni) {
        const int dv = ni * 32 + r;
#pragma unroll
        for (int g = 0; g < 4; ++g) {
          const int kp = t0.kpos + wm * 64 + mi * 32 + 8 * g + 4 * h;
          uint2 o; o.x = pk2(acc[mi][ni][4 * g], acc[mi][ni][4 * g + 1]); o.y = pk2(acc[mi][ni][4 * g + 2], acc[mi][ni][4 * g + 3]);
          *(uint2*)(VSWAT + (((size_t)t0.b * 2 + wn) * 64 + dv) * KEYS + kp) = o;
        }
      }
  } else {
    const bool is_kv = tn == 12;
    const bool rope_wave = (tn == 14) && (wn == 1);
    if (!rope_wave) {
      bf16_t* dst = is_kv ? CKV : CQ;
      const int ld = is_kv ? 128 : 192;
      const int cbase = (tn == 14 ? 128 : 0) + wn * 64;
      float* rs = ROWSS + (is_kv ? 0 : M_ALL);
#pragma unroll
      for (int mi = 0; mi < 2; ++mi)
#pragma unroll
        for (int i = 0; i < 16; ++i) {
          const int row = m0 + wm * 64 + mi * 32 + crow(i, h);
          const float v0 = acc[mi][0][i], v1 = acc[mi][1][i];
          dst[(size_t)row * ld + cbase + r] = f2bf(v0);
          dst[(size_t)row * ld + cbase + 32 + r] = f2bf(v1);
          float s = v0 * v0 + v1 * v1;
#pragma unroll
          for (int o = 16; o; o >>= 1) s += __shfl_xor(s, o);
          if (r == 0) atomicAdd(rs + row, s);
        }
    } else {
#pragma unroll
      for (int mi = 0; mi < 2; ++mi)
#pragma unroll
        for (int i = 0; i < 16; ++i) {
          const int lr = wm * 64 + mi * 32 + crow(i, h);
          const int pos = t0.pos + lr;
          const float x = acc[mi][0][i];
          const float partner = __shfl_xor(x, 16);
          float y = x;
          if (t0.lat) {
            const f32x2 cs = RM[pos * 16 + (r & 15)];
            y = (r < 16) ? (x * cs.x - partner * cs.y) : (partner * cs.y + x * cs.x);
          }
          const bf16_t yb = f2bf(y);
#pragma unroll
          for (int hd = 0; hd < 4; ++hd) KMLA[(((size_t)t0.b * 4 + hd) * KEYS + (t0.kpos + lr)) * 96 + 64 + r] = yb;
        }
    }
  }
}
DI void phase_win(const P& p, int Mrows, unsigned char* smem) {
  const bf16_t* U = (const bf16_t*)(p.ws + O_U);
  const bf16_t* W = (const bf16_t*)(p.ws + O_WIN);
  const int Mwide = Mrows < M_LAT ? Mrows : M_LAT;
  for_tiles<256>(Mwide >> 7, 8, [&](int m0, int n0, int tn) __attribute__((always_inline)) {
    (void)n0;
    f32x16 acc[2][4];
    zero_acc<4>(acc);
    gemm_kloop_wide(acc, U, 1024, W, 1024, 1024, m0, n0, smem);
    const int wn = (TIDX >> 6) & 1, go = tn * 2 + wn;
    if (go < 15) {
#pragma unroll
      for (int half = 0; half < 2; ++half) {
        f32x16 t4[2][2];
        t4[0][0] = acc[0][2 * half]; t4[0][1] = acc[0][2 * half + 1]; t4[1][0] = acc[1][2 * half]; t4[1][1] = acc[1][2 * half + 1];
        win_epilogue(p, m0, go, half, t4);
      }
    }
  });
  if (Mrows > Mwide) {
    for_tiles((Mrows - Mwide) >> 7, 15, [&](int m0, int n0, int tn) __attribute__((always_inline)) {
      f32x16 acc[2][2];
      zero_acc<2>(acc);
      gemm_kloop<2>(acc, U, 1024, W, 1024, 1024, m0, n0, smem);
      win_epilogue(p, m0, tn, (TIDX >> 6) & 1, acc);
    }, Mwide);
  }
}

DI void phase_kvq(const P& p, int Mkv, int Mq, unsigned char* smem) {
  unsigned char* ws = p.ws;
  const bf16_t* CKV = (const bf16_t*)(ws + O_CKV);
  const bf16_t* CQ = (const bf16_t*)(ws + O_CQ);
  const bf16_t* WUKV = (const bf16_t*)(ws + O_WUKV);
  const bf16_t* WUQ = (const bf16_t*)(ws + O_WUQ);
  bf16_t* KMLA = (bf16_t*)(ws + O_KMLA);
  bf16_t* VMLAT = (bf16_t*)(ws + O_VMLAT);
  bf16_t* QMLA = (bf16_t*)(ws + O_QMLA);
  const float* ROWSS = (const float*)(ws + O_ROWSS);
  const f32x2* RM = (const f32x2*)(ws + O_ROPEM);
  const float qscale = 0.10206207261596577f * LOG2E;
  for_tiles(Mkv >> 7, 4, [&](int m0, int n0, int tn) __attribute__((always_inline)) {
    f32x16 acc[2][2];
    zero_acc<2>(acc);
    gemm_kloop<2>(acc, CKV, 128, WUKV, 128, 128, m0, n0, smem);
    EPI_COORDS
    const RowInfo t0 = row_info(m0);
#pragma unroll
    for (int mi = 0; mi < 2; ++mi) {
      float rstd[16];
#pragma unroll
      for (int i = 0; i < 16; ++i) rstd[i] = rsqrtf(ROWSS[m0 + wm * 64 + mi * 32 + crow(i, h)] * (1.0f / 128.0f) + EPS);
      if (wn == 0) {
#pragma unroll
        for (int ni = 0; ni < 2; ++ni)
#pragma unroll
          for (int i = 0; i < 16; ++i) {
            const int lr = wm * 64 + mi * 32 + crow(i, h);
            KMLA[(((size_t)t0.b * 4 + tn) * KEYS + (t0.kpos + lr)) * 96 + ni * 32 + r] = f2bf(acc[mi][ni][i] * rstd[i]);
          }
      } else {
#pragma unroll
        for (int ni = 0; ni < 2; ++ni) {
          const int dv = ni * 32 + r;
#pragma unroll
          for (int g = 0; g < 4; ++g) {
            const int kp = t0.kpos + wm * 64 + mi * 32 + 8 * g + 4 * h;
            uint2 o;
            o.x = pk2(acc[mi][ni][4 * g] * rstd[4 * g], acc[mi][ni][4 * g + 1] * rstd[4 * g + 1]);
            o.y = pk2(acc[mi][ni][4 * g + 2] * rstd[4 * g + 2], acc[mi][ni][4 * g + 3] * rstd[4 * g + 3]);
            *(uint2*)(VMLAT + (((size_t)t0.b * 4 + tn) * 64 + dv) * KEYS + kp) = o;
          }
        }
      }
    }
  });
  for_tiles(Mq >> 7, 3, [&](int m0, int n0, int tn) __attribute__((always_inline)) {
    f32x16 acc[2][2];
    zero_acc<2>(acc);
    gemm_kloop<2>(acc, CQ, 192, WUQ, 192, 192, m0, n0, smem);
    EPI_COORDS
    (void)tn;
    const RowInfo t0 = row_info(m0);
#pragma unroll
    for (int mi = 0; mi < 2; ++mi)
#pragma unroll
      for (int ni = 0; ni < 2; ++ni) {
        const int cb = n0 + wn * 64 + ni * 32;
        const int head = cb / 96, d0 = cb - head * 96;
#pragma unroll
        for (int i = 0; i < 16; ++i) {
          const int lr = wm * 64 + mi * 32 + crow(i, h);
          const int row = m0 + lr;
          const float rstd = rsqrtf(ROWSS[M_ALL + row] * (1.0f / 192.0f) + EPS);
          float v = acc[mi][ni][i] * rstd;
          if (d0 == 64) {
            const float partner = __shfl_xor(v, 16);
            if (t0.lat) {
              const f32x2 cs = RM[(t0.pos + lr) * 16 + (r & 15)];
              v = (r < 16) ? (v * cs.x - partner * cs.y) : (partner * cs.y + v * cs.x);
            }
          }
          QMLA[((size_t)row * 4 + head) * 96 + d0 + r] = f2bf(v * qscale);
        }
      }
  });
}

template <int NI>
DI void merge_tile(const P& p, int layer, int m0, int n0, unsigned char* smem) {
  unsigned char* ws = p.ws;
  const bf16_t* U = (const bf16_t*)(ws + O_U);
  const bf16_t* O4 = (const bf16_t*)(ws + O_O4);
  const bf16_t* WG = (const bf16_t*)(ws + O_WGATE);
  const bf16_t* WB = (const bf16_t*)(ws + O_WBR);
  bf16_t* MB = (bf16_t*)(ws + O_MBUF);
  const float* bg = p.in[I_BGATE] + (size_t)layer * 4 * 1024;
  EPI_COORDS
  f32x16 macc[2][NI];
  zero_acc<NI>(macc);
#pragma unroll 1
  for (int br = 0; br < 4; ++br) {
    f32x16 acc[2][NI];
    zero_acc<NI>(acc);
    gemm_kloop<NI>(acc, O4 + (size_t)br * M_ALL * 256, 256, WB + (size_t)br * 1024 * 256, 256, 256, m0, n0, smem);
    unsigned po[2][NI][8];
#pragma unroll
    for (int mi = 0; mi < 2; ++mi)
#pragma unroll
      for (int ni = 0; ni < NI; ++ni)
#pragma unroll
        for (int q = 0; q < 8; ++q) po[mi][ni][q] = pk2(acc[mi][ni][2 * q], acc[mi][ni][2 * q + 1]);
    zero_acc<NI>(acc);
    gemm_kloop<NI>(acc, U, 1024, WG + (size_t)br * 1024 * 1024, 1024, 1024, m0, n0, smem);
#pragma unroll
    for (int ni = 0; ni < NI; ++ni) {
      const float bias = bg[br * 1024 + n0 + wn * 32 * NI + ni * 32 + r];
#pragma unroll
      for (int mi = 0; mi < 2; ++mi)
#pragma unroll
        for (int q = 0; q < 8; ++q) {
          const float o0 = __uint_as_float(po[mi][ni][q] << 16), o1 = __uint_as_float(po[mi][ni][q] & 0xffff0000u);
          macc[mi][ni][2 * q] += sigmoidf_(acc[mi][ni][2 * q] + bias) * o0;
          macc[mi][ni][2 * q + 1] += sigmoidf_(acc[mi][ni][2 * q + 1] + bias) * o1;
        }
    }
  }
#pragma unroll
  for (int mi = 0; mi < 2; ++mi)
#pragma unroll
    for (int ni = 0; ni < NI; ++ni)
#pragma unroll
      for (int i = 0; i < 16; ++i) {
        const int row = m0 + wm * 64 + mi * 32 + crow(i, h), col = n0 + wn * 32 * NI + ni * 32 + r;
        MB[(size_t)row * 1024 + col] = f2bf(macc[mi][ni][i]);
      }
}
DI void phase_merge(const P& p, int layer, int Mrows, unsigned char* smem) {
  for_tiles(Mrows >> 7, 8, [&](int m0, int n0, int tn) __attribute__((always_inline)) { (void)tn; merge_tile<2>(p, layer, m0, n0, smem); });
}

DI float gelu_tanh(float x) {
  const float z = 0.7978845608028654f * (x + 0.044715f * x * x * x);
  const float e = fast_exp(2.f * z);
  const float th = 1.f - 2.f * __builtin_amdgcn_rcpf(e + 1.f);
  return 0.5f * x * (1.f + th);
}
DI void phase_glu(const P& p, int layer, int Mrows, unsigned char* smem) {
  unsigned char* ws = p.ws;
  const bf16_t* Y = (const bf16_t*)(ws + O_Y);
  const float* S5U = (const float*)(ws + O_S5U);
  const bf16_t* WGLU = (const bf16_t*)(ws + O_WGLU);
  bf16_t* O3 = (bf16_t*)(ws + O_O4) + (size_t)3 * M_ALL * 256;
  const float* Dv = p.in[I_S5D] + (size_t)layer * 256;
  const float* gb = p.in[I_GLUB] + (size_t)layer * 256;
  bf16_t* sG = (bf16_t*)smem;
  const int tid = TIDX, lane = tid & 63, wave = tid >> 6, r = lane & 31, h = lane >> 5;
  for (int t = blockIdx.x; t < (Mrows >> 6); t += gridDim.x) {
    const int m0 = t * 64;
    for (int e = tid; e < 64 * 64; e += NT) {
      const int rr = e >> 6, c4 = (e & 63) * 4;
      const size_t gi = (size_t)(m0 + rr) * 256 + c4;
      typedef unsigned u32x2g __attribute__((ext_vector_type(2)));
      const u32x2g y0 = __builtin_nontemporal_load((const u32x2g*)(Y + gi)), y1 = __builtin_nontemporal_load((const u32x2g*)(Y + (size_t)M_ALL * 256 + gi));
      const f32x4 u = __builtin_nontemporal_load((const f32x4*)(S5U + gi));
      const float4 dd = *(const float4*)(Dv + c4);
      const float a0 = __uint_as_float(y0.x << 16) + __uint_as_float(y1.x << 16) + u.x * dd.x;
      const float a1 = __uint_as_float(y0.x & 0xffff0000u) + __uint_as_float(y1.x & 0xffff0000u) + u.y * dd.y;
      const float a2 = __uint_as_float(y0.y << 16) + __uint_as_float(y1.y << 16) + u.z * dd.z;
      const float a3 = __uint_as_float(y0.y & 0xffff0000u) + __uint_as_float(y1.y & 0xffff0000u) + u.w * dd.w;
      uint2 o; o.x = pk2(gelu_tanh(a0), gelu_tanh(a1)); o.y = pk2(gelu_tanh(a2), gelu_tanh(a3));
      *(uint2*)(sG + rr * 264 + c4) = o;
    }
    __syncthreads();
    f32x16 acc[2][2];
    zero_acc<2>(acc);
#pragma unroll 4
    for (int kk = 0; kk < 16; ++kk) {
      const bf16x8 a0 = *(const bf16x8*)(sG + r * 264 + kk * 16 + 8 * h), a1 = *(const bf16x8*)(sG + (32 + r) * 264 + kk * 16 + 8 * h);
      const bf16x8 b0 = *(const bf16x8*)(WGLU + (size_t)(wave * 64 + r) * 256 + kk * 16 + 8 * h);
      const bf16x8 b1 = *(const bf16x8*)(WGLU + (size_t)(wave * 64 + 32 + r) * 256 + kk * 16 + 8 * h);
      acc[0][0] = MFMA32(a0, b0, acc[0][0]);
      acc[0][1] = MFMA32(a0, b1, acc[0][1]);
      acc[1][0] = MFMA32(a1, b0, acc[1][0]);
      acc[1][1] = MFMA32(a1, b1, acc[1][1]);
    }
#pragma unroll
    for (int mi = 0; mi < 2; ++mi)
#pragma unroll
      for (int ni = 0; ni < 2; ++ni) {
        const int col = wave * 64 + ni * 32 + r;
        const float bias = gb[col];
#pragma unroll
        for (int i = 0; i < 16; ++i) {
          const int lr = mi * 32 + crow(i, h);
          const float g = bf2f(sG[lr * 264 + col]);
          O3[(size_t)(m0 + lr) * 256 + col] = f2bf(g * sigmoidf_(acc[mi][ni][i] + bias));
        }
      }
    __syncthreads();
  }
}

DI f32x2 cmulf(f32x2 a, f32x2 b) { f32x2 r = {a.x * b.x - a.y * b.y, a.x * b.y + a.y * b.x}; return r; }
DI void s5_item(const P& p, int layer, int combo, unsigned char* smem) {
  unsigned char* ws = p.ws;
  const int tid = TIDX, lane = tid & 63, wave = tid >> 6;
  const int d = combo & 1, g = (combo >> 1) & 15, b = combo >> 5;
  f32x2* sX = (f32x2*)(smem + wave * 8448);
  bf16_t* sH = (bf16_t*)(smem + 4 * 8448) + wave * (16 * 136);
  f32x2* sE = (f32x2*)(smem + 4 * 8448 + 4 * 16 * 136 * 2);
  const float* S5U = (const float*)(ws + O_S5U);
  bf16_t* Y = (bf16_t*)(ws + O_Y) + (size_t)d * M_ALL * 256;
  const int pbase = ((layer * 2 + d) * 16 + g) * 64;
  const int col = lane & 15, q = lane >> 4;
  f32x2 ab, ff;
  {
    const float a_re = p.in[I_ARE][pbase + lane], a_im = p.in[I_AIM][pbase + lane];
    const float dt = fast_exp(p.in[I_LOGDT][(layer * 2 + d) * 16 + g]);
    const float mag = fast_exp(dt * a_re);
    float sn, cs; sincos_d((double)(dt * a_im), sn, cs);
    ab.x = mag * cs; ab.y = mag * sn;
    const float den = a_re * a_re + a_im * a_im;
    ff.x = ((ab.x - 1.f) * a_re + ab.y * a_im) / den;
    ff.y = (ab.y * a_re - (ab.x - 1.f) * a_im) / den;
  }
  bf16x8 fA[8];
#pragma unroll
  for (int blk = 0; blk < 8; ++blk) {
    const int ps = 8 * blk + (col >> 1), im = col & 1;
    const float fx = __shfl(ff.x, ps), fy = __shfl(ff.y, ps);
    const float* bre = p.in[I_BRE] + (size_t)(pbase + ps) * 16 + 8 * (q & 1);
    const float* bim = p.in[I_BIM] + (size_t)(pbase + ps) * 16 + 8 * (q & 1);
#pragma unroll
    for (int j = 0; j < 8; j += 2) {
      const float br0 = bre[j], bi0 = bim[j], br1 = bre[j + 1], bi1 = bim[j + 1];
      float v0 = im ? (fx * bi0 + fy * br0) : (fx * br0 - fy * bi0);
      float v1 = im ? (fx * bi1 + fy * br1) : (fx * br1 - fy * bi1);
      if (q >= 2) { v0 = 0.f; v1 = 0.f; }
      const unsigned w = pk2(v0, v1);
      fA[blk][j] = (short)(w & 0xffffu); fA[blk][j + 1] = (short)(w >> 16);
    }
  }
  bf16x8 cB[4];
  {
    const float* cre = p.in[I_CRE] + ((size_t)((layer * 2 + d) * 16 + g) * 16 + col) * 64;
    const float* cim = p.in[I_CIM] + ((size_t)((layer * 2 + d) * 16 + g) * 16 + col) * 64;
#pragma unroll
    for (int ks = 0; ks < 4; ++ks)
#pragma unroll
      for (int j = 0; j < 8; j += 2) {
        const int pp = (32 * ks + 8 * q + j) >> 1;
        const unsigned w = pk2(cre[pp], -cim[pp]);
        cB[ks][j] = (short)(w & 0xffffu); cB[ks][j + 1] = (short)(w >> 16);
      }
  }
  f32x2 apow;
  {
    f32x2 a2 = ab;
#pragma unroll
    for (int i = 0; i < 6; ++i) a2 = cmulf(a2, a2);
    f32x2 a3 = a2;
#pragma unroll
    for (int i = 0; i < 4; ++i) a3 = cmulf(a3, a3);
    apow = cmulf(a2, a3);
  }
  f32x2 hst = {0.f, 0.f};
#pragma unroll 1
  for (int pass = 0; pass < 2; ++pass) {
    for (int gj = 0; gj < 68; ++gj) {
      const int grp = wave * 68 + gj;
      const bool isctx = grp < 16;
      const int gi = isctx ? grp : grp - 16, L = isctx ? 256 : 4096;
      const int rowbase = isctx ? M_LAT + b * 256 : b * 4096;
      bf16x8 ub;
      {
        const int n = gi * 16 + col, t = d ? L - 1 - n : n;
        const float* up = S5U + (size_t)(rowbase + t) * 256 + g * 16 + 8 * (q & 1);
        const float4 u0 = *(const float4*)up, u1 = *(const float4*)(up + 4);
        unsigned w0 = pk2(u0.x, u0.y), w1 = pk2(u0.z, u0.w), w2 = pk2(u1.x, u1.y), w3 = pk2(u1.z, u1.w);
        if (q >= 2) { w0 = 0u; w1 = 0u; w2 = 0u; w3 = 0u; }
        ub[0] = (short)(w0 & 0xffffu); ub[1] = (short)(w0 >> 16); ub[2] = (short)(w1 & 0xffffu); ub[3] = (short)(w1 >> 16);
        ub[4] = (short)(w2 & 0xffffu); ub[5] = (short)(w2 >> 16); ub[6] = (short)(w3 & 0xffffu); ub[7] = (short)(w3 >> 16);
      }
#pragma unroll
      for (int blk = 0; blk < 8; ++blk) {
        f32x4 xz = {0.f, 0.f, 0.f, 0.f};
        xz = MFMA16(fA[blk], ub, xz);
        *(f32x4*)(sX + col * 66 + 8 * blk + 2 * q) = xz;
      }
      __syncthreads();
#pragma unroll 4
      for (int tt = 0; tt < 16; ++tt) {
        const f32x2 x = sX[tt * 66 + lane];
        f32x2 hn;
        hn.x = ab.x * hst.x - ab.y * hst.y + x.x;
        hn.y = ab.x * hst.y + ab.y * hst.x + x.y;
        hst = hn;
        if (pass) *(unsigned*)(sH + tt * 136 + 2 * lane) = pk2(hst.x, hst.y);
      }
      __syncthreads();
      if (pass) {
        f32x4 acc = {0.f, 0.f, 0.f, 0.f};
#pragma unroll
        for (int ks = 0; ks < 4; ++ks) {
          const bf16x8 a = *(const bf16x8*)(sH + (lane & 15) * 136 + ks * 32 + 8 * q);
          acc = MFMA16(a, cB[ks], acc);
        }
#pragma unroll
        for (int i = 0; i < 4; ++i) {
          const int tt = q * 4 + i, n = gi * 16 + tt, t = d ? L - 1 - n : n;
          Y[(size_t)(rowbase + t) * 256 + g * 16 + col] = f2bf(acc[i]);
        }
      }
    }
    if (pass == 0) {
      sE[wave * 64 + lane] = hst;
      __syncthreads();
      f32x2 st = {0.f, 0.f};
      for (int w = 0; w < wave; ++w) st = cmulf(apow, st) + sE[w * 64 + lane];
      hst = st;
      __syncthreads();
    }
  }
  __syncthreads();
}

DI float hy_in(const bf16_t* chp, int L, int t, float w0, float w1, float w2, float cb) {
  const float x0 = t > 0 ? bf2f(chp[t - 1]) : 0.f, x1 = bf2f(chp[t]), x2 = (t + 1 < L) ? bf2f(chp[t + 1]) : 0.f;
  return cb + w0 * x0 + w1 * x1 + w2 * x2;
}
DI void hyena_item(const P& p, int layer, int kind, int c, int bp, unsigned char* smem) {
  unsigned char* ws = p.ws;
  const int tid = TIDX;
  const int L = kind ? 256 : 4096, N = 2 * L, logN = kind ? 9 : 13;
  f32x2* W = (f32x2*)smem;
  const bf16_t* HYT = (const bf16_t*)(ws + O_HYT);
  const bf16_t* s0 = HYT + (kind ? HYT_LATSZ + (size_t)(2 * bp) * 768 * 256 : (size_t)(2 * bp) * 768 * 4096);
  const bf16_t* s1 = s0 + (size_t)768 * L;
  const int row0 = kind ? M_LAT + (2 * bp) * 256 : (2 * bp) * 4096;
  const int row1 = row0 + L;
  const float* cw = p.in[I_HCW] + (size_t)layer * 3 * 768;
  const float* cbv = p.in[I_HCB] + (size_t)layer * 768;
  const float bias1 = p.in[I_HBIAS][(layer * 2 + 0) * 256 + c], bias2 = p.in[I_HBIAS][(layer * 2 + 1) * 256 + c];
  const f32x2* KFa = kind ? (const f32x2*)(ws + O_KF1) + (size_t)(c * 2) * 512 : (const f32x2*)(ws + O_KF0) + (size_t)(c * 2) * 8192;
  const f32x2* KFb = KFa + N;
  bf16_t* OUT = (bf16_t*)(ws + O_O4) + (size_t)1 * M_ALL * 256;
  f32x2 zr[16];
  {
    const int ch = c;
    const float w0 = cw[ch], w1 = cw[768 + ch], w2 = cw[1536 + ch], cb = cbv[ch];
#pragma unroll
    for (int i = 0; i < 16; ++i) {
      const int t = tid + 256 * i;
      if (t < L) {
        f32x2 v = {hy_in(s0 + (size_t)ch * L, L, t, w0, w1, w2, cb), hy_in(s1 + (size_t)ch * L, L, t, w0, w1, w2, cb)};
        zr[i] = v; W[PH(t)] = v;
        f32x2 zz = {0.f, 0.f};
        W[PH(t + L)] = zz;
      }
    }
  }
  __syncthreads();
  fft_dif(W, N, logN);
  for (int n = tid; n < N; n += NT) W[PH(n)] = cmul(W[PH(n)], KFa[n]);
  __syncthreads();
  fft_dit_inv(W, N, logN);
  {
    const int ch = 256 + c;
    const float w0 = cw[ch], w1 = cw[768 + ch], w2 = cw[1536 + ch], cb = cbv[ch];
#pragma unroll
    for (int i = 0; i < 16; ++i) {
      const int t = tid + 256 * i;
      if (t < L) {
        const f32x2 y = W[PH(t)];
        const float g0 = hy_in(s0 + (size_t)ch * L, L, t, w0, w1, w2, cb), g1 = hy_in(s1 + (size_t)ch * L, L, t, w0, w1, w2, cb);
        zr[i].x = g0 * (y.x + bias1 * zr[i].x);
        zr[i].y = g1 * (y.y + bias1 * zr[i].y);
      }
    }
  }
  __syncthreads();
#pragma unroll
  for (int i = 0; i < 16; ++i) {
    const int t = tid + 256 * i;
    if (t < L) { W[PH(t)] = zr[i]; f32x2 zz = {0.f, 0.f}; W[PH(t + L)] = zz; }
  }
  __syncthreads();
  fft_dif(W, N, logN);
  for (int n = tid; n < N; n += NT) W[PH(n)] = cmul(W[PH(n)], KFb[n]);
  __syncthreads();
  fft_dit_inv(W, N, logN);
  {
    const int ch = 512 + c;
    const float w0 = cw[ch], w1 = cw[768 + ch], w2 = cw[1536 + ch], cb = cbv[ch];
#pragma unroll
    for (int i = 0; i < 16; ++i) {
      const int t = tid + 256 * i;
      if (t < L) {
        const f32x2 y = W[PH(t)];
        const float g0 = hy_in(s0 + (size_t)ch * L, L, t, w0, w1, w2, cb), g1 = hy_in(s1 + (size_t)ch * L, L, t, w0, w1, w2, cb);
        OUT[(size_t)(row0 + t) * 256 + c] = f2bf(g0 * (y.x + bias2 * zr[i].x));
        OUT[(size_t)(row1 + t) * 256 + c] = f2bf(g1 * (y.y + bias2 * zr[i].y));
      }
    }
  }
  __syncthreads();
}

template <int DQK>
DI void attn_item(const bf16_t* __restrict__ Qh, int qstride, const bf16_t* __restrict__ Kh, const bf16_t* __restrict__ Vth, bf16_t* __restrict__ Oh,
                  int a0, int a1, int b0, int b1, bool band, int qpos0, float m_init, float l_init, unsigned char* smem) {
  constexpr int KS = DQK + 8, NQ = DQK / 16, KCH = DQK / 8, KPT = (64 * KCH) / 256;
  bf16_t* sK = (bf16_t*)smem;
  bf16_t* sV = (bf16_t*)(smem + 2 * 64 * KS * 2);
  const int tid = TIDX, lane = tid & 63, wave = tid >> 6, r = lane & 31, h = lane >> 5;
  bf16x8 qf[NQ];
  {
    const bf16_t* qp = Qh + (size_t)(wave * 32 + r) * qstride + 8 * h;
#pragma unroll
    for (int ds = 0; ds < NQ; ++ds) qf[ds] = *(const bf16x8*)(qp + ds * 16);
  }
  f32x16 o0, o1;
#pragma unroll
  for (int i = 0; i < 16; ++i) { o0[i] = 0.f; o1[i] = 0.f; }
  float m = m_init, l = (h == 0) ? l_init : 0.f;
  const int nA = (a1 - a0) >> 6, nB = (b1 - b0) >> 6, nT = nA + nB;
  uint4 rk0, rk1, rk2 = {0u, 0u, 0u, 0u}, rv0, rv1;
#define ATT_KADDR(i) (Kh + (size_t)(key0_ + (tid + 256 * (i)) / KCH) * DQK + ((tid + 256 * (i)) % KCH) * 8)
#define ATT_VADDR(i) (Vth + (size_t)((tid + 256 * (i)) >> 3) * KEYS + key0_ + ((tid + 256 * (i)) & 7) * 8)
#define ATT_GLOAD(TI)                                                                                         \
  {                                                                                                           \
    const int ti_ = (TI);                                                                                     \
    const int key0_ = ti_ < nA ? a0 + ti_ * 64 : b0 + (ti_ - nA) * 64;                                        \
    rk0 = *(const uint4*)ATT_KADDR(0);                                                                        \
    rk1 = *(const uint4*)ATT_KADDR(1);                                                                        \
    if (KPT > 2) rk2 = *(const uint4*)ATT_KADDR(2);                                                           \
    rv0 = *(const uint4*)ATT_VADDR(0);                                                                        \
    rv1 = *(const uint4*)ATT_VADDR(1);                                                                        \
  }
#define ATT_KSADDR(i) (sK + buf_ * (64 * KS) + ((tid + 256 * (i)) / KCH) * KS + ((tid + 256 * (i)) % KCH) * 8)
#define ATT_VSADDR(i) (sV + buf_ * (64 * 72) + ((tid + 256 * (i)) >> 3) * 72 + ((tid + 256 * (i)) & 7) * 8)
#define ATT_SSTORE(BUF)                                                                                       \
  {                                                                                                           \
    const int buf_ = (BUF);                                                                                   \
    *(uint4*)ATT_KSADDR(0) = rk0;                                                                             \
    *(uint4*)ATT_KSADDR(1) = rk1;                                                                             \
    if (KPT > 2) *(uint4*)ATT_KSADDR(2) = rk2;                                                                \
    *(uint4*)ATT_VSADDR(0) = rv0;                                                                             \
    *(uint4*)ATT_VSADDR(1) = rv1;                                                                             \
  }
  ATT_GLOAD(0)
  ATT_SSTORE(0)
  __syncthreads();
  for (int ti = 0; ti < nT; ++ti) {
    const int cur = ti & 1;
    if (ti + 1 < nT) ATT_GLOAD(ti + 1)
    __builtin_amdgcn_sched_barrier(0);
    const bool inA = ti < nA;
    const int key0 = inA ? a0 + ti * 64 : b0 + (ti - nA) * 64;
    const bool msk = band && inA;
#pragma unroll
    for (int kb = 0; kb < 2; ++kb) {
      const int kbase = key0 + kb * 32;
      bool skip = false;
      if (msk) { const int qw = qpos0 + wave * 32; skip = (kbase > qw + 31 + 128) || (kbase + 31 < qw - 128); }
      if (!skip) {
        f32x16 s;
#pragma unroll
        for (int i = 0; i < 16; ++i) s[i] = 0.f;
        const bf16_t* kp = sK + cur * (64 * KS) + (kb * 32 + r) * KS + 8 * h;
#pragma unroll
        for (int ds = 0; ds < NQ; ++ds) { const bf16x8 a = *(const bf16x8*)(kp + ds * 16); s = MFMA32(a, qf[ds], s); }
        if (msk) {
          const int qp_ = qpos0 + wave * 32 + r;
#pragma unroll
          for (int i = 0; i < 16; ++i) { const int dlt = qp_ - (kbase + crow(i, h)); if (dlt > 128 || dlt < -128) s[i] = -1e30f; }
        }
        float mx = s[0];
#pragma unroll
        for (int i = 1; i < 16; ++i) mx = fmaxf(mx, s[i]);
        mx = fmaxf(mx, __shfl_xor(mx, 32));
        const float mn = fmaxf(m, mx);
        const float alpha = __builtin_amdgcn_exp2f(m - mn);
        m = mn;
        s = s - mn;
#pragma unroll
        for (int i = 0; i < 16; ++i) s[i] = __builtin_amdgcn_exp2f(s[i]);
        float ps;
        {
          typedef float f32x8_t __attribute__((ext_vector_type(8)));
          const f32x8_t lo8 = __builtin_shufflevector(s, s, 0, 1, 2, 3, 4, 5, 6, 7), hi8 = __builtin_shufflevector(s, s, 8, 9, 10, 11, 12, 13, 14, 15);
          const f32x8_t s8 = lo8 + hi8;
          const f32x4 s4 = __builtin_shufflevector(s8, s8, 0, 1, 2, 3) + __builtin_shufflevector(s8, s8, 4, 5, 6, 7);
          const f32x2 s2 = __builtin_shufflevector(s4, s4, 0, 1) + __builtin_shufflevector(s4, s4, 2, 3);
          ps = s2.x + s2.y;
        }
        l = l * alpha + ps;
        if (__builtin_amdgcn_ballot_w64(alpha != 1.0f) != 0ull) {
#pragma unroll
          for (int i = 0; i < 16; ++i) { o0[i] *= alpha; o1[i] *= alpha; }
        }
        bf16x8 pf0, pf1;
#pragma unroll
        for (int j = 0; j < 8; j += 2) {
          const unsigned w0 = pk2(s[j], s[j + 1]), w1 = pk2(s[8 + j], s[8 + j + 1]);
          pf0[j] = (short)(w0 & 0xffffu); pf0[j + 1] = (short)(w0 >> 16);
          pf1[j] = (short)(w1 & 0xffffu); pf1[j + 1] = (short)(w1 >> 16);
        }
        const bf16_t* vp = sV + cur * (64 * 72) + r * 72 + kb * 32 + 4 * h;
#pragma unroll
        for (int st = 0; st < 2; ++st) {
          const s16x4 lo0 = *(const s16x4*)(vp + 16 * st), hi0 = *(const s16x4*)(vp + 16 * st + 8);
          const s16x4 lo1 = *(const s16x4*)(vp + 32 * 72 + 16 * st), hi1 = *(const s16x4*)(vp + 32 * 72 + 16 * st + 8);
          const bf16x8 va0 = __builtin_shufflevector(lo0, hi0, 0, 1, 2, 3, 4, 5, 6, 7);
          const bf16x8 va1 = __builtin_shufflevector(lo1, hi1, 0, 1, 2, 3, 4, 5, 6, 7);
          o0 = MFMA32(va0, st ? pf1 : pf0, o0);
          o1 = MFMA32(va1, st ? pf1 : pf0, o1);
        }
      }
    }
    __builtin_amdgcn_sched_barrier(0);
    if (ti + 1 < nT) ATT_SSTORE(cur ^ 1)
    __syncthreads();
  }
  l += __shfl_xor(l, 32);
  const float inv = 1.0f / l;
  bf16_t* op = Oh + (size_t)(wave * 32 + r) * 256;
#pragma unroll
  for (int g = 0; g < 4; ++g) {
    uint2 w;
    w.x = pk2(o0[4 * g] * inv, o0[4 * g + 1] * inv); w.y = pk2(o0[4 * g + 2] * inv, o0[4 * g + 3] * inv);
    *(uint2*)(op + 8 * g + 4 * h) = w;
    w.x = pk2(o1[4 * g] * inv, o1[4 * g + 1] * inv); w.y = pk2(o1[4 * g + 2] * inv, o1[4 * g + 3] * inv);
    *(uint2*)(op + 32 + 8 * g + 4 * h) = w;
  }
}

DI void mla_item(const P& p, int b, int head, int row0, int a0, int a1, unsigned char* smem) {
  unsigned char* ws = p.ws;
  const bf16_t* Q = (const bf16_t*)(ws + O_QMLA) + ((size_t)row0 * 4 + head) * 96;
  const bf16_t* K = (const bf16_t*)(ws + O_KMLA) + ((size_t)b * 4 + head) * KEYS * 96;
  const bf16_t* V = (const bf16_t*)(ws + O_VMLAT) + ((size_t)b * 4 + head) * 64 * KEYS;
  bf16_t* O = (bf16_t*)(ws + O_O4) + (size_t)row0 * 256 + head * 64;
  attn_item<96>(Q, 384, K, V, O, a0, a1, 0, 0, false, 0, -1e30f, 0.f, smem);
}
DI void swa_item(const P& p, int layer, int b, int head, int row0, int a0, int a1, int b0, int b1, bool band, int qpos0, unsigned char* smem) {
  unsigned char* ws = p.ws;
  const int kvh = head >> 1;
  const bf16_t* Q = (const bf16_t*)(ws + O_QSWA) + ((size_t)row0 * 4 + head) * 64;
  const bf16_t* K = (const bf16_t*)(ws + O_KSWA) + ((size_t)b * 2 + kvh) * KEYS * 64;
  const bf16_t* V = (const bf16_t*)(ws + O_VSWAT) + ((size_t)b * 2 + kvh) * 64 * KEYS;
  bf16_t* O = (bf16_t*)(ws + O_O4) + (size_t)2 * M_ALL * 256 + (size_t)row0 * 256 + head * 64;
  const float sink = p.in[I_SINK][layer * 4 + head] * LOG2E;
  attn_item<64>(Q, 256, K, V, O, a0, a1, b0, b1, band, qpos0, sink, 1.f, smem);
}

DI void phase_mix(const P& p, int slot, int layer, bool ctx_out, unsigned char* smem, int* s_item) {
  unsigned* ctr = (unsigned*)(p.ws + O_CTR) + slot;
  const int n_s5 = 256, n_hy = 1024, n_mla = 1024, n_swa = 1024;
  const int e0 = n_s5, e1 = e0 + n_hy, e2 = e1 + n_mla, e3 = e2 + n_swa;
  const int e4 = e3 + (ctx_out ? 1024 : 0), e5 = e4 + (ctx_out ? 64 : 0), e6 = e5 + (ctx_out ? 64 : 0);
  for (;;) {
    if (TIDX == 0) *s_item = (int)atomicAdd(ctr, 1u);
    __syncthreads();
    const int it = *s_item;
    __syncthreads();
    if (it >= e6) break;
    if (it < e0) { for (int rp = 0; rp < REP_S5; ++rp) s5_item(p, layer, it, smem); }
    else if (it < e1) { const int j = it - e0; for (int rp = 0; rp < REP_HY; ++rp) hyena_item(p, layer, 0, j >> 2, j & 3, smem); }
    else if (it < e2) {
      const int j = it - e1, qb = j & 31, head = (j >> 5) & 3, b = j >> 7;
      for (int rp = 0; rp < REP_MLA; ++rp) mla_item(p, b, head, b * 4096 + qb * 128, 0, KEYS, smem);
    } else if (it < e3) {
      const int j = it - e2, qb = j & 31, head = (j >> 5) & 3, b = j >> 7, q0 = qb * 128;
      const int a0 = q0 >= 128 ? q0 - 128 : 0, a1 = q0 + 256 <= 4096 ? q0 + 256 : 4096;
      for (int rp = 0; rp < REP_SWA; ++rp) swa_item(p, layer, b, head, b * 4096 + q0, a0, a1, 4096, KEYS, true, q0, smem);
    } else if (it < e4) { const int j = it - e3; hyena_item(p, layer, 1, j >> 2, j & 3, smem); }
    else if (it < e5) {
      const int j = it - e4, qb = j & 1, head = (j >> 1) & 3, b = j >> 3;
      mla_item(p, b, head, M_LAT + b * 256 + qb * 128, 4096, KEYS, smem);
    } else {
      const int j = it - e5, qb = j & 1, head = (j >> 1) & 3, b = j >> 3;
      swa_item(p, layer, b, head, M_LAT + b * 256 + qb * 128, 4096, KEYS, 0, 0, false, 0, smem);
    }
  }
}

#define XB_TMO      128
#define XB_XCNT(j)  (256  + 64 * (j))
#define XB_XSUB(j)  (1280 + 64 * (j))
#define XB_XGEN(j)  (2304 + 64 * (j))
#define XB_TOP      3328
#define XB_TOPGEN   3392
#define XCD_BAR_WORDS 3456
#define XB_SPIN_CAP (1u << 22)
#define LAS __attribute__((address_space(3)))
DI unsigned xb_ld(unsigned* p) { return __hip_atomic_load(p, __ATOMIC_RELAXED, __HIP_MEMORY_SCOPE_AGENT); }
DI unsigned xb_add(unsigned* p, unsigned v) { return __hip_atomic_fetch_add(p, v, __ATOMIC_RELAXED, __HIP_MEMORY_SCOPE_AGENT); }
DI unsigned xb_xcc_id() { return (unsigned)__builtin_amdgcn_s_getreg((3 << 11) | 20) & 0xFu; }
#define XB_SPIN(cond, bar) do { unsigned _sp = 0; while (cond) { __builtin_amdgcn_s_sleep(1); \
    if ((++_sp & 255u) == 0u) { if (xb_ld(&(bar)[XB_TMO])) break; if (_sp > XB_SPIN_CAP) { atomicAdd(&(bar)[XB_TMO], 1u); break; } } } } while (0)
struct XcdBarrier { unsigned* bar; unsigned x; volatile LAS unsigned* st; };
DI XcdBarrier xcd_barrier_post(unsigned* bar, volatile LAS unsigned* st) {
  XcdBarrier b; b.bar = bar; b.x = xb_xcc_id(); b.st = st;
  if (threadIdx.x == 0) (void)xb_add(&bar[XB_XCNT(b.x)], 1u);
  return b;
}
DI void xcd_barrier_complete(unsigned* bar, unsigned x, unsigned& nloc, unsigned& nx) {
  const unsigned G = gridDim.x * gridDim.y * gridDim.z;
  unsigned sum, cnt, mine, sp = 0u;
  for (;;) {
    sum = 0u; cnt = 0u; mine = 0u;
#pragma unroll
    for (unsigned j = 0; j < 16; ++j) { const unsigned c = xb_ld(&bar[XB_XCNT(j)]); sum += c; cnt += (c > 0u) ? 1u : 0u; mine = (j == x) ? c : mine; }
    if (sum == G) break;
    __builtin_amdgcn_s_sleep(1);
    if ((++sp & 255u) == 0u) { if (xb_ld(&bar[XB_TMO])) break; if (sp > XB_SPIN_CAP) { atomicAdd(&bar[XB_TMO], 1u); break; } }
  }
  nloc = mine > 0u ? mine : 1u; nx = cnt > 0u ? cnt : 1u;
}
DI void xcd_barrier(const XcdBarrier& b) {
  asm volatile("s_waitcnt vmcnt(0)" ::: "memory");
  __syncthreads();
  if (threadIdx.x == 0) {
    unsigned* bar = b.bar;
    __builtin_amdgcn_s_waitcnt(0);
    unsigned nloc = b.st[0], nx = b.st[1];
    if (nloc == 0u) { xcd_barrier_complete(bar, b.x, nloc, nx); b.st[0] = nloc; b.st[1] = nx; }
    const unsigned old = xb_add(&bar[XB_XSUB(b.x)], 1u);
    const unsigned gen = old / nloc;
    if (old + 1u == (gen + 1u) * nloc) {
      __builtin_amdgcn_fence(__ATOMIC_RELEASE, "agent");
      asm volatile("s_waitcnt vmcnt(0)" ::: "memory");
      const unsigned og = xb_add(&bar[XB_TOP], 1u);
      const unsigned tg = og / nx;
      if (og + 1u == (tg + 1u) * nx) xb_add(&bar[XB_TOPGEN], 1u);
      else XB_SPIN(xb_ld(&bar[XB_TOPGEN]) == tg, bar);
      __builtin_amdgcn_fence(__ATOMIC_ACQUIRE, "agent");
      xb_add(&bar[XB_XGEN(b.x)], 1u);
      asm volatile("s_waitcnt vmcnt(0)" ::: "memory");
    } else {
      XB_SPIN(xb_ld(&bar[XB_XGEN(b.x)]) == gen, bar);
      __builtin_amdgcn_fence(__ATOMIC_ACQUIRE, "agent");
      asm volatile("s_waitcnt vmcnt(0)" ::: "memory");
    }
  }
  __syncthreads();
}

#ifndef REP_UPDN
#define REP_UPDN 1
#endif
#ifndef REP_MIXER_GEMM
#define REP_MIXER_GEMM 1
#endif
#ifndef REP_MIX
#define REP_MIX 1
#endif
#ifndef REP_PRO
#define REP_PRO 1
#endif
#ifndef REP_CONV
#define REP_CONV 1
#endif
#ifndef REP_KF
#define REP_KF 1
#endif
#ifndef REP_MODH
#define REP_MODH 1
#endif
#ifndef REP_MODONLY
#define REP_MODONLY 1
#endif
#ifndef REP_H2ONLY
#define REP_H2ONLY 1
#endif
#ifndef REP_SYNC
#define REP_SYNC 1
#endif
#define GSYNC() { for (int rs_ = 0; rs_ < REP_SYNC; ++rs_) xcd_barrier(xb); }
__global__ void __launch_bounds__(NT, 2) fwd_megakernel(P p) {
  cg::grid_group grid = cg::this_grid();
  __shared__ __attribute__((aligned(16))) unsigned char smem[SMEM_BYTES];
  __shared__ int s_item;
  unsigned char* ws = p.ws;
  __shared__ uint4 xb_words;
  if (threadIdx.x == 0) xb_words = make_uint4(0u, 0u, 0u, 0u);
  __syncthreads();
  XcdBarrier xb = xcd_barrier_post((unsigned*)(ws + O_BAR), (volatile LAS unsigned*)&xb_words);
  for (int rep = 0; rep < REP_PRO; ++rep) {
    for (int r2 = 0; r2 < REP_MODH; ++r2) { for (int r3 = 0; r3 < REP_MODONLY; ++r3) phase_modulation(p, smem); for (int r3 = 0; r3 < REP_H2ONLY; ++r3) phase_h2(p); phase_rope(p); }
    for (int r2 = 0; r2 < REP_CONV; ++r2) phase_convert(p, 0, smem);
    if (p.out == nullptr) grid.sync();
    GSYNC();
  }
  for (int rep = 0; rep < REP_PRO * REP_KF; ++rep) phase_kf(p, 0, true, smem);
  phase_rows(p, M_ALL, 0, 0, 0, 0.f, true, true, 0, 0, false);
  GSYNC();
#pragma unroll 1
  for (int layer = 0; layer < 2; ++layer) {
    const bool ctx_out = layer == 0;
    const int Mc = ctx_out ? M_ALL : M_LAT;
    for (int rep = 0; rep < REP_UPDN; ++rep) {
      phase_ffn_up(p, M_ALL, O_WUP1, smem);
      GSYNC();
      phase_gemm_plain_bf16(p, M_ALL, (const bf16_t*)(ws + O_ACT), DFF, (const bf16_t*)(ws + O_WDN1), (bf16_t*)(ws + O_F), 1024, smem);
      GSYNC();
    }
    phase_rows(p, M_ALL, 1, layer, 0, 0.5f, layer == 0, true, layer, 1, true);
    GSYNC();
    for (int rep = 0; rep < REP_MIXER_GEMM; ++rep) {
      if (rep) { phase_rows(p, M_ALL, 2, layer, 0, 0.f, false, false, 0, 0, true); GSYNC(); }
      phase_win(p, M_ALL, smem);
      GSYNC();
      phase_kvq(p, M_ALL, Mc, smem);
      GSYNC();
    }
    for (int rep = 0; rep < REP_MIX; ++rep) {
      phase_mix(p, layer + 2 * rep, layer, ctx_out, smem, &s_item);
      GSYNC();
      phase_glu(p, layer, Mc, smem);
      GSYNC();
    }
    for (int rep = 0; rep < REP_MIXER_GEMM; ++rep) {
      phase_merge(p, layer, Mc, smem);
      GSYNC();
      phase_gemm_plain_bf16(p, Mc, (const bf16_t*)(ws + O_MBUF), 1024, (const bf16_t*)(ws + O_WOUT), (bf16_t*)(ws + O_F), 1024, smem);
      GSYNC();
    }
    phase_rows(p, Mc, 1, layer, 1, 1.0f, false, true, layer, 2, false);
    GSYNC();
    for (int rep = 0; rep < REP_UPDN; ++rep) {
      phase_ffn_up(p, Mc, O_WUP2, smem);
      GSYNC();
      phase_gemm_plain_bf16(p, Mc, (const bf16_t*)(ws + O_ACT), DFF, (const bf16_t*)(ws + O_WDN2), (bf16_t*)(ws + O_F), 1024, smem);
      GSYNC();
    }
    phase_rows(p, Mc, 1, layer, 2, 0.5f, false, layer == 0, layer + 1, 0, false);
    if (layer == 0) {
      for (int rep = 0; rep < REP_PRO; ++rep) {
        for (int r2 = 0; r2 < REP_CONV; ++r2) phase_convert(p, 1, smem);
        for (int r2 = 0; r2 < REP_KF; ++r2) phase_kf(p, 1, false, smem);
      }
    }
    GSYNC();
  }
}

extern "C" void kernel_launch(void* const* d_in, const int* in_sizes, int n_in, void* d_out, int out_size, void* d_ws, size_t ws_size,
                              hipStream_t stream) {
  (void)in_sizes; (void)out_size;
  static int grid_blocks = 0;
  if (!grid_blocks) {
    int dev = 0, cus = 0, per = 0;
    (void)hipGetDevice(&dev);
    (void)hipDeviceGetAttribute(&cus, hipDeviceAttributeMultiprocessorCount, dev);
    (void)hipOccupancyMaxActiveBlocksPerMultiprocessor(&per, fwd_megakernel, NT, 0);
    if (per > 2) per = 2;
    if (per < 1) per = 1;
    grid_blocks = cus * per;
    grid_blocks &= ~7;
  }
  if (ws_size < WS_NEED || n_in < N_INPUTS) {
    fprintf(stderr, "workspace too small: need %zu have %zu\n", (size_t)WS_NEED, ws_size);
    return;
  }
  P p{};
  for (int i = 0; i < N_INPUTS; ++i) p.in[i] = (const float*)d_in[i];
  p.out = (float*)d_out;
  p.ws = (unsigned char*)d_ws;
  (void)hipMemsetAsync((unsigned char*)d_ws + O_CTR, 0, (size_t)(O_R - O_CTR), stream);
  void* args[] = {&p};
  hipError_t e = hipLaunchCooperativeKernel((void*)fwd_megakernel, dim3(grid_blocks), dim3(NT), args, 0, stream);
  if (e != hipSuccess) fprintf(stderr, "cooperative launch failed: %s (grid %d)\n", hipGetErrorString(e), grid_blocks);
}
```

```cpp
#include <hip/hip_runtime.h>
#include <hip/hip_cooperative_groups.h>
#include <cstdio>
namespace cg = cooperative_groups;
#ifndef PROBE_DBL
#define PROBE_DBL 0
#endif
#ifndef REP_S5
#define REP_S5 1
#endif
#ifndef REP_HY
#define REP_HY 1
#endif
#ifndef REP_MLA
#define REP_MLA 1
#endif
#ifndef REP_SWA
#define REP_SWA 1
#endif

#define DI __device__ __forceinline__
typedef unsigned short bf16_t;
typedef short bf16x8 __attribute__((ext_vector_type(8)));
typedef short s16x4 __attribute__((ext_vector_type(4)));
typedef float f32x16 __attribute__((ext_vector_type(16)));
typedef float f32x4 __attribute__((ext_vector_type(4)));
typedef float f32x2 __attribute__((ext_vector_type(2)));
typedef __bf16 bf16v2 __attribute__((ext_vector_type(2)));
#define MFMA32(a, b, c) __builtin_amdgcn_mfma_f32_32x32x16_bf16((a), (b), (c), 0, 0, 0)
#define MFMA16(a, b, c) __builtin_amdgcn_mfma_f32_16x16x32_bf16((a), (b), (c), 0, 0, 0)

constexpr int NT = 256;
constexpr int DM = 1024, NB = 8, SEQ = 4096, CTX = 256, DFF = 2816;
constexpr int M_LAT = NB * SEQ, M_CTX = NB * CTX, M_ALL = M_LAT + M_CTX;
constexpr int KEYS = SEQ + CTX;
constexpr float EPS = 1e-6f;
constexpr float LOG2E = 1.4426950408889634f;
constexpr int SMEM_BYTES = 73728;

enum { I_X = 0, I_C, I_CTX, I_CCTX, I_WADA, I_BADA, I_NPRE, I_NPOST, I_UP1, I_DN1, I_UP2, I_DN2, I_WIN, I_QNORM, I_KVNORM, I_WUQ, I_WUKV,
       I_HCW, I_HCB, I_HW1, I_HB1, I_HFREQ, I_HW2, I_HB2, I_HW3, I_HBIAS, I_SINK, I_ARE, I_AIM, I_LOGDT, I_BRE, I_BIM, I_CRE, I_CIM, I_S5D,
       I_GLUW, I_GLUB, I_WGATE, I_BGATE, I_BRMLA, I_BRHY, I_BRSWA, I_BRS5, I_WOUT, N_INPUTS };

constexpr size_t AL(size_t x) { return (x + 255) & ~size_t(255); }
constexpr size_t O_WUP1 = 0;
constexpr size_t O_WDN1 = O_WUP1 + AL((size_t)5632 * 1024 * 2);
constexpr size_t O_WUP2 = O_WDN1 + AL((size_t)1024 * 2816 * 2);
constexpr size_t O_WDN2 = O_WUP2 + AL((size_t)5632 * 1024 * 2);
constexpr size_t O_WIN = O_WDN2 + AL((size_t)1024 * 2816 * 2);
constexpr size_t O_WGATE = O_WIN + AL((size_t)1920 * 1024 * 2);
constexpr size_t O_WBR = O_WGATE + AL((size_t)4096 * 1024 * 2);
constexpr size_t O_WOUT = O_WBR + AL((size_t)4 * 1024 * 256 * 2);
constexpr size_t O_WUKV = O_WOUT + AL((size_t)1024 * 1024 * 2);
constexpr size_t O_WUQ = O_WUKV + AL((size_t)512 * 128 * 2);
constexpr size_t O_WGLU = O_WUQ + AL((size_t)384 * 192 * 2);
constexpr size_t O_U = O_WGLU + AL((size_t)256 * 256 * 2);
constexpr size_t O_XC = O_U + AL((size_t)M_ALL * 1024 * 2);
constexpr size_t O_MOD = O_XC + AL((size_t)M_CTX * 1024 * 4);
constexpr size_t O_H2 = O_MOD + AL((size_t)2 * 9 * 9216 * 4);
constexpr size_t O_ROPEM = O_H2 + AL((size_t)2 * (4096 + 256) * 64 * 4);
constexpr size_t O_ROPEW = O_ROPEM + AL((size_t)4096 * 16 * 8);
constexpr size_t O_KF0 = O_ROPEW + AL((size_t)4096 * 32 * 8);
constexpr size_t O_KF1 = O_KF0 + AL((size_t)256 * 2 * 8192 * 8);
constexpr size_t O_ROWSS = O_KF1 + AL((size_t)256 * 2 * 512 * 8);
constexpr size_t O_CTR = O_ROWSS + AL((size_t)2 * M_ALL * 4);
constexpr size_t O_BAR = O_CTR + 256;
constexpr size_t O_R = O_BAR + AL((size_t)3456 * 4);
constexpr size_t O_ACT = O_R;
constexpr size_t O_F = O_R + AL((size_t)M_ALL * 2816 * 2);
constexpr size_t O_O4 = O_R;
constexpr size_t O_Y = O_O4 + AL((size_t)4 * M_ALL * 256 * 2);
constexpr size_t O_HYT = O_Y + AL((size_t)2 * M_ALL * 256 * 2);
constexpr size_t O_MBUF = O_HYT;
constexpr size_t O_S5U = O_HYT + AL((size_t)M_ALL * 768 * 2);
constexpr size_t O_CKV = O_S5U + AL((size_t)M_ALL * 256 * 4);
constexpr size_t O_CQ = O_CKV + AL((size_t)M_ALL * 128 * 2);
constexpr size_t O_KMLA = O_CQ + AL((size_t)M_ALL * 192 * 2);
constexpr size_t O_VMLAT = O_KMLA + AL((size_t)NB * 4 * KEYS * 96 * 2);
constexpr size_t O_QMLA = O_VMLAT + AL((size_t)NB * 4 * 64 * KEYS * 2);
constexpr size_t O_KSWA = O_QMLA + AL((size_t)M_ALL * 384 * 2);
constexpr size_t O_VSWAT = O_KSWA + AL((size_t)NB * 2 * KEYS * 64 * 2);
constexpr size_t O_QSWA = O_VSWAT + AL((size_t)NB * 2 * 64 * KEYS * 2);
constexpr size_t O_END_MIX = O_QSWA + AL((size_t)M_ALL * 256 * 2);
constexpr size_t O_END_FFN = O_F + AL((size_t)M_ALL * 1024 * 2);
constexpr size_t WS_NEED = O_END_MIX > O_END_FFN ? O_END_MIX : O_END_FFN;
static_assert(O_MBUF + (size_t)M_ALL * 1024 * 2 <= O_CKV, "mbuf overlaps");
static_assert(O_F >= O_CKV, "F placement");
static_assert(WS_NEED <= (size_t)512 * 1024 * 1024, "workspace budget");
constexpr size_t HYT_LATSZ = (size_t)NB * 768 * 4096;

struct P {
  const float* in[N_INPUTS];
  float* out;
  unsigned char* ws;
};

DI int opaque_i(int x) { asm volatile("" : "+v"(x)); return x; }
#define TIDX opaque_i((int)threadIdx.x)
DI unsigned pk2(float lo, float hi) { f32x2 v = {lo, hi}; return __builtin_bit_cast(unsigned, __builtin_convertvector(v, bf16v2)); }
DI bf16_t f2bf(float x) { return (bf16_t)(pk2(x, 0.f) & 0xffffu); }
DI float bf2f(bf16_t b) { return __uint_as_float(((unsigned)b) << 16); }
DI float wave_sum(float v) {
#pragma unroll
  for (int o = 32; o; o >>= 1) v += __shfl_xor(v, o);
  return v;
}
DI int crow(int i, int h) { return (i & 3) + 8 * (i >> 2) + 4 * h; }
DI float fast_exp(float x) { return __builtin_amdgcn_exp2f(x * LOG2E); }
DI float sigmoidf_(float x) { return __builtin_amdgcn_rcpf(1.f + fast_exp(-x)); }
DI float siluf_(float x) { return x * sigmoidf_(x); }
DI void sincos_d(double x, float& s_out, float& c_out) {
  double k = rint(x * 0.15915494309189535);
  double r = x - k * 6.283185307179586;
  double y = r * 0.0625, y2 = y * y;
  double s = y * (1.0 - y2 / 6.0 * (1.0 - y2 / 20.0 * (1.0 - y2 / 42.0 * (1.0 - y2 / 72.0 * (1.0 - y2 / 110.0)))));
  double c = 1.0 - y2 / 2.0 * (1.0 - y2 / 12.0 * (1.0 - y2 / 30.0 * (1.0 - y2 / 56.0 * (1.0 - y2 / 90.0 * (1.0 - y2 / 132.0)))));
#pragma unroll
  for (int i = 0; i < 4; ++i) { double s2 = 2.0 * s * c, c2 = c * c - s * s; s = s2; c = c2; }
  s_out = (float)s; c_out = (float)c;
}
DI float sin_acc(float x) { float s, c; sincos_d((double)x, s, c); return s; }

template <int NI>
DI void gemm_kloop(f32x16 (&acc)[2][NI], const bf16_t* __restrict__ A, int lda, const bf16_t* __restrict__ Bt, int ldb, int K, int m0, int n0,
                   unsigned char* smem) {
  unsigned char* sA = smem;
  unsigned char* sB = smem + 32768;
  const int tid = TIDX, lane = tid & 63, wave = tid >> 6, r = lane & 31, h = lane >> 5, wm = wave >> 1, wn = wave & 1;
  const int drow = wave * 8 + (lane >> 3);
  const int csw = (lane & 7) ^ ((drow >> 1) & 7);
  const bf16_t* gA = A + (size_t)(m0 + drow) * lda + csw * 8;
  const bf16_t* gB = Bt + (size_t)(n0 + drow) * ldb + csw * 8;
  const int ldst = wave * 1024 + lane * 16;
  const int rsw = (r >> 1) & 7;
#define G_ISSUE(BUF, KO)                                                                                                        \
  {                                                                                                                             \
    _Pragma("unroll") for (int i = 0; i < 4; ++i)                                                                               \
        __builtin_amdgcn_global_load_lds((const unsigned*)(gA + (size_t)(32 * i) * lda + (KO)),                                 \
                                         (unsigned*)(sA + (BUF) * 16384 + i * 4096 + ldst), 16, 0, 0);                          \
    _Pragma("unroll") for (int i = 0; i < 2 * NI; ++i)                                                                          \
        __builtin_amdgcn_global_load_lds((const unsigned*)(gB + (size_t)(32 * i) * ldb + (KO)),                                 \
                                         (unsigned*)(sB + (BUF) * 16384 + i * 4096 + ldst), 16, 0, 0);                          \
  }
  const int nk = K >> 6;
  __syncthreads();
  G_ISSUE(0, 0)
  asm volatile("s_waitcnt vmcnt(0)" ::: "memory");
  __syncthreads();
  for (int ks = 0; ks < nk; ++ks) {
    const int cur = ks & 1;
    if (ks + 1 < nk) G_ISSUE(cur ^ 1, (ks + 1) * 64)
    const unsigned char* ab = sA + cur * 16384 + (wm * 64 + r) * 128;
    const unsigned char* bb = sB + cur * 16384 + (wn * 32 * NI + r) * 128;
#pragma unroll
    for (int kk = 0; kk < 4; ++kk) {
      const int pc = ((kk * 2 + h) ^ rsw) * 16;
      const bf16x8 a0 = *(const bf16x8*)(ab + pc), a1 = *(const bf16x8*)(ab + 32 * 128 + pc);
#pragma unroll
      for (int ni = 0; ni < NI; ++ni) {
        const bf16x8 b = *(const bf16x8*)(bb + ni * 32 * 128 + pc);
        acc[0][ni] = MFMA32(a0, b, acc[0][ni]);
        acc[1][ni] = MFMA32(a1, b, acc[1][ni]);
      }
    }
    asm volatile("s_waitcnt vmcnt(0)" ::: "memory");
    __syncthreads();
  }
#undef G_ISSUE
}
template <int NI>
DI void zero_acc(f32x16 (&acc)[2][NI]) {
#pragma unroll
  for (int a = 0; a < 2; ++a)
#pragma unroll
    for (int b = 0; b < NI; ++b)
#pragma unroll
      for (int i = 0; i < 16; ++i) acc[a][b][i] = 0.f;
}
#define DSR(dst, addr, off) asm volatile("ds_read_b128 %0, %1 offset:%2" : "=v"(dst) : "v"(addr), "i"(off))
#define FR_READ(F, ST, AA, BB)                                     \
  {                                                                \
    DSR(F##a0, AA, (ST) * 24576);                                  \
    DSR(F##a1, AA, (ST) * 24576 + 2048);                           \
    DSR(F##b0, BB, (ST) * 24576 + 8192);                           \
    DSR(F##b1, BB, (ST) * 24576 + 8192 + 2048);                    \
    DSR(F##b2, BB, (ST) * 24576 + 8192 + 4096);                    \
    DSR(F##b3, BB, (ST) * 24576 + 8192 + 6144);                    \
  }
#define FR_WAIT(F, N) asm volatile("s_waitcnt lgkmcnt(" #N ")" : "+v"(F##a0), "+v"(F##a1), "+v"(F##b0), "+v"(F##b1), "+v"(F##b2), "+v"(F##b3)::"memory")
#define FR_MFMA(F)                                                 \
  {                                                                \
    acc[0][0] = MFMA32(F##a0, F##b0, acc[0][0]);                   \
    acc[1][0] = MFMA32(F##a1, F##b0, acc[1][0]);                   \
    acc[0][1] = MFMA32(F##a0, F##b1, acc[0][1]);                   \
    acc[1][1] = MFMA32(F##a1, F##b1, acc[1][1]);                   \
    acc[0][2] = MFMA32(F##a0, F##b2, acc[0][2]);                   \
    acc[1][2] = MFMA32(F##a1, F##b2, acc[1][2]);                   \
    acc[0][3] = MFMA32(F##a0, F##b3, acc[0][3]);                   \
    acc[1][3] = MFMA32(F##a1, F##b3, acc[1][3]);                   \
    if (PROBE_DBL) {                                               \
      dum0 = MFMA32(F##a1, F##b0, dum0); dum1 = MFMA32(F##a0, F##b1, dum1);  \
      dum0 = MFMA32(F##a1, F##b2, dum0); dum1 = MFMA32(F##a0, F##b3, dum1);  \
      dum0 = MFMA32(F##a0, F##b0, dum0); dum1 = MFMA32(F##a1, F##b1, dum1);  \
      dum0 = MFMA32(F##a0, F##b2, dum0); dum1 = MFMA32(F##a1, F##b3, dum1);  \
    }                                                              \
  }
DI void gemm_kloop_wide(f32x16 (&acc)[2][4], const bf16_t* __restrict__ A, int lda, const bf16_t* __restrict__ Bt, int ldb, int K, int m0, int n0,
                        unsigned char* smem) {
  const int tid = TIDX, lane = tid & 63, wave = tid >> 6, r = lane & 31, h = lane >> 5, wm = wave >> 1, wn = wave & 1;
  const int drow = wave * 16 + (lane >> 2);
  const int csw = (lane & 3) ^ ((lane >> 4) & 3);
  const bf16_t* gA = A + (size_t)(m0 + drow) * lda + csw * 8;
  const bf16_t* gB = Bt + (size_t)(n0 + drow) * ldb + csw * 8;
  const int ldst = wave * 1024 + lane * 16;
  const int rsw = (r >> 2) & 3;
  const unsigned lbase = (unsigned)(size_t)smem;
  const unsigned aA0 = lbase + (wm * 64 + r) * 64 + ((0 + h) ^ rsw) * 16, aA1 = lbase + (wm * 64 + r) * 64 + ((2 + h) ^ rsw) * 16;
  const unsigned bB0 = lbase + (wn * 128 + r) * 64 + ((0 + h) ^ rsw) * 16, bB1 = lbase + (wn * 128 + r) * 64 + ((2 + h) ^ rsw) * 16;
#define GW_ISSUE(ST, KO)                                                                                                        \
  {                                                                                                                             \
    _Pragma("unroll") for (int i = 0; i < 2; ++i)                                                                               \
        __builtin_amdgcn_global_load_lds((const unsigned*)(gA + (size_t)(64 * i) * lda + (KO)),                                 \
                                         (unsigned*)(smem + (ST) * 24576 + i * 4096 + ldst), 16, 0, 0);                         \
    _Pragma("unroll") for (int i = 0; i < 4; ++i)                                                                               \
        __builtin_amdgcn_global_load_lds((const unsigned*)(gB + (size_t)(64 * i) * ldb + (KO)),                                 \
                                         (unsigned*)(smem + (ST) * 24576 + 8192 + i * 4096 + ldst), 16, 0, 0);                  \
  }
  bf16x8 Pa0, Pa1, Pb0, Pb1, Pb2, Pb3, Qa0, Qa1, Qb0, Qb1, Qb2, Qb3;
  f32x16 dum0, dum1;
  _Pragma("unroll") for (int i = 0; i < 16; ++i) { dum0[i] = 0.f; dum1[i] = 0.f; }
#define GW_STEP(KIDX, S, S1, S2)                                                                                                \
  {                                                                                                                             \
    asm volatile("s_waitcnt vmcnt(0)" ::: "memory");                                 \
    __builtin_amdgcn_s_barrier();                               \
    if ((KIDX) + 2 < nk) GW_ISSUE(S2, ((KIDX) + 2) * 32)                                                                        \
    FR_READ(Q, S, aA1, bB1)                                                                           \
    FR_WAIT(P, 6);                                               \
    FR_MFMA(P)                                                                                                                  \
    FR_WAIT(Q, 0);                                                                                                              \
    if ((KIDX) + 1 < nk) FR_READ(P, S1, aA0, bB0)                                                    \
    FR_MFMA(Q)                                                                                                                  \
  }
  const int nk = K >> 5;
  asm volatile("s_waitcnt vmcnt(0) lgkmcnt(0)" ::: "memory");
  __builtin_amdgcn_s_barrier();
  GW_ISSUE(0, 0)
  GW_ISSUE(1, 32)
  asm volatile("s_waitcnt vmcnt(6)" ::: "memory");
  __builtin_amdgcn_s_barrier();
  FR_READ(P, 0, aA0, bB0)
  for (int k = 0; k < nk; k += 3) {
    GW_STEP(k, 0, 1, 2)
    if (k + 1 < nk) GW_STEP(k + 1, 1, 2, 0)
    if (k + 2 < nk) GW_STEP(k + 2, 2, 0, 1)
  }
#undef GW_ISSUE
#undef GW_STEP
  if (PROBE_DBL) { _Pragma("unroll") for (int i = 0; i < 16; ++i) acc[0][0][i] += 0.f * (dum0[i] + dum1[i]); }
}
template <int BN = 128, class F>
DI void for_tiles(int ntm, int ntn, F f, int m_base = 0) {
  constexpr int GM = 8, GN = 8;
  const int xcd = blockIdx.x & 7, slot = blockIdx.x >> 3, nslot = gridDim.x >> 3;
  const int nmx = ntm >> 3;
  const int per = nmx * ntn;
  const int fullN = ntn / GN, fullM = nmx / GM;
  for (int L = slot; L < per; L += nslot) {
    int ng = L / (nmx * GN), gn = GN;
    if (ng >= fullN) { ng = fullN; gn = ntn - fullN * GN; }
    const int rem = L - ng * (nmx * GN);
    int mg = rem / (GM * gn), gm = GM;
    if (mg >= fullM) { mg = fullM; gm = nmx - fullM * GM; }
    const int rem2 = rem - mg * (GM * gn);
    const int mi = rem2 % gm, ni = rem2 / gm;
    const int tn = ng * GN + ni, tm = xcd + 8 * (mg * GM + mi);
    f(m_base + tm * 128, tn * BN, tn);
  }
}
struct RowInfo { int b, pos, kpos, L; bool lat; };
DI RowInfo row_info(int row) {
  RowInfo ri;
  if (row < M_LAT) { ri.b = row >> 12; ri.pos = row & 4095; ri.kpos = ri.pos; ri.lat = true; ri.L = 4096; }
  else { int q = row - M_LAT; ri.b = q >> 8; ri.pos = q & 255; ri.kpos = 4096 + ri.pos; ri.lat = false; ri.L = 256; }
  return ri;
}

DI int map_col(int mode, int n) {
  if (mode == 0) return n;
  if (mode == 1) { const int isb = n >= DFF; const int j = isb ? n - DFF : n; return (j >> 5) * 64 + (isb ? 32 : 0) + (j & 31); }
  if (n >= 1120) return n - 1120;
  if (n >= 864) return n - 864 + 1024;
  if (n >= 672) return n - 672 + 1664;
  if (n >= 416) return n - 416 + 768;
  if (n >= 288) return n - 288 + 1408;
  if (n >= 160) return n - 160 + 1280;
  if (n >= 128) return n - 128 + 1856;
  return n + 1536;
}
DI void conv_tile(const float* __restrict__ src, bf16_t* __restrict__ dst, const float* __restrict__ kscale, int K, int N, int mode, int t, float* tile  ) {
  const int ntn = (N + 63) >> 6;
  const int kt = t / ntn, nt = t % ntn, k0 = kt * 64, n0 = nt * 64, tid = TIDX;
  float vv[16];
#pragma unroll
  for (int i = 0; i < 16; ++i) {
    const int idx = tid + 256 * i, kk = idx >> 6, nn = idx & 63;
    vv[i] = (n0 + nn < N) ? __builtin_nontemporal_load(src + (size_t)(k0 + kk) * N + n0 + nn) : 0.f;
  }
#pragma unroll
  for (int i = 0; i < 16; ++i) {
    const int idx = tid + 256 * i, kk = idx >> 6, nn = idx & 63;
    float v = vv[i];
    if (kscale) v *= kscale[k0 + kk];
    tile[kk * 65 + nn] = v;
  }
  __syncthreads();
#pragma unroll 4
  for (int i = 0; i < 8; ++i) {
    const int idx = tid + 256 * i, nn = idx >> 5, kp = idx & 31;
    if (n0 + nn < N) {
      const int dr = map_col(mode, n0 + nn);
      *(unsigned*)(dst + (size_t)dr * K + k0 + 2 * kp) = pk2(tile[(2 * kp) * 65 + nn], tile[(2 * kp + 1) * 65 + nn]);
    }
  }
  __syncthreads();
}
DI void phase_convert(const P& p, int layer, unsigned char* smem) {
  unsigned char* ws = p.ws;
  const size_t l = (size_t)layer;
  const int tid = TIDX;
#define CONV_JOB(SRC, OFF, KS, KK, NN, MODE)                                                              \
  {                                                                                                       \
    const int ntiles_ = ((KK) >> 6) * (((NN) + 63) >> 6);                                                 \
    for (int t = blockIdx.x; t < ntiles_; t += gridDim.x) conv_tile((SRC), (bf16_t*)(ws + (OFF)), (KS), (KK), (NN), (MODE), t, (float*)smem); \
  }
  CONV_JOB(p.in[I_UP1] + l * 1024 * 5632, O_WUP1, nullptr, 1024, 5632, 1)
  CONV_JOB(p.in[I_DN1] + l * 2816 * 1024, O_WDN1, nullptr, 2816, 1024, 0)
  CONV_JOB(p.in[I_UP2] + l * 1024 * 5632, O_WUP2, nullptr, 1024, 5632, 1)
  CONV_JOB(p.in[I_DN2] + l * 2816 * 1024, O_WDN2, nullptr, 2816, 1024, 0)
  CONV_JOB(p.in[I_WIN] + l * 1024 * 1888, O_WIN, nullptr, 1024, 1888, 2)
#pragma unroll 1
  for (int i = 0; i < 4; ++i) CONV_JOB(p.in[I_WGATE] + (l * 4 + i) * 1024 * 1024, O_WGATE + (size_t)i * 1024 * 1024 * 2, nullptr, 1024, 1024, 0)
  CONV_JOB(p.in[I_BRMLA] + l * 256 * 1024, O_WBR + (size_t)0 * 1024 * 256 * 2, nullptr, 256, 1024, 0)
  CONV_JOB(p.in[I_BRHY] + l * 256 * 1024, O_WBR + (size_t)1 * 1024 * 256 * 2, nullptr, 256, 1024, 0)
  CONV_JOB(p.in[I_BRSWA] + l * 256 * 1024, O_WBR + (size_t)2 * 1024 * 256 * 2, nullptr, 256, 1024, 0)
  CONV_JOB(p.in[I_BRS5] + l * 256 * 1024, O_WBR + (size_t)3 * 1024 * 256 * 2, nullptr, 256, 1024, 0)
  CONV_JOB(p.in[I_WOUT] + l * 1024 * 1024, O_WOUT, nullptr, 1024, 1024, 0)
  CONV_JOB(p.in[I_WUKV] + l * 128 * 512, O_WUKV, p.in[I_KVNORM] + l * 128, 128, 512, 0)
  CONV_JOB(p.in[I_WUQ] + l * 192 * 384, O_WUQ, p.in[I_QNORM] + l * 192, 192, 384, 0)
  CONV_JOB(p.in[I_GLUW] + l * 256 * 256, O_WGLU, nullptr, 256, 256, 0)
#undef CONV_JOB
  {
    unsigned* z = (unsigned*)(ws + O_WIN + (size_t)1888 * 1024 * 2);
    for (int i = blockIdx.x * NT + tid; i < 32 * 1024 / 2; i += gridDim.x * NT) z[i] = 0u;
  }
}

DI void phase_modulation(const P& p, unsigned char* smem) {
  float* sS = (float*)smem;
  float* sR = sS + 9 * 1024;
  const int tid = TIDX, lane = tid & 63, wave = tid >> 6;
  float* MOD = (float*)(p.ws + O_MOD);
  bool filled = false;
  for (int it = blockIdx.x; it < 2 * 144; it += gridDim.x) {
    if (!filled) {
      for (int i = tid; i < 9 * 1024; i += NT) {
        const int v = i >> 10, k = i & 1023;
        const float x = v < 8 ? p.in[I_C][v * 1024 + k] : p.in[I_CCTX][k];
        sS[i] = siluf_(x);
      }
      filled = true;
      __syncthreads();
    }
    const int layer = it / 144, col = (it % 144) * 64 + lane;
    const float* w = p.in[I_WADA] + (size_t)layer * 1024 * 9216 + col;
    float acc[9];
#pragma unroll
    for (int v = 0; v < 9; ++v) acc[v] = 0.f;
#pragma unroll 8
    for (int k = wave * 256; k < wave * 256 + 256; ++k) {
      const float wv = __builtin_nontemporal_load(w + (size_t)k * 9216);
#pragma unroll
      for (int v = 0; v < 9; ++v) acc[v] += sS[v * 1024 + k] * wv;
    }
#pragma unroll
    for (int v = 0; v < 9; ++v) sR[(wave * 9 + v) * 64 + lane] = acc[v];
    __syncthreads();
    for (int i = tid; i < 9 * 64; i += NT) {
      const int v = i >> 6, c = i & 63;
      const float s = sR[(0 * 9 + v) * 64 + c] + sR[(1 * 9 + v) * 64 + c] + sR[(2 * 9 + v) * 64 + c] + sR[(3 * 9 + v) * 64 + c];
      const int cc = (it % 144) * 64 + c;
      MOD[((size_t)layer * 9 + v) * 9216 + cc] = s + p.in[I_BADA][(size_t)layer * 9216 + cc];
    }
    __syncthreads();
  }
  __syncthreads();
}

DI size_t h2_off(int layer, int kind) { return ((size_t)layer * (4096 + 256) + (kind ? 4096 : 0)) * 64; }
DI void phase_h2(const P& p) {
  const int tid = TIDX, lane = tid & 63, wave = tid >> 6;
  float* H2 = (float*)(p.ws + O_H2);
  const int rows_per_layer = 4096 + 256;
  for (int rr = blockIdx.x * 4 + wave; rr < 2 * rows_per_layer; rr += gridDim.x * 4) {
    const int layer = rr / rows_per_layer, q = rr % rows_per_layer;
    const int kind = q >= 4096, t = kind ? q - 4096 : q, L = kind ? 256 : 4096;
    float z = 0.f;
    if (lane == 0) z = (float)t / (float)(L - 1);
    else if (lane < 33) {
      const int j = (lane - 1) & 15;
      const float w = (6.2831855f * (float)t) / (float)L;
      const float fr = 1e-4f + (float)j * ((15.0f - 1e-4f) / 15.0f);
      const float ang = w * fr;
      float s, c; sincos_d((double)ang, s, c);
      z = lane <= 16 ? c : -s;
    }
    const float* w1 = p.in[I_HW1] + (size_t)layer * 33 * 64;
    const float* w2 = p.in[I_HW2] + (size_t)layer * 64 * 64;
    float a = p.in[I_HB1][layer * 64 + lane];
    for (int i = 0; i < 33; ++i) a += __shfl(z, i) * w1[i * 64 + lane];
    const float h1 = sin_acc(p.in[I_HFREQ][(layer * 2 + 0) * 64 + lane] * a);
    float a2 = p.in[I_HB2][layer * 64 + lane];
    for (int i = 0; i < 64; ++i) a2 += __shfl(h1, i) * w2[i * 64 + lane];
    const float h2 = sin_acc(p.in[I_HFREQ][(layer * 2 + 1) * 64 + lane] * a2);
    H2[h2_off(layer, kind) + (size_t)t * 64 + lane] = h2;
  }
}

DI void phase_rope(const P& p) {
  f32x2* RM = (f32x2*)(p.ws + O_ROPEM);
  f32x2* RW = (f32x2*)(p.ws + O_ROPEW);
  const int g0 = blockIdx.x * NT + TIDX, gs = gridDim.x * NT;
  for (int i = g0; i < 4096 * 48; i += gs) {
    const int pos = i / 48, e = i % 48;
    const float rowf = (float)(pos >> 6), colf = (float)(pos & 63);
    float ang;
    if (e < 16) { const int f = e & 7; const float fr = fast_exp(-(float)f / 8.0f * 9.210340371976184f); ang = (e < 8 ? rowf : colf) * fr; }
    else { const int e2 = e - 16, f = e2 & 15; const float fr = fast_exp(-(float)f / 16.0f * 9.210340371976184f); ang = (e2 < 16 ? rowf : colf) * fr; }
    float s, c; sincos_d((double)ang, s, c);
    f32x2 v = {c, s};
    if (e < 16) RM[pos * 16 + e] = v; else RW[pos * 32 + (e - 16)] = v;
  }
}

DI f32x2 cmul(f32x2 a, f32x2 b) { f32x2 r = {a.x * b.x - a.y * b.y, a.x * b.y + a.y * b.x}; return r; }
DI f32x2 cmulc(f32x2 a, f32x2 b) { f32x2 r = {a.x * b.x + a.y * b.y, a.y * b.x - a.x * b.y}; return r; }
DI f32x2 mul_mi(f32x2 a) { f32x2 r = {a.y, -a.x}; return r; }
DI f32x2 mul_pi(f32x2 a) { f32x2 r = {-a.y, a.x}; return r; }
#define PH(i) ((i) + ((i) >> 4))
DI void fft16_dif_tail(f32x2 (&x)[16]) {
  const float C1 = 0.92387953251f, S1 = 0.38268343236f, R2 = 0.70710678118f;
  const f32x2 T[4] = {{1.f, 0.f}, {C1, -S1}, {R2, -R2}, {S1, -C1}};
  const f32x2 T2[4] = {{1.f, 0.f}, {R2, -R2}, {0.f, -1.f}, {-R2, -R2}};
#pragma unroll
  for (int j = 0; j < 4; ++j) {
    const f32x2 a0 = x[j], a1 = x[j + 4], a2 = x[j + 8], a3 = x[j + 12];
    const f32x2 b0 = a0 + a2, b2 = cmul(a0 - a2, T[j]), b1 = a1 + a3, b3 = mul_mi(cmul(a1 - a3, T[j]));
    x[j] = b0 + b1; x[j + 4] = cmul(b0 - b1, T2[j]); x[j + 8] = b2 + b3; x[j + 12] = cmul(b2 - b3, T2[j]);
  }
#pragma unroll
  for (int k = 0; k < 4; ++k) {
    const f32x2 a0 = x[4 * k], a1 = x[4 * k + 1], a2 = x[4 * k + 2], a3 = x[4 * k + 3];
    const f32x2 b0 = a0 + a2, b2 = a0 - a2, b1 = a1 + a3, b3 = mul_mi(a1 - a3);
    x[4 * k] = b0 + b1; x[4 * k + 1] = b0 - b1; x[4 * k + 2] = b2 + b3; x[4 * k + 3] = b2 - b3;
  }
}
DI void fft16_dit_head(f32x2 (&x)[16]) {
  const float C1 = 0.92387953251f, S1 = 0.38268343236f, R2 = 0.70710678118f;
  const f32x2 T[4] = {{1.f, 0.f}, {C1, -S1}, {R2, -R2}, {S1, -C1}};
  const f32x2 T2[4] = {{1.f, 0.f}, {R2, -R2}, {0.f, -1.f}, {-R2, -R2}};
#pragma unroll
  for (int k = 0; k < 4; ++k) {
    const f32x2 c0 = x[4 * k], c1 = x[4 * k + 1], c2 = x[4 * k + 2], c3 = x[4 * k + 3];
    const f32x2 b0 = c0 + c1, b1 = c0 - c1, b2 = c2 + c3, b3 = c2 - c3;
    const f32x2 up = mul_pi(b3);
    x[4 * k] = b0 + b2; x[4 * k + 2] = b0 - b2; x[4 * k + 1] = b1 + up; x[4 * k + 3] = b1 - up;
  }
#pragma unroll
  for (int j = 0; j < 4; ++j) {
    const f32x2 c0 = x[j], c1 = x[j + 4], c2 = x[j + 8], c3 = x[j + 12];
    const f32x2 t = cmulc(c1, T2[j]), tp = cmulc(c3, T2[j]);
    const f32x2 b0 = c0 + t, b1 = c0 - t, b2 = c2 + tp, b3 = c2 - tp;
    const f32x2 u = cmulc(b2, T[j]), up = mul_pi(cmulc(b3, T[j]));
    x[j] = b0 + u; x[j + 8] = b0 - u; x[j + 4] = b1 + up; x[j + 12] = b1 - up;
  }
}
DI void fft_dif(f32x2* W, int N, int logN) {
  const int tid = TIDX;
  int s = logN - 1;
  {
    const int half = 1 << s, hp = half + (half >> 4);
    const float inv = 1.0f / (float)(2 * half);
    for (int i = tid; i < (N >> 1); i += NT) {
      const int j = i & (half - 1), base = PH(((i >> s) << (s + 1)) + j);
      const f32x2 a = W[base], b = W[base + hp];
      const float rev = (float)j * inv;
      const f32x2 w = {__builtin_amdgcn_cosf(rev), -__builtin_amdgcn_sinf(rev)};
      W[base] = a + b;
      W[base + hp] = cmul(a - b, w);
    }
    __syncthreads();
    --s;
  }
  for (; s >= 5; s -= 2) {
    const int half = 1 << s, quarter = half >> 1, hp = half + (half >> 4), qp = quarter + (quarter >> 4);
    const float inv = 1.0f / (float)(2 * half);
    for (int i = tid; i < (N >> 2); i += NT) {
      const int j = i & (quarter - 1), i0 = PH(((i >> (s - 1)) << (s + 1)) + j);
      const f32x2 a0 = W[i0], a1 = W[i0 + qp], a2 = W[i0 + hp], a3 = W[i0 + hp + qp];
      const float rev = (float)j * inv;
      const f32x2 w1 = {__builtin_amdgcn_cosf(rev), -__builtin_amdgcn_sinf(rev)};
      const f32x2 w2 = cmul(w1, w1);
      const f32x2 b0 = a0 + a2, b2 = cmul(a0 - a2, w1), b1 = a1 + a3, b3 = mul_mi(cmul(a1 - a3, w1));
      W[i0] = b0 + b1;
      W[i0 + qp] = cmul(b0 - b1, w2);
      W[i0 + hp] = b2 + b3;
      W[i0 + hp + qp] = cmul(b2 - b3, w2);
    }
    __syncthreads();
  }
  for (int gq = tid; gq < (N >> 4); gq += NT) {
    f32x2 x[16];
#pragma unroll
    for (int e = 0; e < 16; ++e) x[e] = W[17 * gq + e];
    fft16_dif_tail(x);
#pragma unroll
    for (int e = 0; e < 16; ++e) W[17 * gq + e] = x[e];
  }
  __syncthreads();
}
DI void fft_dit_inv(f32x2* W, int N, int logN) {
  const int tid = TIDX;
  for (int gq = tid; gq < (N >> 4); gq += NT) {
    f32x2 x[16];
#pragma unroll
    for (int e = 0; e < 16; ++e) x[e] = W[17 * gq + e];
    fft16_dit_head(x);
#pragma unroll
    for (int e = 0; e < 16; ++e) W[17 * gq + e] = x[e];
  }
  __syncthreads();
  int s = 5;
  for (; s < logN - 1; s += 2) {
    const int half = 1 << s, quarter = half >> 1, hp = half + (half >> 4), qp = quarter + (quarter >> 4);
    const float inv = 1.0f / (float)(2 * half);
    for (int i = tid; i < (N >> 2); i += NT) {
      const int j = i & (quarter - 1), i0 = PH(((i >> (s - 1)) << (s + 1)) + j);
      const f32x2 c0 = W[i0], c1 = W[i0 + qp], c2 = W[i0 + hp], c3 = W[i0 + hp + qp];
      const float rev = (float)j * inv;
      const f32x2 w1 = {__builtin_amdgcn_cosf(rev), -__builtin_amdgcn_sinf(rev)};
      const f32x2 w2 = cmul(w1, w1);
      const f32x2 t = cmulc(c1, w2), tp = cmulc(c3, w2);
      const f32x2 b0 = c0 + t, b1 = c0 - t, b2 = c2 + tp, b3 = c2 - tp;
      const f32x2 u = cmulc(b2, w1), up = mul_pi(cmulc(b3, w1));
      W[i0] = b0 + u;
      W[i0 + hp] = b0 - u;
      W[i0 + qp] = b1 + up;
      W[i0 + hp + qp] = b1 - up;
    }
    __syncthreads();
  }
  {
    const int sl = logN - 1, half = 1 << sl, hp = half + (half >> 4);
    const float inv = 1.0f / (float)(2 * half);
    for (int i = tid; i < (N >> 1); i += NT) {
      const int j = i & (half - 1), base = PH(((i >> sl) << (sl + 1)) + j);
      const f32x2 a = W[base], b = W[base + hp];
      const float rev = (float)j * inv;
      const f32x2 w = {__builtin_amdgcn_cosf(rev), __builtin_amdgcn_sinf(rev)};
      const f32x2 t = cmul(b, w);
      W[base] = a + t;
      W[base + hp] = a - t;
    }
    __syncthreads();
  }
}

DI void kf_item(const P& p, int layer, int kind, int c, int o, unsigned char* smem) {
  const int tid = TIDX;
  const int L = kind ? 256 : 4096, N = 2 * L, logN = kind ? 9 : 13;
  f32x2* W = (f32x2*)smem;
  float* sW3 = (float*)(smem + 69632);
  const float* w3 = p.in[I_HW3] + (size_t)layer * 64 * 1024;
  if (tid < 128) { const int dir = tid >> 6, j = tid & 63; sW3[tid] = w3[(size_t)j * 1024 + o * 512 + dir * 256 + c]; }
  __syncthreads();
  const float* H2 = (const float*)(p.ws + O_H2) + h2_off(layer, kind);
  const float lo = -3.0701134573253942f, hi = -15.350567286626971f;
  const float delta = fabsf(lo + (float)c * ((hi - lo) / 255.0f));
  const float invN = 1.0f / (float)N;
  for (int n = tid; n < N; n += NT) {
    float val = 0.f;
    if (n != L) {
      const int dir = n > L, t = dir ? N - n : n;
      const float4* hr = (const float4*)(H2 + (size_t)t * 64);
      const float* wv = sW3 + dir * 64;
      float acc = 0.f;
#pragma unroll
      for (int q = 0; q < 16; ++q) { const float4 hv = hr[q]; acc += hv.x * wv[4 * q] + hv.y * wv[4 * q + 1] + hv.z * wv[4 * q + 2] + hv.w * wv[4 * q + 3]; }
      const float tl = (float)t / (float)(L - 1);
      val = acc * fast_exp(-tl * delta) * invN;
    }
    f32x2 v = {val, 0.f};
    W[PH(n)] = v;
  }
  __syncthreads();
  fft_dif(W, N, logN);
  f32x2* KF = kind ? (f32x2*)(p.ws + O_KF1) + (size_t)(c * 2 + o) * 512 : (f32x2*)(p.ws + O_KF0) + (size_t)(c * 2 + o) * 8192;
  for (int n = tid; n < N; n += NT) KF[n] = W[PH(n)];
  __syncthreads();
}
DI void phase_kf(const P& p, int layer, bool with_ctx, unsigned char* smem) {
  const int total = 512 + (with_ctx ? 512 : 0);
  for (int it = blockIdx.x; it < total; it += gridDim.x) {
    const int kind = it >= 512, q = it & 511;
    kf_item(p, layer, kind, q >> 1, q & 1, smem);
  }
}

DI void phase_rows(const P& p, int Mrows, int mode, int layer, int sub, float resw, bool from_input, bool has_next, int nl, int nj, bool zero_rowss) {
  const int tid = TIDX, lane = tid & 63, wave = tid >> 6;
  const float* MOD = (const float*)(p.ws + O_MOD);
  const bf16_t* F = (const bf16_t*)(p.ws + O_F);
  bf16_t* U = (bf16_t*)(p.ws + O_U);
  float* XC = (float*)(p.ws + O_XC);
  float* ROWSS = (float*)(p.ws + O_ROWSS);
  for (int row0 = (blockIdx.x * 4 + wave) * 2; row0 < Mrows; row0 += gridDim.x * 8) {
    if (mode == 2) { if (lane < 2) { ROWSS[row0 + lane] = 0.f; ROWSS[M_ALL + row0 + lane] = 0.f; } continue; }
    const float* xin[2]; float* X[2]; int midx[2];
#pragma unroll
    for (int rr = 0; rr < 2; ++rr) {
      const int row = row0 + rr;
      const bool lat = row < M_LAT;
      midx[rr] = lat ? (row >> 12) : 8;
      xin[rr] = lat ? p.in[I_X] + (size_t)row * 1024 : p.in[I_CTX] + (size_t)(row - M_LAT) * 1024;
      X[rr] = lat ? p.out + (size_t)row * 1024 : XC + (size_t)(row - M_LAT) * 1024;
    }
    float4 xv[2][4];
    if (mode == 0) {
#pragma unroll
      for (int rr = 0; rr < 2; ++rr)
#pragma unroll
        for (int c4 = 0; c4 < 4; ++c4) { const f32x4 t4 = __builtin_nontemporal_load((const f32x4*)(xin[rr] + c4 * 256 + lane * 4)); xv[rr][c4].x = t4.x; xv[rr][c4].y = t4.y; xv[rr][c4].z = t4.z; xv[rr][c4].w = t4.w; }
    } else {
      uint2 raw[2][4];
      float4 xold[2][4];
#pragma unroll
      for (int rr = 0; rr < 2; ++rr)
#pragma unroll
        for (int c4 = 0; c4 < 4; ++c4) {
          { typedef unsigned u32x2v __attribute__((ext_vector_type(2)));
            const u32x2v rw = __builtin_nontemporal_load((const u32x2v*)(F + (size_t)(row0 + rr) * 1024 + c4 * 256 + lane * 4));
            raw[rr][c4].x = rw.x; raw[rr][c4].y = rw.y;
            const f32x4 xo4 = __builtin_nontemporal_load((const f32x4*)((from_input ? xin[rr] : X[rr]) + c4 * 256 + lane * 4));
            xold[rr][c4].x = xo4.x; xold[rr][c4].y = xo4.y; xold[rr][c4].z = xo4.z; xold[rr][c4].w = xo4.w; }
        }
      const float* gp = p.in[I_NPOST] + ((size_t)layer * 3 + sub) * 1024;
#pragma unroll
      for (int rr = 0; rr < 2; ++rr) {
        const float* mod = MOD + ((size_t)layer * 9 + midx[rr]) * 9216 + (3 * sub + 2) * 1024;
        float4 fv[4];
        float ss = 0.f;
#pragma unroll
        for (int c4 = 0; c4 < 4; ++c4) {
          fv[c4].x = __uint_as_float(raw[rr][c4].x << 16); fv[c4].y = __uint_as_float(raw[rr][c4].x & 0xffff0000u);
          fv[c4].z = __uint_as_float(raw[rr][c4].y << 16); fv[c4].w = __uint_as_float(raw[rr][c4].y & 0xffff0000u);
          ss += fv[c4].x * fv[c4].x + fv[c4].y * fv[c4].y + fv[c4].z * fv[c4].z + fv[c4].w * fv[c4].w;
        }
        ss = wave_sum(ss);
        const float rstd = rsqrtf(ss * (1.0f / 1024.0f) + EPS);
#pragma unroll
        for (int c4 = 0; c4 < 4; ++c4) {
          const int col = c4 * 256 + lane * 4;
          const float4 g = *(const float4*)(gp + col);
          const float4 mg = *(const float4*)(mod + col);
          xv[rr][c4].x = xold[rr][c4].x + resw * mg.x * (fv[c4].x * rstd * g.x);
          xv[rr][c4].y = xold[rr][c4].y + resw * mg.y * (fv[c4].y * rstd * g.y);
          xv[rr][c4].z = xold[rr][c4].z + resw * mg.z * (fv[c4].z * rstd * g.z);
          xv[rr][c4].w = xold[rr][c4].w + resw * mg.w * (fv[c4].w * rstd * g.w);
          { f32x4 st4 = {xv[rr][c4].x, xv[rr][c4].y, xv[rr][c4].z, xv[rr][c4].w}; __builtin_nontemporal_store(st4, (f32x4*)(X[rr] + col)); }
        }
      }
    }
    if (has_next) {
      const float* gpre = p.in[I_NPRE] + ((size_t)nl * 3 + nj) * 1024;
#pragma unroll
      for (int rr = 0; rr < 2; ++rr) {
        float ss = 0.f;
#pragma unroll
        for (int c4 = 0; c4 < 4; ++c4) ss += xv[rr][c4].x * xv[rr][c4].x + xv[rr][c4].y * xv[rr][c4].y + xv[rr][c4].z * xv[rr][c4].z + xv[rr][c4].w * xv[rr][c4].w;
        ss = wave_sum(ss);
        const float rstd = rsqrtf(ss * (1.0f / 1024.0f) + EPS);
        const float* modn = MOD + ((size_t)nl * 9 + midx[rr]) * 9216;
#pragma unroll
        for (int c4 = 0; c4 < 4; ++c4) {
          const int col = c4 * 256 + lane * 4;
          const float4 g = *(const float4*)(gpre + col);
          const float4 sc = *(const float4*)(modn + (3 * nj + 1) * 1024 + col);
          const float4 sh = *(const float4*)(modn + (3 * nj) * 1024 + col);
          const float u0 = xv[rr][c4].x * rstd * g.x * (1.f + sc.x) + sh.x;
          const float u1 = xv[rr][c4].y * rstd * g.y * (1.f + sc.y) + sh.y;
          const float u2 = xv[rr][c4].z * rstd * g.z * (1.f + sc.z) + sh.z;
          const float u3 = xv[rr][c4].w * rstd * g.w * (1.f + sc.w) + sh.w;
          uint2 o; o.x = pk2(u0, u1); o.y = pk2(u2, u3);
          *(uint2*)(U + (size_t)(row0 + rr) * 1024 + col) = o;
        }
      }
    }
    if (zero_rowss && lane < 2) { ROWSS[row0 + lane] = 0.f; ROWSS[M_ALL + row0 + lane] = 0.f; }
  }
}

#define EPI_COORDS                                                                                      \
  const int tid = TIDX, lane = tid & 63, wave = tid >> 6, r = lane & 31, h = lane >> 5, wm = wave >> 1, wn = wave & 1; \
  (void)tid; (void)lane; (void)wave; (void)r; (void)h; (void)wm; (void)wn;

DI void phase_ffn_up(const P& p, int Mrows, size_t off_w, unsigned char* smem) {
  const bf16_t* U = (const bf16_t*)(p.ws + O_U);
  const bf16_t* W = (const bf16_t*)(p.ws + off_w);
  bf16_t* ACT = (bf16_t*)(p.ws + O_ACT);
  for_tiles<256>(Mrows >> 7, 22, [&](int m0, int n0, int tn) __attribute__((always_inline)) {
    f32x16 acc[2][4];
    zero_acc<4>(acc);
    gemm_kloop_wide(acc, U, 1024, W, 1024, 1024, m0, n0, smem);
    EPI_COORDS
#pragma unroll
    for (int j = 0; j < 2; ++j) {
      const int col = tn * 128 + wn * 64 + j * 32 + r;
#pragma unroll
      for (int mi = 0; mi < 2; ++mi)
#pragma unroll
        for (int i = 0; i < 16; ++i) {
          const int row = m0 + wm * 64 + mi * 32 + crow(i, h);
          const float a = acc[mi][2 * j][i], b = acc[mi][2 * j + 1][i];
          ACT[(size_t)row * DFF + col] = f2bf(siluf_(a) * b);
        }
    }
  });
}
DI void phase_gemm_plain_bf16(const P& p, int Mrows, const bf16_t* A, int K, const bf16_t* W, bf16_t* OUT, int N, unsigned char* smem) {
  (void)p;
  const int Mwide = Mrows < M_LAT ? Mrows : M_LAT;
  for_tiles<256>(Mwide >> 7, N >> 8, [&](int m0, int n0, int tn) __attribute__((always_inline)) {
    (void)tn;
    f32x16 acc[2][4];
    zero_acc<4>(acc);
    gemm_kloop_wide(acc, A, K, W, K, K, m0, n0, smem);
    EPI_COORDS
#pragma unroll
    for (int mi = 0; mi < 2; ++mi)
#pragma unroll
      for (int ni = 0; ni < 4; ++ni)
#pragma unroll
        for (int i = 0; i < 16; ++i) {
          const int row = m0 + wm * 64 + mi * 32 + crow(i, h), col = n0 + wn * 128 + ni * 32 + r;
          OUT[(size_t)row * N + col] = f2bf(acc[mi][ni][i]);
        }
  });
  if (Mrows > Mwide) {
    for_tiles<64>((Mrows - Mwide) >> 7, N >> 6, [&](int m0, int n0, int tn) __attribute__((always_inline)) {
      (void)tn;
      f32x16 acc[2][1];
      zero_acc<1>(acc);
      gemm_kloop<1>(acc, A, K, W, K, K, m0, n0, smem);
      EPI_COORDS
#pragma unroll
      for (int mi = 0; mi < 2; ++mi)
#pragma unroll
        for (int i = 0; i < 16; ++i) {
          const int row = m0 + wm * 64 + mi * 32 + crow(i, h), col = n0 + wn * 32 + r;
          OUT[(size_t)row * N + col] = f2bf(acc[mi][0][i]);
        }
    }, Mwide);
  }
}

DI void win_epilogue(const P& p, int m0, int tn, int wn, f32x16 (&acc)[2][2]) {
  unsigned char* ws = p.ws;
  bf16_t* HYT = (bf16_t*)(ws + O_HYT);
  float* S5U = (float*)(ws + O_S5U);
  bf16_t* QSWA = (bf16_t*)(ws + O_QSWA);
  bf16_t* KSWA = (bf16_t*)(ws + O_KSWA);
  bf16_t* VSWAT = (bf16_t*)(ws + O_VSWAT);
  bf16_t* CKV = (bf16_t*)(ws + O_CKV);
  bf16_t* CQ = (bf16_t*)(ws + O_CQ);
  bf16_t* KMLA = (bf16_t*)(ws + O_KMLA);
  float* ROWSS = (float*)(ws + O_ROWSS);
  const f32x2* RM = (const f32x2*)(ws + O_ROPEM);
  const f32x2* RW = (const f32x2*)(ws + O_ROPEW);
  const float qscale = 0.125f * LOG2E;
  const int tid = TIDX, lane = tid & 63, wave = tid >> 6, r = lane & 31, h = lane >> 5, wm = wave >> 1;
    const RowInfo t0 = row_info(m0);
  if (tn < 6) {
    bf16_t* base = HYT + (t0.lat ? (size_t)t0.b * 768 * 4096 : HYT_LATSZ + (size_t)t0.b * 768 * 256);
#pragma unroll
    for (int mi = 0; mi < 2; ++mi)
#pragma unroll
      for (int ni = 0; ni < 2; ++ni) {
        const int ch = tn * 128 + wn * 64 + ni * 32 + r;
#pragma unroll
        for (int g = 0; g < 4; ++g) {
          const int pos = t0.pos + wm * 64 + mi * 32 + 8 * g + 4 * h;
          uint2 o; o.x = pk2(acc[mi][ni][4 * g], acc[mi][ni][4 * g + 1]); o.y = pk2(acc[mi][ni][4 * g + 2], acc[mi][ni][4 * g + 3]);
          *(uint2*)(base + (size_t)ch * t0.L + pos) = o;
        }
      }
  } else if (tn < 8) {
#pragma unroll
    for (int mi = 0; mi < 2; ++mi)
#pragma unroll
      for (int ni = 0; ni < 2; ++ni)
#pragma unroll
        for (int i = 0; i < 16; ++i) {
          const int row = m0 + wm * 64 + mi * 32 + crow(i, h), col = (tn - 6) * 128 + wn * 64 + ni * 32 + r;
          S5U[(size_t)row * 256 + col] = acc[mi][ni][i];
        }
  } else if (tn < 11) {
#pragma unroll
    for (int mi = 0; mi < 2; ++mi)
#pragma unroll
      for (int i = 0; i < 16; ++i) {
        const int lr = wm * 64 + mi * 32 + crow(i, h);
        const int row = m0 + lr, pos = t0.pos + lr;
        float x1 = acc[mi][0][i], x2 = acc[mi][1][i];
        if (t0.lat) {
          const f32x2 cs = RW[pos * 32 + r];
          const float y1 = x1 * cs.x - x2 * cs.y, y2 = x1 * cs.y + x2 * cs.x;
          x1 = y1; x2 = y2;
        }
        if (tn < 10) {
          const int head = (tn - 8) * 2 + wn;
          bf16_t* q = QSWA + ((size_t)row * 4 + head) * 64;
          q[r] = f2bf(x1 * qscale); q[r + 32] = f2bf(x2 * qscale);
        } else {
          bf16_t* k = KSWA + (((size_t)t0.b * 2 + wn) * KEYS + (t0.kpos + lr)) * 64;
          k[r] = f2bf(x1); k[r + 32] = f2bf(x2);
        }
      }
  } else if (tn == 11) {
#pragma unroll
    for (int mi = 0; mi < 2; ++mi)
#pragma unroll
      for (int ni = 0; ni < 2; ++ni) {
        const int dv = ni * 32 + r;
#pragma unroll
        for (int g = 0; g < 4; ++g) {
          const int kp = t0.kpos + wm * 64 + mi * 32 + 8 * g + 4 * h;
          uint2 o; o.x = pk2(acc[mi][ni][4 * g], acc[mi][ni][4 * g + 1]); o.y = pk2(acc[mi][ni][4 * g + 2], acc[mi][ni][4 * g + 3]);
          *(uint2*)(VSWAT + (((size_t)t0.b * 2 + wn) * 64 + dv) * KEYS + kp) = o;
        }
      }
  } else {
    const bool is_kv = tn == 12;
    const bool rope_wave = (tn == 14) && (wn == 1);
    if (!rope_wave) {
      bf16_t* dst = is_kv ? CKV : CQ;
      const int ld = is_kv ? 128 : 192;
      const int cbase = (tn == 14 ? 128 : 0) + wn * 64;
      float* rs = ROWSS + (is_kv ? 0 : M_ALL);
#pragma unroll
      for (int mi = 0; mi < 2; ++mi)
#pragma unroll
        for (int i = 0; i < 16; ++i) {
          const int row = m0 + wm * 64 + mi * 32 + crow(i, h);
          const float v0 = acc[mi][0][i], v1 = acc[mi][1][i];
          dst[(size_t)row * ld + cbase + r] = f2bf(v0);
          dst[(size_t)row * ld + cbase + 32 + r] = f2bf(v1);
          float s = v0 * v0 + v1 * v1;
#pragma unroll
          for (int o = 16; o; o >>= 1) s += __shfl_xor(s, o);
          if (r == 0) atomicAdd(rs + row, s);
        }
    } else {
#pragma unroll
      for (int mi = 0; mi < 2; ++mi)
#pragma unroll
        for (int i = 0; i < 16; ++i) {
          const int lr = wm * 64 + mi * 32 + crow(i, h);
          const int pos = t0.pos + lr;
          const float x = acc[mi][0][i];
          const float partner = __shfl_xor(x, 16);
          float y = x;
          if (t0.lat) {
            const f32x2 cs = RM[pos * 16 + (r & 15)];
            y = (r < 16) ? (x * cs.x - partner * cs.y) : (partner * cs.y + x * cs.x);
          }
          const bf16_t yb = f2bf(y);
#pragma unroll
          for (int hd = 0; hd < 4; ++hd) KMLA[(((size_t)t0.b * 4 + hd) * KEYS + (t0.kpos + lr)) * 96 + 64 + r] = yb;
        }
    }
  }
}
DI void phase_win(const P& p, int Mrows, unsigned char* smem) {
  const bf16_t* U = (const bf16_t*)(p.ws + O_U);
  const bf16_t* W = (const bf16_t*)(p.ws + O_WIN);
  const int Mwide = Mrows < M_LAT ? Mrows : M_LAT;
  for_tiles<256>(Mwide >> 7, 8, [&](int m0, int n0, int tn) __attribute__((always_inline)) {
    (void)n0;
    f32x16 acc[2][4];
    zero_acc<4>(acc);
    gemm_kloop_wide(acc, U, 1024, W, 1024, 1024, m0, n0, smem);
    const int wn = (TIDX >> 6) & 1, go = tn * 2 + wn;
    if (go < 15) {
#pragma unroll
      for (int half = 0; half < 2; ++half) {
        f32x16 t4[2][2];
        t4[0][0] = acc[0][2 * half]; t4[0][1] = acc[0][2 * half + 1]; t4[1][0] = acc[1][2 * half]; t4[1][1] = acc[1][2 * half + 1];
        win_epilogue(p, m0, go, half, t4);
      }
    }
  });
  if (Mrows > Mwide) {
    for_tiles((Mrows - Mwide) >> 7, 15, [&](int m0, int n0, int tn) __attribute__((always_inline)) {
      f32x16 acc[2][2];
      zero_acc<2>(acc);
      gemm_kloop<2>(acc, U, 1024, W, 1024, 1024, m0, n0, smem);
      win_epilogue(p, m0, tn, (TIDX >> 6) & 1, acc);
    }, Mwide);
  }
}

DI void phase_kvq(const P& p, int Mkv, int Mq, unsigned char* smem) {
  unsigned char* ws = p.ws;
  const bf16_t* CKV = (const bf16_t*)(ws + O_CKV);
  const bf16_t* CQ = (const bf16_t*)(ws + O_CQ);
  const bf16_t* WUKV = (const bf16_t*)(ws + O_WUKV);
  const bf16_t* WUQ = (const bf16_t*)(ws + O_WUQ);
  bf16_t* KMLA = (bf16_t*)(ws + O_KMLA);
  bf16_t* VMLAT = (bf16_t*)(ws + O_VMLAT);
  bf16_t* QMLA = (bf16_t*)(ws + O_QMLA);
  const float* ROWSS = (const float*)(ws + O_ROWSS);
  const f32x2* RM = (const f32x2*)(ws + O_ROPEM);
  const float qscale = 0.10206207261596577f * LOG2E;
  for_tiles(Mkv >> 7, 4, [&](int m0, int n0, int tn) __attribute__((always_inline)) {
    f32x16 acc[2][2];
    zero_acc<2>(acc);
    gemm_kloop<2>(acc, CKV, 128, WUKV, 128, 128, m0, n0, smem);
    EPI_COORDS
    const RowInfo t0 = row_info(m0);
#pragma unroll
    for (int mi = 0; mi < 2; ++mi) {
      float rstd[16];
#pragma unroll
      for (int i = 0; i < 16; ++i) rstd[i] = rsqrtf(ROWSS[m0 + wm * 64 + mi * 32 + crow(i, h)] * (1.0f / 128.0f) + EPS);
      if (wn == 0) {
#pragma unroll
        for (int ni = 0; ni < 2; ++ni)
#pragma unroll
          for (int i = 0; i < 16; ++i) {
            const int lr = wm * 64 + mi * 32 + crow(i, h);
            KMLA[(((size_t)t0.b * 4 + tn) * KEYS + (t0.kpos + lr)) * 96 + ni * 32 + r] = f2bf(acc[mi][ni][i] * rstd[i]);
          }
      } else {
#pragma unroll
        for (int ni = 0; ni < 2; ++ni) {
          const int dv = ni * 32 + r;
#pragma unroll
          for (int g = 0; g < 4; ++g) {
            const int kp = t0.kpos + wm * 64 + mi * 32 + 8 * g + 4 * h;
            uint2 o;
            o.x = pk2(acc[mi][ni][4 * g] * rstd[4 * g], acc[mi][ni][4 * g + 1] * rstd[4 * g + 1]);
            o.y = pk2(acc[mi][ni][4 * g + 2] * rstd[4 * g + 2], acc[mi][ni][4 * g + 3] * rstd[4 * g + 3]);
            *(uint2*)(VMLAT + (((size_t)t0.b * 4 + tn) * 64 + dv) * KEYS + kp) = o;
          }
        }
      }
    }
  });
  for_tiles(Mq >> 7, 3, [&](int m0, int n0, int tn) __attribute__((always_inline)) {
    f32x16 acc[2][2];
    zero_acc<2>(acc);
    gemm_kloop<2>(acc, CQ, 192, WUQ, 192, 192, m0, n0, smem);
    EPI_COORDS
    (void)tn;
    const RowInfo t0 = row_info(m0);
#pragma unroll
    for (int mi = 0; mi < 2; ++mi)
#pragma unroll
      for (int ni = 0; ni < 2; ++ni) {
        const int cb = n0 + wn * 64 + ni * 32;
        const int head = cb / 96, d0 = cb - head * 96;
#pragma unroll
        for (int i = 0; i < 16; ++i) {
          const int lr = wm * 64 + mi * 32 + crow(i, h);
          const int row = m0 + lr;
          const float rstd = rsqrtf(ROWSS[M_ALL + row] * (1.0f / 192.0f) + EPS);
          float v = acc[mi][ni][i] * rstd;
          if (d0 == 64) {
            const float partner = __shfl_xor(v, 16);
            if (t0.lat) {
              const f32x2 cs = RM[(t0.pos + lr) * 16 + (r & 15)];
              v = (r < 16) ? (v * cs.x - partner * cs.y) : (partner * cs.y + v * cs.x);
            }
          }
          QMLA[((size_t)row * 4 + head) * 96 + d0 + r] = f2bf(v * qscale);
        }
      }
  });
}

template <int NI>
DI void merge_tile(const P& p, int layer, int m0, int n0, unsigned char* smem) {
  unsigned char* ws = p.ws;
  const bf16_t* U = (const bf16_t*)(ws + O_U);
  const bf16_t* O4 = (const bf16_t*)(ws + O_O4);
  const bf16_t* WG = (const bf16_t*)(ws + O_WGATE);
  const bf16_t* WB = (const bf16_t*)(ws + O_WBR);
  bf16_t* MB = (bf16_t*)(ws + O_MBUF);
  const float* bg = p.in[I_BGATE] + (size_t)layer * 4 * 1024;
  EPI_COORDS
  f32x16 macc[2][NI];
  zero_acc<NI>(macc);
#pragma unroll 1
  for (int br = 0; br < 4; ++br) {
    f32x16 acc[2][NI];
    zero_acc<NI>(acc);
    gemm_kloop<NI>(acc, O4 + (size_t)br * M_ALL * 256, 256, WB + (size_t)br * 1024 * 256, 256, 256, m0, n0, smem);
    unsigned po[2][NI][8];
#pragma unroll
    for (int mi = 0; mi < 2; ++mi)
#pragma unroll
      for (int ni = 0; ni < NI; ++ni)
#pragma unroll
        for (int q = 0; q < 8; ++q) po[mi][ni][q] = pk2(acc[mi][ni][2 * q], acc[mi][ni][2 * q + 1]);
    zero_acc<NI>(acc);
    gemm_kloop<NI>(acc, U, 1024, WG + (size_t)br * 1024 * 1024, 1024, 1024, m0, n0, smem);
#pragma unroll
    for (int ni = 0; ni < NI; ++ni) {
      const float bias = bg[br * 1024 + n0 + wn * 32 * NI + ni * 32 + r];
#pragma unroll
      for (int mi = 0; mi < 2; ++mi)
#pragma unroll
        for (int q = 0; q < 8; ++q) {
          const float o0 = __uint_as_float(po[mi][ni][q] << 16), o1 = __uint_as_float(po[mi][ni][q] & 0xffff0000u);
          macc[mi][ni][2 * q] += sigmoidf_(acc[mi][ni][2 * q] + bias) * o0;
          macc[mi][ni][2 * q + 1] += sigmoidf_(acc[mi][ni][2 * q + 1] + bias) * o1;
        }
    }
  }
#pragma unroll
  for (int mi = 0; mi < 2; ++mi)
#pragma unroll
    for (int ni = 0; ni < NI; ++ni)
#pragma unroll
      for (int i = 0; i < 16; ++i) {
        const int row = m0 + wm * 64 + mi * 32 + crow(i, h), col = n0 + wn * 32 * NI + ni * 32 + r;
        MB[(size_t)row * 1024 + col] = f2bf(macc[mi][ni][i]);
      }
}
DI void phase_merge(const P& p, int layer, int Mrows, unsigned char* smem) {
  for_tiles(Mrows >> 7, 8, [&](int m0, int n0, int tn) __attribute__((always_inline)) { (void)tn; merge_tile<2>(p, layer, m0, n0, smem); });
}

DI float gelu_tanh(float x) {
  const float z = 0.7978845608028654f * (x + 0.044715f * x * x * x);
  const float e = fast_exp(2.f * z);
  const float th = 1.f - 2.f * __builtin_amdgcn_rcpf(e + 1.f);
  return 0.5f * x * (1.f + th);
}
DI void phase_glu(const P& p, int layer, int Mrows, unsigned char* smem) {
  unsigned char* ws = p.ws;
  const bf16_t* Y = (const bf16_t*)(ws + O_Y);
  const float* S5U = (const float*)(ws + O_S5U);
  const bf16_t* WGLU = (const bf16_t*)(ws + O_WGLU);
  bf16_t* O3 = (bf16_t*)(ws + O_O4) + (size_t)3 * M_ALL * 256;
  const float* Dv = p.in[I_S5D] + (size_t)layer * 256;
  const float* gb = p.in[I_GLUB] + (size_t)layer * 256;
  bf16_t* sG = (bf16_t*)smem;
  const int tid = TIDX, lane = tid & 63, wave = tid >> 6, r = lane & 31, h = lane >> 5;
  for (int t = blockIdx.x; t < (Mrows >> 6); t += gridDim.x) {
    const int m0 = t * 64;
    for (int e = tid; e < 64 * 64; e += NT) {
      const int rr = e >> 6, c4 = (e & 63) * 4;
      const size_t gi = (size_t)(m0 + rr) * 256 + c4;
      typedef unsigned u32x2g __attribute__((ext_vector_type(2)));
      const u32x2g y0 = __builtin_nontemporal_load((const u32x2g*)(Y + gi)), y1 = __builtin_nontemporal_load((const u32x2g*)(Y + (size_t)M_ALL * 256 + gi));
      const f32x4 u = __builtin_nontemporal_load((const f32x4*)(S5U + gi));
      const float4 dd = *(const float4*)(Dv + c4);
      const float a0 = __uint_as_float(y0.x << 16) + __uint_as_float(y1.x << 16) + u.x * dd.x;
      const float a1 = __uint_as_float(y0.x & 0xffff0000u) + __uint_as_float(y1.x & 0xffff0000u) + u.y * dd.y;
      const float a2 = __uint_as_float(y0.y << 16) + __uint_as_float(y1.y << 16) + u.z * dd.z;
      const float a3 = __uint_as_float(y0.y & 0xffff0000u) + __uint_as_float(y1.y & 0xffff0000u) + u.w * dd.w;
      uint2 o; o.x = pk2(gelu_tanh(a0), gelu_tanh(a1)); o.y = pk2(gelu_tanh(a2), gelu_tanh(a3));
      *(uint2*)(sG + rr * 264 + c4) = o;
    }
    __syncthreads();
    f32x16 acc[2][2];
    zero_acc<2>(acc);
#pragma unroll 4
    for (int kk = 0; kk < 16; ++kk) {
      const bf16x8 a0 = *(const bf16x8*)(sG + r * 264 + kk * 16 + 8 * h), a1 = *(const bf16x8*)(sG + (32 + r) * 264 + kk * 16 + 8 * h);
      const bf16x8 b0 = *(const bf16x8*)(WGLU + (size_t)(wave * 64 + r) * 256 + kk * 16 + 8 * h);
      const bf16x8 b1 = *(const bf16x8*)(WGLU + (size_t)(wave * 64 + 32 + r) * 256 + kk * 16 + 8 * h);
      acc[0][0] = MFMA32(a0, b0, acc[0][0]);
      acc[0][1] = MFMA32(a0, b1, acc[0][1]);
      acc[1][0] = MFMA32(a1, b0, acc[1][0]);
      acc[1][1] = MFMA32(a1, b1, acc[1][1]);
    }
#pragma unroll
    for (int mi = 0; mi < 2; ++mi)
#pragma unroll
      for (int ni = 0; ni < 2; ++ni) {
        const int col = wave * 64 + ni * 32 + r;
        const float bias = gb[col];
#pragma unroll
        for (int i = 0; i < 16; ++i) {
          const int lr = mi * 32 + crow(i, h);
          const float g = bf2f(sG[lr * 264 + col]);
          O3[(size_t)(m0 + lr) * 256 + col] = f2bf(g * sigmoidf_(acc[mi][ni][i] + bias));
        }
      }
    __syncthreads();
  }
}

DI f32x2 cmulf(f32x2 a, f32x2 b) { f32x2 r = {a.x * b.x - a.y * b.y, a.x * b.y + a.y * b.x}; return r; }
DI void s5_item(const P& p, int layer, int combo, unsigned char* smem) {
  unsigned char* ws = p.ws;
  const int tid = TIDX, lane = tid & 63, wave = tid >> 6;
  const int d = combo & 1, g = (combo >> 1) & 15, b = combo >> 5;
  f32x2* sX = (f32x2*)(smem + wave * 8448);
  bf16_t* sH = (bf16_t*)(smem + 4 * 8448) + wave * (16 * 136);
  f32x2* sE = (f32x2*)(smem + 4 * 8448 + 4 * 16 * 136 * 2);
  const float* S5U = (const float*)(ws + O_S5U);
  bf16_t* Y = (bf16_t*)(ws + O_Y) + (size_t)d * M_ALL * 256;
  const int pbase = ((layer * 2 + d) * 16 + g) * 64;
  const int col = lane & 15, q = lane >> 4;
  f32x2 ab, ff;
  {
    const float a_re = p.in[I_ARE][pbase + lane], a_im = p.in[I_AIM][pbase + lane];
    const float dt = fast_exp(p.in[I_LOGDT][(layer * 2 + d) * 16 + g]);
    const float mag = fast_exp(dt * a_re);
    float sn, cs; sincos_d((double)(dt * a_im), sn, cs);
    ab.x = mag * cs; ab.y = mag * sn;
    const float den = a_re * a_re + a_im * a_im;
    ff.x = ((ab.x - 1.f) * a_re + ab.y * a_im) / den;
    ff.y = (ab.y * a_re - (ab.x - 1.f) * a_im) / den;
  }
  bf16x8 fA[8];
#pragma unroll
  for (int blk = 0; blk < 8; ++blk) {
    const int ps = 8 * blk + (col >> 1), im = col & 1;
    const float fx = __shfl(ff.x, ps), fy = __shfl(ff.y, ps);
    const float* bre = p.in[I_BRE] + (size_t)(pbase + ps) * 16 + 8 * (q & 1);
    const float* bim = p.in[I_BIM] + (size_t)(pbase + ps) * 16 + 8 * (q & 1);
#pragma unroll
    for (int j = 0; j < 8; j += 2) {
      const float br0 = bre[j], bi0 = bim[j], br1 = bre[j + 1], bi1 = bim[j + 1];
      float v0 = im ? (fx * bi0 + fy * br0) : (fx * br0 - fy * bi0);
      float v1 = im ? (fx * bi1 + fy * br1) : (fx * br1 - fy * bi1);
      if (q >= 2) { v0 = 0.f; v1 = 0.f; }
      const unsigned w = pk2(v0, v1);
      fA[blk][j] = (short)(w & 0xffffu); fA[blk][j + 1] = (short)(w >> 16);
    }
  }
  bf16x8 cB[4];
  {
    const float* cre = p.in[I_CRE] + ((size_t)((layer * 2 + d) * 16 + g) * 16 + col) * 64;
    const float* cim = p.in[I_CIM] + ((size_t)((layer * 2 + d) * 16 + g) * 16 + col) * 64;
#pragma unroll
    for (int ks = 0; ks < 4; ++ks)
#pragma unroll
      for (int j = 0; j < 8; j += 2) {
        const int pp = (32 * ks + 8 * q + j) >> 1;
        const unsigned w = pk2(cre[pp], -cim[pp]);
        cB[ks][j] = (short)(w & 0xffffu); cB[ks][j + 1] = (short)(w >> 16);
      }
  }
  f32x2 apow;
  {
    f32x2 a2 = ab;
#pragma unroll
    for (int i = 0; i < 6; ++i) a2 = cmulf(a2, a2);
    f32x2 a3 = a2;
#pragma unroll
    for (int i = 0; i < 4; ++i) a3 = cmulf(a3, a3);
    apow = cmulf(a2, a3);
  }
  f32x2 hst = {0.f, 0.f};
#pragma unroll 1
  for (int pass = 0; pass < 2; ++pass) {
    for (int gj = 0; gj < 68; ++gj) {
      const int grp = wave * 68 + gj;
      const bool isctx = grp < 16;
      const int gi = isctx ? grp : grp - 16, L = isctx ? 256 : 4096;
      const int rowbase = isctx ? M_LAT + b * 256 : b * 4096;
      bf16x8 ub;
      {
        const int n = gi * 16 + col, t = d ? L - 1 - n : n;
        const float* up = S5U + (size_t)(rowbase + t) * 256 + g * 16 + 8 * (q & 1);
        const float4 u0 = *(const float4*)up, u1 = *(const float4*)(up + 4);
        unsigned w0 = pk2(u0.x, u0.y), w1 = pk2(u0.z, u0.w), w2 = pk2(u1.x, u1.y), w3 = pk2(u1.z, u1.w);
        if (q >= 2) { w0 = 0u; w1 = 0u; w2 = 0u; w3 = 0u; }
        ub[0] = (short)(w0 & 0xffffu); ub[1] = (short)(w0 >> 16); ub[2] = (short)(w1 & 0xffffu); ub[3] = (short)(w1 >> 16);
        ub[4] = (short)(w2 & 0xffffu); ub[5] = (short)(w2 >> 16); ub[6] = (short)(w3 & 0xffffu); ub[7] = (short)(w3 >> 16);
      }
#pragma unroll
      for (int blk = 0; blk < 8; ++blk) {
        f32x4 xz = {0.f, 0.f, 0.f, 0.f};
        xz = MFMA16(fA[blk], ub, xz);
        *(f32x4*)(sX + col * 66 + 8 * blk + 2 * q) = xz;
      }
      __syncthreads();
#pragma unroll 4
      for (int tt = 0; tt < 16; ++tt) {
        const f32x2 x = sX[tt * 66 + lane];
        f32x2 hn;
        hn.x = ab.x * hst.x - ab.y * hst.y + x.x;
        hn.y = ab.x * hst.y + ab.y * hst.x + x.y;
        hst = hn;
        if (pass) *(unsigned*)(sH + tt * 136 + 2 * lane) = pk2(hst.x, hst.y);
      }
      __syncthreads();
      if (pass) {
        f32x4 acc = {0.f, 0.f, 0.f, 0.f};
#pragma unroll
        for (int ks = 0; ks < 4; ++ks) {
          const bf16x8 a = *(const bf16x8*)(sH + (lane & 15) * 136 + ks * 32 + 8 * q);
          acc = MFMA16(a, cB[ks], acc);
        }
#pragma unroll
        for (int i = 0; i < 4; ++i) {
          const int tt = q * 4 + i, n = gi * 16 + tt, t = d ? L - 1 - n : n;
          Y[(size_t)(rowbase + t) * 256 + g * 16 + col] = f2bf(acc[i]);
        }
      }
    }
    if (pass == 0) {
      sE[wave * 64 + lane] = hst;
      __syncthreads();
      f32x2 st = {0.f, 0.f};
      for (int w = 0; w < wave; ++w) st = cmulf(apow, st) + sE[w * 64 + lane];
      hst = st;
      __syncthreads();
    }
  }
  __syncthreads();
}

DI float hy_in(const bf16_t* chp, int L, int t, float w0, float w1, float w2, float cb) {
  const float x0 = t > 0 ? bf2f(chp[t - 1]) : 0.f, x1 = bf2f(chp[t]), x2 = (t + 1 < L) ? bf2f(chp[t + 1]) : 0.f;
  return cb + w0 * x0 + w1 * x1 + w2 * x2;
}
DI void hyena_item(const P& p, int layer, int kind, int c, int bp, unsigned char* smem) {
  unsigned char* ws = p.ws;
  const int tid = TIDX;
  const int L = kind ? 256 : 4096, N = 2 * L, logN = kind ? 9 : 13;
  f32x2* W = (f32x2*)smem;
  const bf16_t* HYT = (const bf16_t*)(ws + O_HYT);
  const bf16_t* s0 = HYT + (kind ? HYT_LATSZ + (size_t)(2 * bp) * 768 * 256 : (size_t)(2 * bp) * 768 * 4096);
  const bf16_t* s1 = s0 + (size_t)768 * L;
  const int row0 = kind ? M_LAT + (2 * bp) * 256 : (2 * bp) * 4096;
  const int row1 = row0 + L;
  const float* cw = p.in[I_HCW] + (size_t)layer * 3 * 768;
  const float* cbv = p.in[I_HCB] + (size_t)layer * 768;
  const float bias1 = p.in[I_HBIAS][(layer * 2 + 0) * 256 + c], bias2 = p.in[I_HBIAS][(layer * 2 + 1) * 256 + c];
  const f32x2* KFa = kind ? (const f32x2*)(ws + O_KF1) + (size_t)(c * 2) * 512 : (const f32x2*)(ws + O_KF0) + (size_t)(c * 2) * 8192;
  const f32x2* KFb = KFa + N;
  bf16_t* OUT = (bf16_t*)(ws + O_O4) + (size_t)1 * M_ALL * 256;
  f32x2 zr[16];
  {
    const int ch = c;
    const float w0 = cw[ch], w1 = cw[768 + ch], w2 = cw[1536 + ch], cb = cbv[ch];
#pragma unroll
    for (int i = 0; i < 16; ++i) {
      const int t = tid + 256 * i;
      if (t < L) {
        f32x2 v = {hy_in(s0 + (size_t)ch * L, L, t, w0, w1, w2, cb), hy_in(s1 + (size_t)ch * L, L, t, w0, w1, w2, cb)};
        zr[i] = v; W[PH(t)] = v;
        f32x2 zz = {0.f, 0.f};
        W[PH(t + L)] = zz;
      }
    }
  }
  __syncthreads();
  fft_dif(W, N, logN);
  for (int n = tid; n < N; n += NT) W[PH(n)] = cmul(W[PH(n)], KFa[n]);
  __syncthreads();
  fft_dit_inv(W, N, logN);
  {
    const int ch = 256 + c;
    const float w0 = cw[ch], w1 = cw[768 + ch], w2 = cw[1536 + ch], cb = cbv[ch];
#pragma unroll
    for (int i = 0; i < 16; ++i) {
      const int t = tid + 256 * i;
      if (t < L) {
        const f32x2 y = W[PH(t)];
        const float g0 = hy_in(s0 + (size_t)ch * L, L, t, w0, w1, w2, cb), g1 = hy_in(s1 + (size_t)ch * L, L, t, w0, w1, w2, cb);
        zr[i].x = g0 * (y.x + bias1 * zr[i].x);
        zr[i].y = g1 * (y.y + bias1 * zr[i].y);
      }
    }
  }
  __syncthreads();
#pragma unroll
  for (int i = 0; i < 16; ++i) {
    const int t = tid + 256 * i;
    if (t < L) { W[PH(t)] = zr[i]; f32x2 zz = {0.f, 0.f}; W[PH(t + L)] = zz; }
  }
  __syncthreads();
  fft_dif(W, N, logN);
  for (int n = tid; n < N; n += NT) W[PH(n)] = cmul(W[PH(n)], KFb[n]);
  __syncthreads();
  fft_dit_inv(W, N, logN);
  {
    const int ch = 512 + c;
    const float w0 = cw[ch], w1 = cw[768 + ch], w2 = cw[1536 + ch], cb = cbv[ch];
#pragma unroll
    for (int i = 0; i < 16; ++i) {
      const int t = tid + 256 * i;
      if (t < L) {
        const f32x2 y = W[PH(t)];
        const float g0 = hy_in(s0 + (size_t)ch * L, L, t, w0, w1, w2, cb), g1 = hy_in(s1 + (size_t)ch * L, L, t, w0, w1, w2, cb);
        OUT[(size_t)(row0 + t) * 256 + c] = f2bf(g0 * (y.x + bias2 * zr[i].x));
        OUT[(size_t)(row1 + t) * 256 + c] = f2bf(g1 * (y.y + bias2 * zr[i].y));
      }
    }
  }
  __syncthreads();
}

template <int DQK>
DI void attn_item(const bf16_t* __restrict__ Qh, int qstride, const bf16_t* __restrict__ Kh, const bf16_t* __restrict__ Vth, bf16_t* __restrict__ Oh,
                  int a0, int a1, int b0, int b1, bool band, int qpos0, float m_init, float l_init, unsigned char* smem) {
  constexpr int KS = DQK + 8, NQ = DQK / 16, KCH = DQK / 8, KPT = (64 * KCH) / 256;
  bf16_t* sK = (bf16_t*)smem;
  bf16_t* sV = (bf16_t*)(smem + 2 * 64 * KS * 2);
  const int tid = TIDX, lane = tid & 63, wave = tid >> 6, r = lane & 31, h = lane >> 5;
  bf16x8 qf[NQ];
  {
    const bf16_t* qp = Qh + (size_t)(wave * 32 + r) * qstride + 8 * h;
#pragma unroll
    for (int ds = 0; ds < NQ; ++ds) qf[ds] = *(const bf16x8*)(qp + ds * 16);
  }
  f32x16 o0, o1;
#pragma unroll
  for (int i = 0; i < 16; ++i) { o0[i] = 0.f; o1[i] = 0.f; }
  float m = m_init, l = (h == 0) ? l_init : 0.f;
  const int nA = (a1 - a0) >> 6, nB = (b1 - b0) >> 6, nT = nA + nB;
  uint4 rk0, rk1, rk2 = {0u, 0u, 0u, 0u}, rv0, rv1;
#define ATT_KADDR(i) (Kh + (size_t)(key0_ + (tid + 256 * (i)) / KCH) * DQK + ((tid + 256 * (i)) % KCH) * 8)
#define ATT_VADDR(i) (Vth + (size_t)((tid + 256 * (i)) >> 3) * KEYS + key0_ + ((tid + 256 * (i)) & 7) * 8)
#define ATT_GLOAD(TI)                                                                                         \
  {                                                                                                           \
    const int ti_ = (TI);                                                                                     \
    const int key0_ = ti_ < nA ? a0 + ti_ * 64 : b0 + (ti_ - nA) * 64;                                        \
    rk0 = *(const uint4*)ATT_KADDR(0);                                                                        \
    rk1 = *(const uint4*)ATT_KADDR(1);                                                                        \
    if (KPT > 2) rk2 = *(const uint4*)ATT_KADDR(2);                                                           \
    rv0 = *(const uint4*)ATT_VADDR(0);                                                                        \
    rv1 = *(const uint4*)ATT_VADDR(1);                                                                        \
  }
#define ATT_KSADDR(i) (sK + buf_ * (64 * KS) + ((tid + 256 * (i)) / KCH) * KS + ((tid + 256 * (i)) % KCH) * 8)
#define ATT_VSADDR(i) (sV + buf_ * (64 * 72) + ((tid + 256 * (i)) >> 3) * 72 + ((tid + 256 * (i)) & 7) * 8)
#define ATT_SSTORE(BUF)                                                                                       \
  {                                                                                                           \
    const int buf_ = (BUF);                                                                                   \
    *(uint4*)ATT_KSADDR(0) = rk0;                                                                             \
    *(uint4*)ATT_KSADDR(1) = rk1;                                                                             \
    if (KPT > 2) *(uint4*)ATT_KSADDR(2) = rk2;                                                                \
    *(uint4*)ATT_VSADDR(0) = rv0;                                                                             \
    *(uint4*)ATT_VSADDR(1) = rv1;                                                                             \
  }
  ATT_GLOAD(0)
  ATT_SSTORE(0)
  __syncthreads();
  for (int ti = 0; ti < nT; ++ti) {
    const int cur = ti & 1;
    if (ti + 1 < nT) ATT_GLOAD(ti + 1)
    __builtin_amdgcn_sched_barrier(0);
    const bool inA = ti < nA;
    const int key0 = inA ? a0 + ti * 64 : b0 + (ti - nA) * 64;
    const bool msk = band && inA;
#pragma unroll
    for (int kb = 0; kb < 2; ++kb) {
      const int kbase = key0 + kb * 32;
      bool skip = false;
      if (msk) { const int qw = qpos0 + wave * 32; skip = (kbase > qw + 31 + 128) || (kbase + 31 < qw - 128); }
      if (!skip) {
        f32x16 s;
#pragma unroll
        for (int i = 0; i < 16; ++i) s[i] = 0.f;
        const bf16_t* kp = sK + cur * (64 * KS) + (kb * 32 + r) * KS + 8 * h;
#pragma unroll
        for (int ds = 0; ds < NQ; ++ds) { const bf16x8 a = *(const bf16x8*)(kp + ds * 16); s = MFMA32(a, qf[ds], s); }
        if (msk) {
          const int qp_ = qpos0 + wave * 32 + r;
#pragma unroll
          for (int i = 0; i < 16; ++i) { const int dlt = qp_ - (kbase + crow(i, h)); if (dlt > 128 || dlt < -128) s[i] = -1e30f; }
        }
        float mx = s[0];
#pragma unroll
        for (int i = 1; i < 16; ++i) mx = fmaxf(mx, s[i]);
        mx = fmaxf(mx, __shfl_xor(mx, 32));
        const float mn = fmaxf(m, mx);
        const float alpha = __builtin_amdgcn_exp2f(m - mn);
        m = mn;
        s = s - mn;
#pragma unroll
        for (int i = 0; i < 16; ++i) s[i] = __builtin_amdgcn_exp2f(s[i]);
        float ps;
        {
          typedef float f32x8_t __attribute__((ext_vector_type(8)));
          const f32x8_t lo8 = __builtin_shufflevector(s, s, 0, 1, 2, 3, 4, 5, 6, 7), hi8 = __builtin_shufflevector(s, s, 8, 9, 10, 11, 12, 13, 14, 15);
          const f32x8_t s8 = lo8 + hi8;
          const f32x4 s4 = __builtin_shufflevector(s8, s8, 0, 1, 2, 3) + __builtin_shufflevector(s8, s8, 4, 5, 6, 7);
          const f32x2 s2 = __builtin_shufflevector(s4, s4, 0, 1) + __builtin_shufflevector(s4, s4, 2, 3);
          ps = s2.x + s2.y;
        }
        l = l * alpha + ps;
        if (__builtin_amdgcn_ballot_w64(alpha != 1.0f) != 0ull) {
#pragma unroll
          for (int i = 0; i < 16; ++i) { o0[i] *= alpha; o1[i] *= alpha; }
        }
        bf16x8 pf0, pf1;
#pragma unroll
        for (int j = 0; j < 8; j += 2) {
          const unsigned w0 = pk2(s[j], s[j + 1]), w1 = pk2(s[8 + j], s[8 + j + 1]);
          pf0[j] = (short)(w0 & 0xffffu); pf0[j + 1] = (short)(w0 >> 16);
          pf1[j] = (short)(w1 & 0xffffu); pf1[j + 1] = (short)(w1 >> 16);
        }
        const bf16_t* vp = sV + cur * (64 * 72) + r * 72 + kb * 32 + 4 * h;
#pragma unroll
        for (int st = 0; st < 2; ++st) {
          const s16x4 lo0 = *(const s16x4*)(vp + 16 * st), hi0 = *(const s16x4*)(vp + 16 * st + 8);
          const s16x4 lo1 = *(const s16x4*)(vp + 32 * 72 + 16 * st), hi1 = *(const s16x4*)(vp + 32 * 72 + 16 * st + 8);
          const bf16x8 va0 = __builtin_shufflevector(lo0, hi0, 0, 1, 2, 3, 4, 5, 6, 7);
          const bf16x8 va1 = __builtin_shufflevector(lo1, hi1, 0, 1, 2, 3, 4, 5, 6, 7);
          o0 = MFMA32(va0, st ? pf1 : pf0, o0);
          o1 = MFMA32(va1, st ? pf1 : pf0, o1);
        }
      }
    }
    __builtin_amdgcn_sched_barrier(0);
    if (ti + 1 < nT) ATT_SSTORE(cur ^ 1)
    __syncthreads();
  }
  l += __shfl_xor(l, 32);
  const float inv = 1.0f / l;
  bf16_t* op = Oh + (size_t)(wave * 32 + r) * 256;
#pragma unroll
  for (int g = 0; g < 4; ++g) {
    uint2 w;
    w.x = pk2(o0[4 * g] * inv, o0[4 * g + 1] * inv); w.y = pk2(o0[4 * g + 2] * inv, o0[4 * g + 3] * inv);
    *(uint2*)(op + 8 * g + 4 * h) = w;
    w.x = pk2(o1[4 * g] * inv, o1[4 * g + 1] * inv); w.y = pk2(o1[4 * g + 2] * inv, o1[4 * g + 3] * inv);
    *(uint2*)(op + 32 + 8 * g + 4 * h) = w;
  }
}

DI void mla_item(const P& p, int b, int head, int row0, int a0, int a1, unsigned char* smem) {
  unsigned char* ws = p.ws;
  const bf16_t* Q = (const bf16_t*)(ws + O_QMLA) + ((size_t)row0 * 4 + head) * 96;
  const bf16_t* K = (const bf16_t*)(ws + O_KMLA) + ((size_t)b * 4 + head) * KEYS * 96;
  const bf16_t* V = (const bf16_t*)(ws + O_VMLAT) + ((size_t)b * 4 + head) * 64 * KEYS;
  bf16_t* O = (bf16_t*)(ws + O_O4) + (size_t)row0 * 256 + head * 64;
  attn_item<96>(Q, 384, K, V, O, a0, a1, 0, 0, false, 0, -1e30f, 0.f, smem);
}
DI void swa_item(const P& p, int layer, int b, int head, int row0, int a0, int a1, int b0, int b1, bool band, int qpos0, unsigned char* smem) {
  unsigned char* ws = p.ws;
  const int kvh = head >> 1;
  const bf16_t* Q = (const bf16_t*)(ws + O_QSWA) + ((size_t)row0 * 4 + head) * 64;
  const bf16_t* K = (const bf16_t*)(ws + O_KSWA) + ((size_t)b * 2 + kvh) * KEYS * 64;
  const bf16_t* V = (const bf16_t*)(ws + O_VSWAT) + ((size_t)b * 2 + kvh) * 64 * KEYS;
  bf16_t* O = (bf16_t*)(ws + O_O4) + (size_t)2 * M_ALL * 256 + (size_t)row0 * 256 + head * 64;
  const float sink = p.in[I_SINK][layer * 4 + head] * LOG2E;
  attn_item<64>(Q, 256, K, V, O, a0, a1, b0, b1, band, qpos0, sink, 1.f, smem);
}

DI void phase_mix(const P& p, int slot, int layer, bool ctx_out, unsigned char* smem, int* s_item) {
  unsigned* ctr = (unsigned*)(p.ws + O_CTR) + slot;
  const int n_s5 = 256, n_hy = 1024, n_mla = 1024, n_swa = 1024;
  const int e0 = n_s5, e1 = e0 + n_hy, e2 = e1 + n_mla, e3 = e2 + n_swa;
  const int e4 = e3 + (ctx_out ? 1024 : 0), e5 = e4 + (ctx_out ? 64 : 0), e6 = e5 + (ctx_out ? 64 : 0);
  for (;;) {
    if (TIDX == 0) *s_item = (int)atomicAdd(ctr, 1u);
    __syncthreads();
    const int it = *s_item;
    __syncthreads();
    if (it >= e6) break;
    if (it < e0) { for (int rp = 0; rp < REP_S5; ++rp) s5_item(p, layer, it, smem); }
    else if (it < e1) { const int j = it - e0; for (int rp = 0; rp < REP_HY; ++rp) hyena_item(p, layer, 0, j >> 2, j & 3, smem); }
    else if (it < e2) {
      const int j = it - e1, qb = j & 31, head = (j >> 5) & 3, b = j >> 7;
      for (int rp = 0; rp < REP_MLA; ++rp) mla_item(p, b, head, b * 4096 + qb * 128, 0, KEYS, smem);
    } else if (it < e3) {
      const int j = it - e2, qb = j & 31, head = (j >> 5) & 3, b = j >> 7, q0 = qb * 128;
      const int a0 = q0 >= 128 ? q0 - 128 : 0, a1 = q0 + 256 <= 4096 ? q0 + 256 : 4096;
      for (int rp = 0; rp < REP_SWA; ++rp) swa_item(p, layer, b, head, b * 4096 + q0, a0, a1, 4096, KEYS, true, q0, smem);
    } else if (it < e4) { const int j = it - e3; hyena_item(p, layer, 1, j >> 2, j & 3, smem); }
    else if (it < e5) {
      const int j = it - e4, qb = j & 1, head = (j >> 1) & 3, b = j >> 3;
      mla_item(p, b, head, M_LAT + b * 256 + qb * 128, 4096, KEYS, smem);
    } else {
      const int j = it - e5, qb = j & 1, head = (j >> 1) & 3, b = j >> 3;
      swa_item(p, layer, b, head, M_LAT + b * 256 + qb * 128, 4096, KEYS, 0, 0, false, 0, smem);
    }
  }
}

#define XB_TMO      128
#define XB_XCNT(j)  (256  + 64 * (j))
#define XB_XSUB(j)  (1280 + 64 * (j))
#define XB_XGEN(j)  (2304 + 64 * (j))
#define XB_TOP      3328
#define XB_TOPGEN   3392
#define XCD_BAR_WORDS 3456
#define XB_SPIN_CAP (1u << 22)
#define LAS __attribute__((address_space(3)))
DI unsigned xb_ld(unsigned* p) { return __hip_atomic_load(p, __ATOMIC_RELAXED, __HIP_MEMORY_SCOPE_AGENT); }
DI unsigned xb_add(unsigned* p, unsigned v) { return __hip_atomic_fetch_add(p, v, __ATOMIC_RELAXED, __HIP_MEMORY_SCOPE_AGENT); }
DI unsigned xb_xcc_id() { return (unsigned)__builtin_amdgcn_s_getreg((3 << 11) | 20) & 0xFu; }
#define XB_SPIN(cond, bar) do { unsigned _sp = 0; while (cond) { __builtin_amdgcn_s_sleep(1); \
    if ((++_sp & 255u) == 0u) { if (xb_ld(&(bar)[XB_TMO])) break; if (_sp > XB_SPIN_CAP) { atomicAdd(&(bar)[XB_TMO], 1u); break; } } } } while (0)
struct XcdBarrier { unsigned* bar; unsigned x; volatile LAS unsigned* st; };
DI XcdBarrier xcd_barrier_post(unsigned* bar, volatile LAS unsigned* st) {
  XcdBarrier b; b.bar = bar; b.x = xb_xcc_id(); b.st = st;
  if (threadIdx.x == 0) (void)xb_add(&bar[XB_XCNT(b.x)], 1u);
  return b;
}
DI void xcd_barrier_complete(unsigned* bar, unsigned x, unsigned& nloc, unsigned& nx) {
  const unsigned G = gridDim.x * gridDim.y * gridDim.z;
  unsigned sum, cnt, mine, sp = 0u;
  for (;;) {
    sum = 0u; cnt = 0u; mine = 0u;
#pragma unroll
    for (unsigned j = 0; j < 16; ++j) { const unsigned c = xb_ld(&bar[XB_XCNT(j)]); sum += c; cnt += (c > 0u) ? 1u : 0u; mine = (j == x) ? c : mine; }
    if (sum == G) break;
    __builtin_amdgcn_s_sleep(1);
    if ((++sp & 255u) == 0u) { if (xb_ld(&bar[XB_TMO])) break; if (sp > XB_SPIN_CAP) { atomicAdd(&bar[XB_TMO], 1u); break; } }
  }
  nloc = mine > 0u ? mine : 1u; nx = cnt > 0u ? cnt : 1u;
}
DI void xcd_barrier(const XcdBarrier& b) {
  asm volatile("s_waitcnt vmcnt(0)" ::: "memory");
  __syncthreads();
  if (threadIdx.x == 0) {
    unsigned* bar = b.bar;
    __builtin_amdgcn_s_waitcnt(0);
    unsigned nloc = b.st[0], nx = b.st[1];
    if (nloc == 0u) { xcd_barrier_complete(bar, b.x, nloc, nx); b.st[0] = nloc; b.st[1] = nx; }
    const unsigned old = xb_add(&bar[XB_XSUB(b.x)], 1u);
    const unsigned gen = old / nloc;
    if (old + 1u == (gen + 1u) * nloc) {
      __builtin_amdgcn_fence(__ATOMIC_RELEASE, "agent");
      asm volatile("s_waitcnt vmcnt(0)" ::: "memory");
      const unsigned og = xb_add(&bar[XB_TOP], 1u);
      const unsigned tg = og / nx;
      if (og + 1u == (tg + 1u) * nx) xb_add(&bar[XB_TOPGEN], 1u);
      else XB_SPIN(xb_ld(&bar[XB_TOPGEN]) == tg, bar);
      __builtin_amdgcn_fence(__ATOMIC_ACQUIRE, "agent");
      xb_add(&bar[XB_XGEN(b.x)], 1u);
      asm volatile("s_waitcnt vmcnt(0)" ::: "memory");
    } else {
      XB_SPIN(xb_ld(&bar[XB_XGEN(b.x)]) == gen, bar);
      __builtin_amdgcn_fence(__ATOMIC_ACQUIRE, "agent");
      asm volatile("s_waitcnt vmcnt(0)" ::: "memory");
    }
  }
  __syncthreads();
}

#ifndef REP_UPDN
#define REP_UPDN 1
#endif
#ifndef REP_MIXER_GEMM
#define REP_MIXER_GEMM 1
#endif
#ifndef REP_MIX
#define REP_MIX 1
#endif
#ifndef REP_PRO
#define REP_PRO 1
#endif
#ifndef REP_CONV
#define REP_CONV 1
#endif
#ifndef REP_KF
#define REP_KF 1
#endif
#ifndef REP_MODH
#define REP_MODH 1
#endif
#ifndef REP_MODONLY
#define REP_MODONLY 1
#endif
#ifndef REP_H2ONLY
#define REP_H2ONLY 1
#endif
#ifndef REP_SYNC
#define REP_SYNC 1
#endif
#define GSYNC() { for (int rs_ = 0; rs_ < REP_SYNC; ++rs_) xcd_barrier(xb); }
__global__ void __launch_bounds__(NT, 2) fwd_megakernel(P p) {
  cg::grid_group grid = cg::this_grid();
  __shared__ __attribute__((aligned(16))) unsigned char smem[SMEM_BYTES];
  __shared__ int s_item;
  unsigned char* ws = p.ws;
  __shared__ uint4 xb_words;
  if (threadIdx.x == 0) xb_words = make_uint4(0u, 0u, 0u, 0u);
  __syncthreads();
  XcdBarrier xb = xcd_barrier_post((unsigned*)(ws + O_BAR), (volatile LAS unsigned*)&xb_words);
  for (int rep = 0; rep < REP_PRO; ++rep) {
    for (int r2 = 0; r2 < REP_MODH; ++r2) { for (int r3 = 0; r3 < REP_MODONLY; ++r3) phase_modulation(p, smem); for (int r3 = 0; r3 < REP_H2ONLY; ++r3) phase_h2(p); phase_rope(p); }
    for (int r2 = 0; r2 < REP_CONV; ++r2) phase_convert(p, 0, smem);
    if (p.out == nullptr) grid.sync();
    GSYNC();
  }
  for (int rep = 0; rep < REP_PRO * REP_KF; ++rep) phase_kf(p, 0, true, smem);
  phase_rows(p, M_ALL, 0, 0, 0, 0.f, true, true, 0, 0, false);
  GSYNC();
#pragma unroll 1
  for (int layer = 0; layer < 2; ++layer) {
    const bool ctx_out = layer == 0;
    const int Mc = ctx_out ? M_ALL : M_LAT;
    for (int rep = 0; rep < REP_UPDN; ++rep) {
      phase_ffn_up(p, M_ALL, O_WUP1, smem);
      GSYNC();
      phase_gemm_plain_bf16(p, M_ALL, (const bf16_t*)(ws + O_ACT), DFF, (const bf16_t*)(ws + O_WDN1), (bf16_t*)(ws + O_F), 1024, smem);
      GSYNC();
    }
    phase_rows(p, M_ALL, 1, layer, 0, 0.5f, layer == 0, true, layer, 1, true);
    GSYNC();
    for (int rep = 0; rep < REP_MIXER_GEMM; ++rep) {
      if (rep) { phase_rows(p, M_ALL, 2, layer, 0, 0.f, false, false, 0, 0, true); GSYNC(); }
      phase_win(p, M_ALL, smem);
      GSYNC();
      phase_kvq(p, M_ALL, Mc, smem);
      GSYNC();
    }
    for (int rep = 0; rep < REP_MIX; ++rep) {
      phase_mix(p, layer + 2 * rep, layer, ctx_out, smem, &s_item);
      GSYNC();
      phase_glu(p, layer, Mc, smem);
      GSYNC();
    }
    for (int rep = 0; rep < REP_MIXER_GEMM; ++rep) {
      phase_merge(p, layer, Mc, smem);
      GSYNC();
      phase_gemm_plain_bf16(p, Mc, (const bf16_t*)(ws + O_MBUF), 1024, (const bf16_t*)(ws + O_WOUT), (bf16_t*)(ws + O_F), 1024, smem);
      GSYNC();
    }
    phase_rows(p, Mc, 1, layer, 1, 1.0f, false, true, layer, 2, false);
    GSYNC();
    for (int rep = 0; rep < REP_UPDN; ++rep) {
      phase_ffn_up(p, Mc, O_WUP2, smem);
      GSYNC();
      phase_gemm_plain_bf16(p, Mc, (const bf16_t*)(ws + O_ACT), DFF, (const bf16_t*)(ws + O_WDN2), (bf16_t*)(ws + O_F), 1024, smem);
      GSYNC();
    }
    phase_rows(p, Mc, 1, layer, 2, 0.5f, false, layer == 0, layer + 1, 0, false);
    if (layer == 0) {
      for (int rep = 0; rep < REP_PRO; ++rep) {
        for (int r2 = 0; r2 < REP_CONV; ++r2) phase_convert(p, 1, smem);
        for (int r2 = 0; r2 < REP_KF; ++r2) phase_kf(p, 1, false, smem);
      }
    }
    GSYNC();
  }
}

extern "C" void kernel_launch(void* const* d_in, const int* in_sizes, int n_in, void* d_out, int out_size, void* d_ws, size_t ws_size,
                              hipStream_t stream) {
  (void)in_sizes; (void)out_size;
  static int grid_blocks = 0;
  if (!grid_blocks) {
    int dev = 0, cus = 0, per = 0;
    (void)hipGetDevice(&dev);
    (void)hipDeviceGetAttribute(&cus, hipDeviceAttributeMultiprocessorCount, dev);
    (void)hipOccupancyMaxActiveBlocksPerMultiprocessor(&per, fwd_megakernel, NT, 0);
    if (per > 2) per = 2;
    if (per < 1) per = 1;
    grid_blocks = cus * per;
    grid_blocks &= ~7;
  }
  if (ws_size < WS_NEED || n_in < N_INPUTS) {
    fprintf(stderr, "workspace too small: need %zu have %zu\n", (size_t)WS_NEED, ws_size);
    return;
  }
  P p{};
  for (int i = 0; i < N_INPUTS; ++i) p.in[i] = (const float*)d_in[i];
  p.out = (float*)d_out;
  p.ws = (unsigned char*)d_ws;
  (void)hipMemsetAsync((unsigned char*)d_ws + O_CTR, 0, (size_t)(O_R - O_CTR), stream);
  void* args[] = {&p};
  hipError_t e = hipLaunchCooperativeKernel((void*)fwd_megakernel, dim3(grid_blocks), dim3(NT), args, 0, stream);
  if (e != hipSuccess) fprintf(stderr, "cooperative launch failed: %s (grid %d)\n", hipGetErrorString(e), grid_blocks);
}
```
